# Optimizing an MI355X kernel written in HIP

```python
import jax, jax.numpy as jnp
from jax import lax
import numpy as np

D_MODEL = 1024
BATCH = 2
SEQ = 16384
DEPTH = 1

GRID_W = 64
CTX_LEN = 256
HEAD_DIM = 128
N_Q_HEADS = 4
N_KV_HEADS = 2
Q_PER_KV = N_Q_HEADS // N_KV_HEADS
ATTN_WIDTH = N_Q_HEADS * HEAD_DIM
KV_WIDTH = N_KV_HEADS * HEAD_DIM
AXIS_DIM = HEAD_DIM // 2
ROPE_THETA = 10000.0
Q_BLOCK = 128
CONV_WIDTH = D_MODEL - ATTN_WIDTH
CONV_K = 3
MIX_WIDTH = ATTN_WIDTH + CONV_WIDTH
Q_END = ATTN_WIDTH
K_END = Q_END + KV_WIDTH
KV_END = K_END + KV_WIDTH
CB_END = KV_END + CONV_WIDTH
CC_END = CB_END + CONV_WIDTH
IN_COLS = CC_END + CONV_WIDTH
N_EXPERTS = 32
TOP_K = 4
D_FF = D_MODEL
SWIGLU_LIMIT = 7.0
SWIGLU_ALPHA = 1.702
MOE_BLOCK = 128
N_MOD = 6
NORM_EPS = 1e-6

kernel_name = "hybrid_conv_gqa_moe_prefix_dit_block"


def rmsnorm(x, gain):
    x32 = x.astype(jnp.float32)
    y = x32 * lax.rsqrt(jnp.mean(x32 * x32, axis=-1, keepdims=True) + NORM_EPS)
    return y.astype(x.dtype) * gain


def ada_params(cond, w_ada, b_ada):
    mod = jax.nn.silu(cond) @ w_ada + b_ada
    return jnp.split(mod[..., None, :], N_MOD, axis=-1)


def modulate(x, gain, shift, scale):
    return rmsnorm(x, gain) * (1.0 + scale) + shift


def split_in(p):
    return jnp.split(p, [Q_END, K_END, KV_END, CB_END, CC_END], axis=-1)


def to_heads(t, n_heads, gain=None):
    b, n, _ = t.shape
    t = t.reshape(b, n, n_heads, HEAD_DIM)
    return t if gain is None else rmsnorm(t, gain)


def axial_rope_tables(n_tokens):
    rows = n_tokens // GRID_W
    row = jnp.broadcast_to(jnp.arange(rows, dtype=jnp.float32)[:, None], (rows, GRID_W)).reshape(-1)
    col = jnp.broadcast_to(jnp.arange(GRID_W, dtype=jnp.float32)[None, :], (rows, GRID_W)).reshape(-1)
    inv_freq = ROPE_THETA ** (-jnp.arange(0, AXIS_DIM, 2, dtype=jnp.float32) / AXIS_DIM)
    ang = jnp.stack([row[:, None] * inv_freq, col[:, None] * inv_freq], axis=1)
    return jnp.cos(ang), jnp.sin(ang)


def apply_axial_rope(t, cos, sin):
    b, n, h, _ = t.shape
    tr = t.astype(jnp.float32).reshape(b, n, h, 2, 2, AXIS_DIM // 2)
    t1, t2 = tr[..., 0, :], tr[..., 1, :]
    cs, sn = cos[None, :, None], sin[None, :, None]
    out = jnp.stack([t1 * cs - t2 * sn, t2 * cs + t1 * sn], axis=-2)
    return out.reshape(b, n, h, HEAD_DIM).astype(t.dtype)


def dense_attention(q, k, v):
    b, nq, _, _ = q.shape
    qg = q.reshape(b, nq, N_KV_HEADS, Q_PER_KV, HEAD_DIM)
    s = jnp.einsum('bqkgd,bskd->bkgqs', qg, k, preferred_element_type=jnp.float32) * (HEAD_DIM ** -0.5)
    p = jax.nn.softmax(s, axis=-1).astype(v.dtype)
    o = jnp.einsum('bkgqs,bskd->bqkgd', p, v)
    return o.reshape(b, nq, ATTN_WIDTH)


def blocked_attention(q, k, v):
    b, n, _, _ = q.shape
    nblk = n // Q_BLOCK
    qb = q.reshape(b, nblk, Q_BLOCK, N_Q_HEADS, HEAD_DIM).transpose(1, 0, 2, 3, 4)
    o = lax.map(lambda qblk: dense_attention(qblk, k, v), qb)
    return o.transpose(1, 0, 2, 3).reshape(b, n, ATTN_WIDTH)


def short_conv_mixer(cb, cc, cx, conv_w):
    u = cc * cx
    up = jnp.pad(u, ((0, 0), (1, 1), (0, 0)))
    y = up[:, :-2] * conv_w[0] + up[:, 1:-1] * conv_w[1] + up[:, 2:] * conv_w[2]
    return cb * y


def clamped_swiglu(gu):
    glu, lin = jnp.split(gu, 2, axis=-1)
    glu = jnp.minimum(glu, SWIGLU_LIMIT)
    lin = jnp.clip(lin, -SWIGLU_LIMIT, SWIGLU_LIMIT)
    return glu * jax.nn.sigmoid(SWIGLU_ALPHA * glu) * (lin + 1.0)


def moe_ffn(h, w_router, b_router, w_gate_up, b_gate_up, w_down, b_down):
    n_tok, d = h.shape
    logits = jnp.dot(h, w_router, preferred_element_type=jnp.float32) + b_router.astype(jnp.float32)
    top_logit, top_idx = lax.top_k(logits, TOP_K)
    gate = jax.nn.softmax(top_logit, axis=-1)
    n_pair = n_tok * TOP_K
    n_blocks = -(-(n_pair + N_EXPERTS * (MOE_BLOCK - 1)) // MOE_BLOCK)
    n_slots = n_blocks * MOE_BLOCK
    flat_e = top_idx.reshape(-1).astype(jnp.int32)
    flat_tok = jnp.repeat(jnp.arange(n_tok, dtype=jnp.int32), TOP_K, total_repeat_length=n_pair)
    flat_gate = gate.reshape(-1)
    order = jnp.argsort(flat_e, stable=True)
    e_sorted = flat_e[order]
    counts = jnp.zeros((N_EXPERTS,), jnp.int32).at[flat_e].add(1)
    padded = (counts + MOE_BLOCK - 1) // MOE_BLOCK * MOE_BLOCK
    start = jnp.cumsum(counts) - counts
    pad_end = jnp.cumsum(padded)
    pad_start = pad_end - padded
    slot = pad_start[e_sorted] + jnp.arange(n_pair, dtype=jnp.int32) - start[e_sorted]
    slot_tok = jnp.full((n_slots,), n_tok, jnp.int32).at[slot].set(flat_tok[order])
    slot_gate = jnp.zeros((n_slots,), jnp.float32).at[slot].set(flat_gate[order])
    block_start = jnp.arange(n_blocks, dtype=jnp.int32) * MOE_BLOCK
    block_expert = jnp.minimum(jnp.searchsorted(pad_end, block_start, side='right'), N_EXPERTS - 1)
    h_pad = jnp.concatenate([h, jnp.zeros((1, d), h.dtype)], axis=0)

    def expert_block(args):
        tok, g, e = args
        xb = h_pad[tok]
        gu = xb @ w_gate_up[e] + b_gate_up[e]
        y = clamped_swiglu(gu) @ w_down[e] + b_down[e]
        return y * g[:, None].astype(y.dtype)

    y = lax.map(expert_block, (slot_tok.reshape(n_blocks, MOE_BLOCK),
                               slot_gate.reshape(n_blocks, MOE_BLOCK), block_expert))
    out = jnp.zeros((n_tok + 1, d), y.dtype).at[slot_tok].add(y.reshape(n_slots, d))
    return out[:n_tok]


def setup_inputs(seed: int = 0) -> dict:
    key = jax.random.key(seed)
    ks = jax.random.split(key, 20)
    f32 = jnp.float32
    nrm = lambda k, shape, s: jax.random.normal(k, shape, f32) * s
    return {
        "x": nrm(ks[0], (BATCH, SEQ, D_MODEL), 1.0),
        "c": nrm(ks[1], (BATCH, D_MODEL), 1.0),
        "ctx": nrm(ks[2], (BATCH, CTX_LEN, D_MODEL), 1.0),
        "c_ctx": nrm(ks[3], (D_MODEL,), 1.0),
        "w_ada": nrm(ks[4], (DEPTH, D_MODEL, N_MOD * D_MODEL), 0.2 * D_MODEL ** -0.5),
        "b_ada": nrm(ks[5], (DEPTH, N_MOD * D_MODEL), 0.01),
        "g_norm1": 1.0 + nrm(ks[6], (DEPTH, D_MODEL), 0.01),
        "g_norm2": 1.0 + nrm(ks[7], (DEPTH, D_MODEL), 0.01),
        "w_in": nrm(ks[8], (DEPTH, D_MODEL, IN_COLS), D_MODEL ** -0.5),
        "g_q": 1.0 + nrm(ks[9], (DEPTH, HEAD_DIM), 0.01),
        "g_k": 1.0 + nrm(ks[10], (DEPTH, HEAD_DIM), 0.01),
        "w_conv": nrm(ks[11], (DEPTH, CONV_K, CONV_WIDTH), CONV_K ** -0.5),
        "w_out": nrm(ks[12], (DEPTH, MIX_WIDTH, D_MODEL), MIX_WIDTH ** -0.5),
        "w_router": nrm(ks[13], (DEPTH, D_MODEL, N_EXPERTS), D_MODEL ** -0.5),
        "b_router": nrm(ks[14], (DEPTH, N_EXPERTS), 0.01),
        "w_gate_up": nrm(ks[15], (DEPTH, N_EXPERTS, D_MODEL, 2 * D_FF), D_MODEL ** -0.5),
        "b_gate_up": nrm(ks[16], (DEPTH, N_EXPERTS, 2 * D_FF), 0.01),
        "w_down": nrm(ks[17], (DEPTH, N_EXPERTS, D_FF, D_MODEL), D_FF ** -0.5),
        "b_down": nrm(ks[18], (DEPTH, N_EXPERTS, D_MODEL), 0.01),
        "g_final": 1.0 + nrm(ks[19], (D_MODEL,), 0.01),
    }


def reference(x, c, ctx, c_ctx, w_ada, b_ada, g_norm1, g_norm2, w_in, g_q, g_k, w_conv, w_out,
              w_router, b_router, w_gate_up, b_gate_up, w_down, b_down, g_final):
    b, n, d = x.shape
    cos, sin = axial_rope_tables(n)
    for layer in range(DEPTH):
        last = layer == DEPTH - 1
        sh1, sc1, gt1, sh2, sc2, gt2 = ada_params(c, w_ada[layer], b_ada[layer])
        csh1, csc1, cgt1, csh2, csc2, cgt2 = ada_params(c_ctx, w_ada[layer], b_ada[layer])
        w_in_l = w_in[layer]

        hc = modulate(ctx, g_norm1[layer], csh1, csc1)
        if last:
            kc, vc = jnp.split(hc @ w_in_l[:, Q_END:KV_END], 2, axis=-1)
        else:
            qc, kc, vc, cbc, ccc, cxc = split_in(hc @ w_in_l)
        kc = to_heads(kc, N_KV_HEADS, g_k[layer])
        vc = to_heads(vc, N_KV_HEADS)
        if not last:
            qc = to_heads(qc, N_Q_HEADS, g_q[layer])
            mix_c = jnp.concatenate([dense_attention(qc, kc, vc),
                                     short_conv_mixer(cbc, ccc, cxc, w_conv[layer])], axis=-1)
            ctx_next = ctx + cgt1 * (mix_c @ w_out[layer])
            hc2 = modulate(ctx_next, g_norm2[layer], csh2, csc2).reshape(-1, d)
            ctx_next = ctx_next + cgt2 * moe_ffn(hc2, w_router[layer], b_router[layer], w_gate_up[layer],
                                                 b_gate_up[layer], w_down[layer], b_down[layer]).reshape(ctx.shape)

        h = modulate(x, g_norm1[layer], sh1, sc1)
        q, k, v, cb, cc, cx = split_in(h @ w_in_l)
        q = apply_axial_rope(to_heads(q, N_Q_HEADS, g_q[layer]), cos, sin)
        k = apply_axial_rope(to_heads(k, N_KV_HEADS, g_k[layer]), cos, sin)
        v = to_heads(v, N_KV_HEADS)
        k_all = jnp.concatenate([k, kc], axis=1)
        v_all = jnp.concatenate([v, vc], axis=1)
        attn = blocked_attention(q, k_all, v_all)
        conv = short_conv_mixer(cb, cc, cx, w_conv[layer])
        x = x + gt1 * (jnp.concatenate([attn, conv], axis=-1) @ w_out[layer])

        h2 = modulate(x, g_norm2[layer], sh2, sc2).reshape(-1, d)
        x = x + gt2 * moe_ffn(h2, w_router[layer], b_router[layer], w_gate_up[layer], b_gate_up[layer],
                              w_down[layer], b_down[layer]).reshape(b, n, d)
        if not last:
            ctx = ctx_next
    return rmsnorm(x, g_final)
```

```cpp
#include <hip/hip_runtime.h>
#include <hip/hip_bf16.h>
#include <cstdio>
#include <cstdint>

#ifndef MK_DUP
#define MK_DUP (-1)
#endif
#ifndef MK_ATTN_CHECK
#define MK_ATTN_CHECK 0
#endif
#ifndef MK_PER_PHASE
#define MK_PER_PHASE 0
#endif

constexpr int BATCH = 2, SEQ = 16384, DM = 1024, NTOK = BATCH * SEQ, CTXL = 256, NCTX = BATCH * CTXL, MROWS = NTOK + NCTX;
constexpr int SKV = SEQ + CTXL;
constexpr int HD = 128, NQH = 4, NKVH = 2, QW = NQH * HD  , KVW = NKVH * HD  , CW = 512;
constexpr int INC = 2560, NMOD = 6 * DM;
constexpr int NEXP = 32, TOPK = 4, DFF = 1024;
constexpr float NORM_EPS = 1e-6f;
constexpr float WSCALE = 32.0f, WINV = 1.0f / 32.0f;
constexpr int MAXTILES = (NTOK * TOPK) / 256 + NEXP;
constexpr int MAXROWS = MAXTILES * 256;
constexpr int NPHASE = 11;

constexpr size_t MiB = 1u << 20;
constexpr size_t WS_CTL = 0, CTL_ZERO_BYTES = 1 * MiB;
constexpr size_t WS_MOD = 1 * MiB;
constexpr size_t WS_ROPE = WS_MOD + 128 * 1024;
constexpr size_t WS_WRT = WS_ROPE + 128 * 1024;
constexpr size_t WS_WIN8 = WS_MOD + 512 * 1024;
constexpr size_t WS_WIN = 3 * MiB;
constexpr size_t WS_WOUT = 8 * MiB;
constexpr size_t WS_WGU = 10 * MiB;
constexpr size_t WS_WDN = 138 * MiB;
constexpr size_t WS_X1 = 202 * MiB;
constexpr size_t WS_H2 = 330 * MiB;
constexpr size_t WS_PINFO = 395 * MiB;
constexpr size_t WS_PGATE = 399 * MiB;
constexpr size_t WS_R1 = 404 * MiB;
constexpr size_t WS_H = WS_R1;
constexpr size_t WS_Q = WS_R1 + 65 * MiB;
constexpr size_t WS_K = WS_Q + 32 * MiB;
constexpr size_t WS_V = WS_K + 17 * MiB;
constexpr size_t WS_CB = WS_V + 17 * MiB;
constexpr size_t WS_U = WS_CB + 32 * MiB;
constexpr size_t WS_MIX = WS_U + 32 * MiB;
constexpr size_t WS_Q8 = WS_H, WS_K8 = WS_H + 16 * MiB, WS_V8T = WS_H + 26 * MiB;
constexpr size_t WS_YP = WS_R1;
constexpr size_t WS_ACT = 676 * MiB;
constexpr size_t WS_H8 = WS_ACT;
constexpr size_t WS_END = 948 * MiB;
static_assert(WS_MIX + 64 * MiB <= WS_R1 + 272 * MiB && (size_t)MAXROWS * 2048 <= 272 * MiB, "ws map");
constexpr int CW_FLAG = 32;
constexpr int CW_CNT = 64;
constexpr int CW_BAR = 4096;

constexpr int LDS_BYTES = 163840;
constexpr int MISC_OFF = 155648;
constexpr int MO_BAR = 0, MO_TS = 64, MO_TE = 256, MO_HIST = 2816, MO_BASE = 2944, MO_SELE = 3072, MO_SELG = 5120;

#define GAS __attribute__((address_space(1)))
#define LAS __attribute__((address_space(3)))
typedef unsigned short bf16_t;
typedef short bf16x8 __attribute__((ext_vector_type(8)));
typedef float f32x4 __attribute__((ext_vector_type(4)));
typedef float f32x2 __attribute__((ext_vector_type(2)));
typedef unsigned u32x4 __attribute__((ext_vector_type(4)));
typedef unsigned u32x2 __attribute__((ext_vector_type(2)));
typedef int i32x4_t __attribute__((ext_vector_type(4)));
typedef int i32x8_t __attribute__((ext_vector_type(8)));

__device__ __forceinline__ unsigned cvt_pk_bf16(float lo, float hi) { unsigned r; asm volatile("v_cvt_pk_bf16_f32 %0, %1, %2" : "=v"(r) : "v"(lo), "v"(hi)); return r; }
__device__ __forceinline__ unsigned pk4_fp8(float a, float b, float c, float d) { unsigned w = 0; w = __builtin_amdgcn_cvt_pk_fp8_f32(a, b, w, false); w = __builtin_amdgcn_cvt_pk_fp8_f32(c, d, w, true); return w; }
__device__ __forceinline__ float bf_lo(unsigned w) { return __uint_as_float(w << 16); }
__device__ __forceinline__ float bf_hi(unsigned w) { return __uint_as_float(w & 0xffff0000u); }
template <int CTRL> __device__ __forceinline__ float dpp_f(float v) { return __builtin_bit_cast(float, __builtin_amdgcn_update_dpp(0, __builtin_bit_cast(int, v), CTRL, 0xf, 0xf, true)); }
__device__ __forceinline__ float wave_sum(float v) {
    v += dpp_f<0xB1>(v); v += dpp_f<0x4E>(v); v += dpp_f<0x141>(v); v += dpp_f<0x140>(v);
    { auto r = __builtin_amdgcn_permlane16_swap(__float_as_uint(v), __float_as_uint(v), false, false); v = __uint_as_float(r[0]) + __uint_as_float(r[1]); }
    { auto r = __builtin_amdgcn_permlane32_swap(__float_as_uint(v), __float_as_uint(v), false, false); v = __uint_as_float(r[0]) + __uint_as_float(r[1]); }
    return v;
}
__device__ __forceinline__ float half_max(float v) {
    v = fmaxf(v, dpp_f<0xB1>(v)); v = fmaxf(v, dpp_f<0x4E>(v)); v = fmaxf(v, dpp_f<0x141>(v)); v = fmaxf(v, dpp_f<0x140>(v));
    { auto r = __builtin_amdgcn_permlane16_swap(__float_as_uint(v), __float_as_uint(v), false, false); v = fmaxf(__uint_as_float(r[0]), __uint_as_float(r[1])); }
    return v;
}

namespace pg8 {
constexpr int BM = 256, BK = 64, HALF = 128, HTB = HALF * BK * 2, STAGE_BYTES = 8 * HTB, NXCD = 8, WGM = 8;
__host__ __device__ __forceinline__ int lds_byte(int r, int c) { const int st = (r >> 4) * 2 + (c >> 5), rr = r & 15, cc = c & 31, ob = rr * 64 + cc * 2; return st * 1024 + (ob ^ (((ob >> 9) & 1) << 5)); }
__host__ __device__ __forceinline__ void stage_rc(int b, int& R, int& C) { const int st = b / 1024, sb = b % 1024, swz = sb ^ (((sb >> 9) & 1) << 5); R = (st >> 1) * 16 + swz / 64; C = (st & 1) * 32 + (swz % 64) / 2; }
__host__ __device__ __forceinline__ int perm32(int rho) { const int n = rho >> 4, i = rho & 15; return 8 * (i >> 2) + 4 * n + (i & 3); }

struct Unit { int pm, pn, e; };
struct Gemm { const bf16_t* A; const bf16_t* Bt; int M, N, K; size_t estride;
              const int* pinfo; const unsigned* cnt; const LAS int* ts; int ntok; };

struct StaticOrder {
    int nM, nN, nwg, G, c;
    __device__ void init(int nM_, int nN_, int G_, int c_) { nM = nM_; nN = nN_; nwg = nM * nN; G = G_; c = c_; }
    __device__ bool next(int i, Unit& u) const {
        const long L = (long)i * G + c; if (L >= nwg) return false;
        int wgid = (int)L; { const int q = nwg / NXCD, r = nwg % NXCD, xcd = wgid % NXCD, off = wgid / NXCD; wgid = (xcd < r ? xcd * (q + 1) : r * (q + 1) + (xcd - r) * q) + off; }
        const int nig = WGM * nN, gid = wgid / nig, fm = gid * WGM, gsz = (nM - fm) < WGM ? (nM - fm) : WGM;
        u.pm = fm + ((wgid % nig) % gsz); u.pn = (wgid % nig) / gsz; u.e = 0; return true;
    }
};

template <class Epi, class Sched, bool ALIGN_EPI = false, bool SP2 = false, bool FP8 = false, bool GATHER = false>
__device__ __forceinline__ void gemm_phase(LAS unsigned char* lds, const Gemm g, const Sched& S, const Epi& E) {
    int tid = threadIdx.x; asm volatile("" : "+v"(tid));
    const int wid = __builtin_amdgcn_readfirstlane(tid >> 6), lane = tid & 63, wr = wid >> 2, wc = wid & 3, fr = lane & 15, fq = lane >> 4;
    const int K = g.K, nt = K / BK;
    unsigned voffA[2], voffB[2], voffB1[2]; int Rrow[2]; unsigned cbyte[2];
#pragma unroll
    for (int i = 0; i < 2; ++i) { int R, C; stage_rc(tid * 16 + i * 8192, R, C); const int Rb = Epi::PERM ? ((R & ~31) + perm32(R & 31)) : R;
        voffA[i] = (unsigned)(R * K + C) * 2u; voffB[i] = (unsigned)(Rb * K + C) * 2u; Rrow[i] = R; cbyte[i] = (unsigned)C * 2u;
        if constexpr (Epi::BMODE == 1) {
            const int Rm = 64 * (R >> 5) + 16 * ((R & 15) >> 2) + 4 * ((R >> 4) & 1) + (R & 3);
            voffB[i] = (unsigned)(Rm * K + C) * 2u; voffB1[i] = (unsigned)((Rm + 8) * K + C) * 2u; } }
    unsigned gC[2][2], gN[2][2]; int gR[2][2];
#define PG8_GISSUE(u_) do { const int e_ = (u_).e; const int p0_ = ((u_).pm - g.ts[e_]) * 256; const int c_ = (int)g.cnt[e_]; \
        _Pragma("unroll") for (int h_ = 0; h_ < 2; ++h_) _Pragma("unroll") for (int i_ = 0; i_ < 2; ++i_) { const int pos_ = p0_ + 128 * h_ + Rrow[i_]; \
            const int* ap_ = g.pinfo + (size_t)e_ * g.ntok + (pos_ < c_ ? pos_ : 0); asm volatile("global_load_dword %0, %1, off" : "=v"(gR[h_][i_]) : "v"(ap_) : "memory"); } } while (0)
#define PG8_GCONV(u_, dst_) do { const int e_ = (u_).e; const int p0_ = ((u_).pm - g.ts[e_]) * 256; const int c_ = (int)g.cnt[e_]; \
        asm volatile("" : "+v"(gR[0][0]), "+v"(gR[0][1]), "+v"(gR[1][0]), "+v"(gR[1][1])); \
        _Pragma("unroll") for (int h_ = 0; h_ < 2; ++h_) _Pragma("unroll") for (int i_ = 0; i_ < 2; ++i_) { const int pos_ = p0_ + 128 * h_ + Rrow[i_]; \
            const int tok_ = pos_ < c_ ? (gR[h_][i_] >> 2) : g.ntok; dst_[h_][i_] = (unsigned)tok_ * (unsigned)(K * 2) + cbyte[i_]; } } while (0)
#define PG8_STAGE_B(bufoff, bbase, bj) do { if constexpr (Epi::BMODE == 1) { if ((bj) == 0) PG8_STAGE(bufoff, bbase, voffB); else PG8_STAGE(bufoff, bbase, voffB1); } \
        else { PG8_STAGE(bufoff, (bbase) + (bj) * hstep, voffB); } } while (0)
#define PG8_STAGE_A(bufoff, abase, h, nx) do { if constexpr (GATHER) { unsigned vs_[2] = {(nx) ? gN[h][0] : gC[h][0], (nx) ? gN[h][1] : gC[h][1]}; PG8_STAGE(bufoff, abase, vs_); } \
        else { PG8_STAGE(bufoff, (abase) + (h) * hstep, voffA); } } while (0)
    const size_t kstep = (size_t)(BK * 2);
    const size_t hstep = (size_t)HALF * K * 2;
    const size_t tstep = 2 * hstep;
    const unsigned ldsw = (unsigned)wid * 1024u;
    int aoff = lds_byte(wr * 64 + fr, fq * 8), boff = lds_byte(wc * 32 + fr, fq * 8) + 4 * HTB;
    asm volatile("" : "+v"(aoff), "+v"(boff));
#define PG8_SA(b, h) (((b) * 2 + (h)) * HTB)
#define PG8_SB(b, h) ((4 + (b) * 2 + (h)) * HTB)
#define PG8_STAGE(bufoff, gbase, voff) do { _Pragma("unroll") for (int _i = 0; _i < 2; ++_i) \
        __builtin_amdgcn_global_load_lds((const unsigned*)((const char*)(gbase) + (voff)[_i]), (LAS unsigned*)(lds + (bufoff) + ldsw + _i * 8192), 16, 0, 0); } while (0)
#define PG8_LD16(off) (*(const LAS i32x4_t*)(lds + (off)))
#define PG8_LDA(dst, b, h) do { _Pragma("unroll") for (int m = 0; m < 4; ++m) dst[m] = __builtin_shufflevector(PG8_LD16(aoff + PG8_SA(b, h) + m * 2048), PG8_LD16(aoff + PG8_SA(b, h) + m * 2048 + 1024), 0, 1, 2, 3, 4, 5, 6, 7); } while (0)
#define PG8_LDB(dst, b, h) do { _Pragma("unroll") for (int n = 0; n < 2; ++n) dst[n] = __builtin_shufflevector(PG8_LD16(boff + ((b) * 2 + (h)) * HTB + n * 2048), PG8_LD16(boff + ((b) * 2 + (h)) * HTB + n * 2048 + 1024), 0, 1, 2, 3, 4, 5, 6, 7); } while (0)
#define PG8_LOH(x) __builtin_bit_cast(bf16x8, __builtin_shufflevector((x), (x), 0, 1, 2, 3))
#define PG8_HIH(x) __builtin_bit_cast(bf16x8, __builtin_shufflevector((x), (x), 4, 5, 6, 7))
#define PG8_MMA(ai, bj, At, Bt) do { __builtin_amdgcn_s_setprio(1); if constexpr (FP8) { _Pragma("unroll") for (int m = 0; m < 4; ++m) _Pragma("unroll") for (int n = 0; n < 2; ++n) \
        asm volatile("v_mfma_f32_16x16x128_f8f6f4 %0, %1, %2, %0" : "+v"(acc[ai][bj][m][n]) : "v"(Bt[n]), "v"(At[m])); } else { \
        _Pragma("unroll") for (int m = 0; m < 4; ++m) _Pragma("unroll") for (int n = 0; n < 2; ++n) { \
        acc[ai][bj][m][n] = __builtin_amdgcn_mfma_f32_16x16x32_bf16(PG8_LOH(Bt[n]), PG8_LOH(At[m]), acc[ai][bj][m][n], 0, 0, 0); \
        acc[ai][bj][m][n] = __builtin_amdgcn_mfma_f32_16x16x32_bf16(PG8_HIH(Bt[n]), PG8_HIH(At[m]), acc[ai][bj][m][n], 0, 0, 0); } } __builtin_amdgcn_s_setprio(0); } while (0)
#define PG8_WAIT_V(n) asm volatile("s_waitcnt vmcnt(" #n ")" ::: "memory")
#define PG8_WAIT_L(n) asm volatile("s_waitcnt lgkmcnt(" #n ")" ::: "memory")
#define PG8_BAR __builtin_amdgcn_s_barrier()
#define PG8_SCHED __builtin_amdgcn_sched_barrier(0)
    Unit cur, nxt; int ui = 0;
    if (!S.next(0, cur)) return;
    f32x4 acc[2][2][4][2];
#pragma unroll
    for (int a = 0; a < 2; ++a)
#pragma unroll
        for (int b = 0; b < 2; ++b)
#pragma unroll
            for (int m = 0; m < 4; ++m)
#pragma unroll
                for (int n = 0; n < 2; ++n) acc[a][b][m][n] = (f32x4){0.f, 0.f, 0.f, 0.f};
    i32x8_t At[4], B0[2], B1[2];
    const char* cA = (const char*)g.A + (GATHER ? (size_t)0 : (size_t)cur.pm * tstep); const char* cB = (const char*)g.Bt + (size_t)cur.e * g.estride + (size_t)cur.pn * tstep;
    if constexpr (GATHER) { PG8_GISSUE(cur); asm volatile("s_waitcnt vmcnt(0)" ::: "memory"); PG8_GCONV(cur, gC);
#pragma unroll
        for (int h_ = 0; h_ < 2; ++h_)
#pragma unroll
            for (int i_ = 0; i_ < 2; ++i_) gN[h_][i_] = gC[h_][i_]; }
    if constexpr (SP2) {
        PG8_STAGE_B(PG8_SB(0, 0), cB, 0); PG8_STAGE_B(PG8_SB(0, 1), cB, 1); PG8_STAGE_A(PG8_SA(0, 0), cA, 0, false); PG8_STAGE_A(PG8_SA(0, 1), cA, 1, false);
        if (wr == 1) PG8_BAR;
        PG8_WAIT_V(2); PG8_BAR;
        PG8_STAGE_B(PG8_SB(1, 0), cB + kstep, 0); PG8_STAGE_A(PG8_SA(1, 0), cA + kstep, 0, false); PG8_STAGE_B(PG8_SB(1, 1), cB + kstep, 1);
        PG8_WAIT_V(6); PG8_BAR;
    } else {
        PG8_STAGE(PG8_SB(0, 0), cB, voffB); PG8_STAGE(PG8_SA(0, 0), cA, voffA); PG8_STAGE(PG8_SB(0, 1), cB + hstep, voffB); PG8_STAGE(PG8_SA(0, 1), cA + hstep, voffA);
        if (wr == 1) PG8_BAR;
        PG8_WAIT_V(4); PG8_BAR;
        PG8_STAGE(PG8_SB(1, 0), cB + kstep, voffB); PG8_STAGE(PG8_SA(1, 0), cA + kstep, voffA); PG8_STAGE(PG8_SB(1, 1), cB + hstep + kstep, voffB);
        PG8_WAIT_V(6); PG8_BAR;
    }
    for (;;) {
        const bool has_next = S.next(ui + 1, nxt);
        const char* nA = (has_next && !GATHER) ? (const char*)g.A + (size_t)nxt.pm * tstep : cA; const char* nB = has_next ? (const char*)g.Bt + (size_t)nxt.e * g.estride + (size_t)nxt.pn * tstep : cB;
        if constexpr (GATHER) { if (has_next) PG8_GISSUE(nxt); }
#pragma unroll 1
        for (int t = 0; t < nt; t += 2) {
            const bool last = (t == nt - 2);
            const char* a1 = cA + (size_t)(t + 1) * kstep;
            const char* a2 = last ? nA : cA + (size_t)(t + 2) * kstep; const char* b2 = last ? nB : cB + (size_t)(t + 2) * kstep;
            const char* a3 = a2 + kstep; const char* b3 = b2 + kstep;
            if constexpr (GATHER) { if (last && has_next) PG8_GCONV(nxt, gN); }
            if constexpr (SP2) {
            PG8_LDB(B0, 0, 0); PG8_LDB(B1, 0, 1); PG8_SCHED; PG8_LDA(At, 0, 0); PG8_STAGE_A(PG8_SA(1, 1), a1, 1, false);
            PG8_WAIT_V(8); PG8_WAIT_L(0); PG8_BAR; PG8_MMA(0, 0, At, B0); PG8_MMA(0, 1, At, B1); PG8_BAR; PG8_SCHED;
            PG8_LDA(At, 0, 1); PG8_STAGE_B(PG8_SB(0, 0), b2, 0); PG8_STAGE_B(PG8_SB(0, 1), b2, 1); PG8_STAGE_A(PG8_SA(0, 0), a2, 0, last);
            PG8_WAIT_V(8); PG8_WAIT_L(0); PG8_BAR; PG8_MMA(1, 0, At, B0); PG8_MMA(1, 1, At, B1); PG8_BAR; PG8_SCHED;
            PG8_LDB(B0, 1, 0); PG8_LDB(B1, 1, 1); PG8_SCHED; PG8_LDA(At, 1, 0); PG8_STAGE_A(PG8_SA(0, 1), a2, 1, last);
            PG8_WAIT_V(8); PG8_WAIT_L(0); PG8_BAR; PG8_MMA(0, 0, At, B0); PG8_MMA(0, 1, At, B1); PG8_BAR; PG8_SCHED;
            PG8_LDA(At, 1, 1); PG8_STAGE_B(PG8_SB(1, 0), b3, 0); PG8_STAGE_B(PG8_SB(1, 1), b3, 1); PG8_STAGE_A(PG8_SA(1, 0), a3, 0, last);
            PG8_WAIT_V(8); PG8_WAIT_L(0); PG8_BAR; PG8_MMA(1, 0, At, B0); PG8_MMA(1, 1, At, B1); PG8_BAR; PG8_SCHED;
            } else {
            PG8_LDB(B0, 0, 0); PG8_SCHED; PG8_LDA(At, 0, 0); PG8_STAGE(PG8_SA(1, 1), a1 + hstep, voffA);
            PG8_WAIT_L(8); PG8_BAR; PG8_WAIT_L(0); PG8_MMA(0, 0, At, B0); PG8_BAR; PG8_SCHED;
            PG8_LDB(B1, 0, 1); PG8_STAGE(PG8_SB(0, 0), b2, voffB);
            PG8_BAR; PG8_WAIT_L(0); PG8_MMA(0, 1, At, B1); PG8_BAR;
            PG8_LDA(At, 0, 1); PG8_STAGE(PG8_SA(0, 0), a2, voffA);
            PG8_BAR; PG8_WAIT_L(0); PG8_MMA(1, 0, At, B0); PG8_BAR; PG8_SCHED;
            PG8_STAGE(PG8_SB(0, 1), b2 + hstep, voffB);
            PG8_WAIT_V(6); PG8_BAR; PG8_MMA(1, 1, At, B1); PG8_BAR;
            PG8_LDB(B0, 1, 0); PG8_SCHED; PG8_LDA(At, 1, 0); PG8_STAGE(PG8_SA(0, 1), a2 + hstep, voffA);
            PG8_WAIT_L(8); PG8_BAR; PG8_WAIT_L(0); PG8_MMA(0, 0, At, B0); PG8_BAR; PG8_SCHED;
            PG8_LDB(B1, 1, 1); PG8_STAGE(PG8_SB(1, 0), b3, voffB);
            PG8_BAR; PG8_WAIT_L(0); PG8_MMA(0, 1, At, B1); PG8_BAR;
            PG8_LDA(At, 1, 1); PG8_STAGE(PG8_SA(1, 0), a3, voffA);
            PG8_BAR; PG8_WAIT_L(0); PG8_MMA(1, 0, At, B0); PG8_BAR; PG8_SCHED;
            PG8_STAGE(PG8_SB(1, 1), b3 + hstep, voffB);
            PG8_WAIT_V(6); PG8_BAR; PG8_MMA(1, 1, At, B1); PG8_BAR;
            }
        }
        if constexpr (ALIGN_EPI) { if (wr == 0) PG8_BAR; }
        if constexpr (FP8) { asm volatile("s_nop 15\n\ts_nop 15\n\ts_nop 15" ::: "memory"); PG8_SCHED; }
        E(acc, cur, wr, wc, fr, fq);
        if (!has_next) break;
#pragma unroll
        for (int a = 0; a < 2; ++a)
#pragma unroll
            for (int b = 0; b < 2; ++b)
#pragma unroll
                for (int m = 0; m < 4; ++m)
#pragma unroll
                    for (int n = 0; n < 2; ++n) acc[a][b][m][n] = (f32x4){0.f, 0.f, 0.f, 0.f};
        cur = nxt; cA = nA; cB = nB; ++ui;
        if constexpr (GATHER) {
#pragma unroll
            for (int h_ = 0; h_ < 2; ++h_)
#pragma unroll
                for (int i_ = 0; i_ < 2; ++i_) gC[h_][i_] = gN[h_][i_]; }
        if constexpr (ALIGN_EPI) { if (wr == 1) PG8_BAR; }
    }
    PG8_WAIT_V(0);
    if constexpr (!ALIGN_EPI) { if (wr == 0) PG8_BAR; }
    PG8_BAR;
#undef PG8_SA
#undef PG8_SB
#undef PG8_STAGE
#undef PG8_STAGE_A
#undef PG8_STAGE_B
#undef PG8_GISSUE
#undef PG8_GCONV
#undef PG8_LDA
#undef PG8_LDB
#undef PG8_MMA
#undef PG8_LOH
#undef PG8_HIH
#undef PG8_LD16
#undef PG8_WAIT_V
#undef PG8_WAIT_L
#undef PG8_BAR
#undef PG8_SCHED
}
}

constexpr float QSCALE = 0.088388347648318440f * 1.4426950408889634f;

namespace attn8 {
using bf16 = __hip_bfloat16;
constexpr int NW = 8, QBLK = 32, KVBLK = 64, LDO = DM;
constexpr int LDQB = QW, LDKB = KVW;
constexpr float YS = 8.f, Y0 = 56.f;
constexpr float THRY = Y0 + 8.f * YS;
constexpr int SLOT = 8192, NKS = 2, NVS = 4;
constexpr int LDS_KR = 0, LDS_VR = NKS * SLOT, LDS_WS = (NKS + NVS) * SLOT, SHM_ATTN = LDS_WS + NW * 256;
constexpr int LDS_BG = SHM_ATTN, BGT = 16384, BG_TILES = 48, BG_LAG = 4;
using f32x16 = __attribute__((ext_vector_type(16))) float;
using f32x8 = __attribute__((ext_vector_type(8))) float;
using u32x4g = __attribute__((ext_vector_type(4))) unsigned;
typedef __attribute__((address_space(3))) const char* lds_cptr;
#define SBAR() __builtin_amdgcn_sched_barrier(0)
__device__ __forceinline__ int crow(int r, int hi) { return (r & 3) + 8 * (r >> 2) + 4 * hi; }
__device__ __forceinline__ i32x8_t ld32(lds_cptr p0, lds_cptr p1) { return __builtin_shufflevector(*(const LAS i32x4_t*)p0, *(const LAS i32x4_t*)p1, 0, 1, 2, 3, 4, 5, 6, 7); }
__device__ __forceinline__ void mfma8_init(f32x16& d, const i32x8_t& a, const i32x8_t& b, const f32x16& c) { asm volatile("v_mfma_f32_32x32x64_f8f6f4 %0, %1, %2, %3" : "=&v"(d) : "v"(a), "v"(b), "v"(c)); }
__device__ __forceinline__ void mfma8_acc(f32x16& d, const i32x8_t& a, const i32x8_t& b) { asm volatile("v_mfma_f32_32x32x64_f8f6f4 %0, %1, %2, %0" : "+v"(d) : "v"(a), "v"(b)); }
__device__ __forceinline__ void mfma8_acc_pad(f32x16& d, const i32x8_t& a, const i32x8_t& b) { asm volatile("s_nop 3\n\tv_mfma_f32_32x32x64_f8f6f4 %0, %1, %2, %0" : "+v"(d) : "v"(a), "v"(b)); }
#define PK8(P, B) __builtin_amdgcn_cvt_pk_u8_f32(P[B + 3], 3u, __builtin_amdgcn_cvt_pk_u8_f32(P[B + 2], 2u, __builtin_amdgcn_cvt_pk_u8_f32(P[B + 1], 1u, __builtin_amdgcn_cvt_pk_u8_f32(P[B], 0u, 0u))))

template <bool BG>
__device__ __forceinline__ void attn_body(const unsigned char* __restrict__ Q8, const unsigned char* __restrict__ K8, const unsigned char* __restrict__ V8T, bf16* __restrict__ Ob, int seq, char* lds,
    int bg_t0, const float* __restrict__ bg_wgu, const float* __restrict__ bg_wdn, unsigned char* __restrict__ bg_gu8, unsigned char* __restrict__ bg_dn8, unsigned char* __restrict__ bg_dump) {
  int tid = threadIdx.x; asm volatile("" : "+v"(tid));
  const int lane = tid & 63, r32 = lane & 31, hi = lane >> 5; const int wid = __builtin_amdgcn_readfirstlane(tid >> 6);
  const lds_cptr L3 = (lds_cptr)lds;
  float* ws = (float*)(lds + LDS_WS) + wid * 64; float* li_l = ws; float* al_l = ws + 32;
  const bool kvw = wid < 4;
  unsigned koff, voff;
  { const int row = (wid & 3) * 16 + (lane >> 3), c = (lane & 7) ^ ((row >> 1) & 7); koff = (unsigned)(row * LDKB + c * 16); }
  { const int d = (wid & 3) * 32 + (lane >> 2), c = (lane & 3) ^ ((d >> 2) & 3); voff = (unsigned)(d * SKV + c * 16); }
  const unsigned pdst = (unsigned)(wid & 3) * 2048u;
#define DMA_PIECE(p, t, kslot, vslot) do { if (kvw) { \
    if ((p) == 0) { const char* sb_ = (const char*)K8 + (size_t)(t) * (KVBLK * LDKB); asm volatile("" : "+s"(sb_)); \
      __builtin_amdgcn_global_load_lds((const unsigned*)(sb_ + koff), (LAS unsigned*)((LAS unsigned char*)lds + LDS_KR + (kslot) * SLOT + pdst), 16, 0, 0); \
      __builtin_amdgcn_global_load_lds((const unsigned*)(sb_ + ((koff ^ 64u) + 8u * LDKB)), (LAS unsigned*)((LAS unsigned char*)lds + LDS_KR + (kslot) * SLOT + pdst + 1024u), 16, 0, 0); } \
    if ((p) == 1) { const char* sb_ = (const char*)V8T + (size_t)(t) * KVBLK; asm volatile("" : "+s"(sb_)); \
      __builtin_amdgcn_global_load_lds((const unsigned*)(sb_ + voff), (LAS unsigned*)((LAS unsigned char*)lds + LDS_VR + (vslot) * SLOT + pdst), 16, 0, 0); \
      __builtin_amdgcn_global_load_lds((const unsigned*)(sb_ + (voff + 16u * SKV)), (LAS unsigned*)((LAS unsigned char*)lds + LDS_VR + (vslot) * SLOT + pdst + 1024u), 16, 0, 0); } } } while (0)
#define DMA_ALL(t, kslot, vslot) do { DMA_PIECE(0, t, kslot, vslot); DMA_PIECE(1, t, kslot, vslot); } while (0)
  int ka[4], va[2];
#pragma unroll
  for (int q = 0; q < 4; ++q) ka[q] = LDS_KR + r32 * 128 + ((((q >> 1) * 4 + 2 * hi + (q & 1)) ^ ((r32 >> 1) & 7)) << 4);
#pragma unroll
  for (int i = 0; i < 2; ++i) va[i] = LDS_VR + r32 * 64 + (((2 * hi + i) ^ ((r32 >> 2) & 3)) << 4);
  const int NT = seq / KVBLK;
  DMA_ALL(0, 0, 0); DMA_ALL(1, 1, 1);
  i32x8_t q8[2];
  { const unsigned char* qp = Q8 + (size_t)(wid * QBLK + r32) * LDQB + 32 * hi;
    q8[0] = __builtin_shufflevector(*(const i32x4_t*)qp, *(const i32x4_t*)(qp + 16), 0, 1, 2, 3, 4, 5, 6, 7);
    q8[1] = __builtin_shufflevector(*(const i32x4_t*)(qp + 64), *(const i32x4_t*)(qp + 80), 0, 1, 2, 3, 4, 5, 6, 7); }
  float m_reg = 0.f; f32x16 o[4]; f32x16 lacc; f32x16 negm; f32x16 pA0, pA1, pB0, pB1; i32x8_t p8;
  const i32x8_t ones8 = {0x38383838, 0x38383838, 0x38383838, 0x38383838, 0x38383838, 0x38383838, 0x38383838, 0x38383838};
  asm volatile("s_waitcnt vmcnt(0) lgkmcnt(0)\n\ts_barrier" ::: "memory");
  { float y0 = Y0; asm volatile("" : "+v"(y0));
#pragma unroll
    for (int r = 0; r < 16; ++r) negm[r] = y0; }
  lacc = (f32x16){}; o[0] = (f32x16){}; o[1] = (f32x16){}; o[2] = (f32x16){}; o[3] = (f32x16){};
#define KFR(kbase, kh, s) ld32(L3 + (kbase) + ka[2 * (s)] + (kh) * 4096, L3 + (kbase) + ka[2 * (s) + 1] + (kh) * 4096)
#define VFR(vbase, db) ld32(L3 + (vbase) + va[0] + (db) * 2048, L3 + (vbase) + va[1] + (db) * 2048)
#define QK_TILE(C0, C1, kbase) do { const i32x8_t k00 = KFR(kbase, 0, 0), k01 = KFR(kbase, 0, 1), k10 = KFR(kbase, 1, 0), k11 = KFR(kbase, 1, 1); \
    mfma8_init(C0, k00, q8[0], negm); mfma8_acc(C0, k01, q8[1]); mfma8_init(C1, k10, q8[0], negm); mfma8_acc(C1, k11, q8[1]); } while (0)
#define ROWMAX_A(C0) float rm_ = fmaxf(C0[0], C0[1]); _Pragma("unroll") for (int r = 2; r < 16; ++r) rm_ = fmaxf(rm_, C0[r]);
#define ROWMAX_B(C1) _Pragma("unroll") for (int r = 0; r < 16; ++r) rm_ = fmaxf(rm_, C1[r]); \
    { auto rr = __builtin_amdgcn_permlane32_swap(__float_as_uint(rm_), __float_as_uint(rm_), false, false); rm_ = fmaxf(__uint_as_float(rr[0]), __uint_as_float(rr[1])); }
#define DECIDE(C0, C1, FIRST) do { if ((FIRST) || __builtin_expect(__any(rm_ > THRY), 0)) { const float dl = (FIRST) ? rm_ - Y0 : fmaxf(rm_ - Y0, 0.f); m_reg += dl; \
      _Pragma("unroll") for (int r = 0; r < 16; ++r) { C0[r] -= dl; C1[r] -= dl; } \
      _Pragma("unroll") for (int r = 0; r < 16; ++r) negm[r] = Y0 - m_reg; \
      if (!(FIRST)) { const float f = __builtin_amdgcn_exp2f(dl * (-1.0f / YS)); if (hi == 0) al_l[r32] = f; asm volatile("s_nop 15\n\ts_nop 15\n\ts_nop 15\n\ts_nop 15\n\ts_nop 15\n\ts_nop 15\n\ts_waitcnt lgkmcnt(0)" ::: "memory"); \
        _Pragma("unroll") for (int r = 0; r < 16; ++r) { const float fr_ = al_l[crow(r, hi)]; o[0][r] *= fr_; o[1][r] *= fr_; o[2][r] *= fr_; o[3][r] *= fr_; lacc[r] *= fr_; } } } } while (0)
#define FINISH(P0, P1) do { \
    p8[0] = PK8(P0, 0); p8[1] = PK8(P0, 4); p8[2] = PK8(P0, 8); p8[3] = PK8(P0, 12); p8[4] = PK8(P1, 0); p8[5] = PK8(P1, 4); p8[6] = PK8(P1, 8); p8[7] = PK8(P1, 12); } while (0)
#define PV_TILE(vbase) do { const i32x8_t v0_ = VFR(vbase, 0), v1_ = VFR(vbase, 1), v2_ = VFR(vbase, 2), v3_ = VFR(vbase, 3); \
    mfma8_acc_pad(o[0], p8, v0_); mfma8_acc(o[1], p8, v1_); mfma8_acc(o[2], p8, v2_); mfma8_acc(o[3], p8, v3_); mfma8_acc(lacc, p8, ones8); } while (0)
#define ITER_(C0, C1, P0, P1, KS, jj, TBAR, HOOK0, HOOK, RD, PF) do { const int vprev_ = (((jj) - 1) & 3) * SLOT; const int tn_ = (jj) + 2 < NT ? (jj) + 2 : NT - 1; const int vs2_ = ((jj) + 2) & 3; \
    if (RD) { kf0 = KFR((KS) * SLOT, 0, 0); kf1 = KFR((KS) * SLOT, 0, 1); } \
    const i32x8_t k10 = KFR((KS) * SLOT, 1, 0), k11 = KFR((KS) * SLOT, 1, 1); \
    mfma8_init(C0, kf0, q8[0], negm); p8[0] = PK8(P0, 0); p8[1] = PK8(P0, 4); SBAR(); \
    mfma8_acc(C0, kf1, q8[1]); p8[2] = PK8(P0, 8); p8[3] = PK8(P0, 12); SBAR(); \
    mfma8_init(C1, k10, q8[0], negm); p8[4] = PK8(P1, 0); p8[5] = PK8(P1, 4); SBAR(); \
    mfma8_acc(C1, k11, q8[1]); p8[6] = PK8(P1, 8); p8[7] = PK8(P1, 12); SBAR(); \
    TBAR; \
    i32x8_t va_ = VFR(vprev_, 0), vb_ = VFR(vprev_, 1); \
    mfma8_acc_pad(o[0], p8, va_); asm volatile("s_nop 7" ::: "memory"); ROWMAX_A(C0); SBAR(); \
    mfma8_acc(o[1], p8, vb_); va_ = VFR(vprev_, 2); vb_ = VFR(vprev_, 3); ROWMAX_B(C1); SBAR(); \
    mfma8_acc(o[2], p8, va_); DMA_PIECE(0, tn_, KS, vs2_); DMA_PIECE(1, tn_, KS, vs2_); SBAR(); \
    mfma8_acc(o[3], p8, vb_); SBAR(); f32x8 bgw; HOOK0; \
    mfma8_acc(lacc, p8, ones8); if (PF) { kf0 = KFR((1 - (KS)) * SLOT, 0, 0); kf1 = KFR((1 - (KS)) * SLOT, 0, 1); } SBAR(); HOOK; \
    DECIDE(C0, C1, false); SBAR(); } while (0)
#define TB0 asm volatile("s_waitcnt vmcnt(0)\n\ts_barrier" ::: "memory")
#define TBK do { if (kvw) asm volatile("s_waitcnt vmcnt(0)" ::: "memory"); asm volatile("s_barrier" ::: "memory"); } while (0)
#define NOHOOK do { } while (0)
#define ITER(C0, C1, P0, P1, KS, jj) ITER_(C0, C1, P0, P1, KS, jj, TB0, NOHOOK, NOHOOK, 0, 1)
  int bg_k = 0, bq = 0, bg_nsh = 12; const char* bg_src = (const char*)bg_wgu; unsigned char* bg_dst = bg_dump; unsigned bgo0 = 0u, bgo1 = 0u;
#define BG_DECODE_SRC(tt) do { int t_ = (tt); \
    if (t_ < 16384) { const int e_ = t_ >> 9, nb_ = (t_ >> 4) & 31, kb_ = t_ & 15; bg_src = (const char*)(bg_wgu + (size_t)e_ * (DM * 2048) + (size_t)kb_ * (64 * 2048) + nb_ * 64); bg_nsh = 13; } \
    else { t_ -= 16384; const int e_ = t_ >> 8, nb_ = (t_ >> 4) & 15, kb_ = t_ & 15; bg_src = (const char*)(bg_wdn + (size_t)e_ * (DFF * DM) + (size_t)kb_ * (64 * 1024) + nb_ * 64); bg_nsh = 12; } } while (0)
#define BG_DECODE_DST(tt) do { int t_ = (tt); \
    if (t_ < 16384) { const int e_ = t_ >> 9, nb_ = (t_ >> 4) & 31, kb_ = t_ & 15; bg_dst = bg_gu8 + (size_t)e_ * (2048 * DM) + (size_t)(256 * ((nb_ & 15) >> 1) + 128 * (nb_ >> 4) + 64 * (nb_ & 1)) * 1024 + kb_ * 64; } \
    else { t_ -= 16384; const int e_ = t_ >> 8, nb_ = (t_ >> 4) & 15, kb_ = t_ & 15; bg_dst = bg_dn8 + (size_t)e_ * (DM * DFF) + (size_t)(nb_ * 64) * 1024 + kb_ * 64; } } while (0)
#define BG_LOADH(H) do { if (!kvw) { \
    if ((H) == 0) asm volatile("s_waitcnt vmcnt(%0)" :: "n"(5 * (BG_LAG - 1)) : "memory"); \
    int ln_ = __builtin_amdgcn_mbcnt_hi(~0u, __builtin_amdgcn_mbcnt_lo(~0u, 0u)); asm volatile("" : "+v"(ln_)); \
    const LAS float* cp_ = (const LAS float*)((LAS unsigned char*)lds + LDS_BG + bq * BGT + (wid - 4) * 4096 + (H) * 2048) + ln_; \
    _Pragma("unroll") for (int r_ = 0; r_ < 8; ++r_) bgw[r_] = cp_[r_ * 64]; } else { asm volatile("" : "=v"(bgw)); } SBAR(); } while (0)
#define BG_CONV1() do { if (!kvw) { const f32x8 ws_ = bgw * WSCALE; bgo0 = pk4_fp8(ws_[0], ws_[1], ws_[2], ws_[3]); bgo1 = pk4_fp8(ws_[4], ws_[5], ws_[6], ws_[7]); } \
    else { asm volatile("" : "=v"(bgo0), "=v"(bgo1)); } SBAR(); } while (0)
#define BG_CONV2() do { if (!kvw) { \
    const int c_ = bg_k - BG_LAG; if (c_ < 0) bg_dst = bg_dump; else if ((c_ & 15) == 0) BG_DECODE_DST(bg_t0 + c_); else bg_dst += 64; \
    int ln_ = __builtin_amdgcn_mbcnt_hi(~0u, __builtin_amdgcn_mbcnt_lo(~0u, 0u)); asm volatile("" : "+v"(ln_)); \
    const f32x8 ws_ = bgw * WSCALE; u32x4g o_; o_.x = bgo0; o_.y = bgo1; o_.z = pk4_fp8(ws_[0], ws_[1], ws_[2], ws_[3]); o_.w = pk4_fp8(ws_[4], ws_[5], ws_[6], ws_[7]); \
    __builtin_nontemporal_store(o_, (u32x4g*)(bg_dst + (unsigned)(ln_ * 1024 + (wid - 4) * 16))); } SBAR(); } while (0)
#define BG_DMA() do { if (!kvw) { \
    if (bg_k < BG_TILES) { if ((bg_k & 15) == 0) BG_DECODE_SRC(bg_t0 + bg_k); else bg_src += (64u << bg_nsh); } \
    int ln_ = __builtin_amdgcn_mbcnt_hi(~0u, __builtin_amdgcn_mbcnt_lo(~0u, 0u)); asm volatile("" : "+v"(ln_)); \
    const unsigned so_ = ((unsigned)((wid - 4) * 16 + (ln_ >> 4)) << bg_nsh) + (unsigned)(ln_ & 15) * 16u; \
    LAS unsigned char* lb_ = (LAS unsigned char*)lds + LDS_BG + bq * BGT + (wid - 4) * 4096; \
    __builtin_amdgcn_global_load_lds((const unsigned*)(bg_src + so_), (LAS unsigned*)lb_, 16, 0, 2); \
    __builtin_amdgcn_global_load_lds((const unsigned*)(bg_src + so_ + (4u << bg_nsh)), (LAS unsigned*)(lb_ + 1024), 16, 0, 2); \
    __builtin_amdgcn_global_load_lds((const unsigned*)(bg_src + so_ + (8u << bg_nsh)), (LAS unsigned*)(lb_ + 2048), 16, 0, 2); \
    __builtin_amdgcn_global_load_lds((const unsigned*)(bg_src + so_ + (12u << bg_nsh)), (LAS unsigned*)(lb_ + 3072), 16, 0, 2); } \
    bq = bq == BG_LAG - 1 ? 0 : bq + 1; ++bg_k; SBAR(); } while (0)
#define ITER_BGA(C0, C1, P0, P1, KS, jj) ITER_(C0, C1, P0, P1, KS, jj, TBK, BG_LOADH(0), BG_CONV1(), 0, 0)
#define ITER_BGA2(C0, C1, P0, P1, KS, jj) ITER_(C0, C1, P0, P1, KS, jj, TBK, BG_LOADH(1), BG_CONV2(), 1, 0)
#define ITER_BGB(C0, C1, P0, P1, KS, jj) ITER_(C0, C1, P0, P1, KS, jj, TBK, BG_DMA(), NOHOOK, 1, 1)
#define ITER_BGP(C0, C1, P0, P1, KS, jj) ITER_(C0, C1, P0, P1, KS, jj, TBK, NOHOOK, NOHOOK, 0, 1)
  i32x8_t kf0, kf1;

  QK_TILE(pA0, pA1, 0);
  { asm volatile("s_nop 15\n\ts_nop 15" ::: "memory"); SBAR(); ROWMAX_A(pA0); ROWMAX_B(pA1); DECIDE(pA0, pA1, true); }
  kf0 = KFR(SLOT, 0, 0); kf1 = KFR(SLOT, 0, 1);
  asm volatile("s_waitcnt vmcnt(0)\n\ts_barrier" ::: "memory");
  DMA_ALL(2, 0, 2);
  int j = 1;
  if constexpr (BG) {
    for (; j < 1 + 4 * (BG_TILES + BG_LAG); j += 4) { ITER_BGA(pB0, pB1, pA0, pA1, 1, j); ITER_BGA2(pA0, pA1, pB0, pB1, 0, j + 1); ITER_BGB(pB0, pB1, pA0, pA1, 1, j + 2); ITER_BGP(pA0, pA1, pB0, pB1, 0, j + 3); }
  }
  for (; j + 1 < NT; j += 2) { ITER(pB0, pB1, pA0, pA1, 1, j); ITER(pA0, pA1, pB0, pB1, 0, j + 1); }
  ITER(pB0, pB1, pA0, pA1, 1, j);
  FINISH(pB0, pB1); SBAR();
  PV_TILE(((NT - 1) & 3) * SLOT);
  asm volatile("s_nop 15\n\ts_nop 15" ::: "memory"); SBAR();
  asm volatile("s_nop 15\n\ts_nop 15\n\ts_nop 15\n\ts_nop 15" ::: "memory"); SBAR();
  float rli[16];
#pragma unroll
  for (int r = 0; r < 16; ++r) rli[r] = __builtin_amdgcn_rcpf(lacc[r]);
  { int tid2 = threadIdx.x; asm volatile("" : "+v"(tid2));
    const int hi2 = (tid2 >> 5) & 1; bf16* Ow = Ob + (size_t)((tid2 >> 6) * QBLK) * LDO + (tid2 & 31);
#pragma unroll
    for (int r = 0; r < 16; ++r) { const int orow = crow(r, hi2);
#pragma unroll
      for (int d0 = 0; d0 < 4; ++d0) Ow[(long)orow * LDO + d0 * 32] = __float2bfloat16(o[d0][r] * rli[r]); } }
  asm volatile("s_waitcnt vmcnt(0) lgkmcnt(0)\n\ts_barrier" ::: "memory");
#undef DMA_PIECE
#undef DMA_ALL
#undef KFR
#undef VFR
#undef QK_TILE
#undef ROWMAX_A
#undef ROWMAX_B
#undef DECIDE
#undef FINISH
#undef PV_TILE
#undef ITER
#undef ITER_
#undef ITER_BGA
#undef ITER_BGB
#undef ITER_BGP
#undef TB0
#undef TBK
#undef BG_DMA
#undef BG_DECODE_SRC
#undef BG_DECODE_DST
#undef BG_LOADH
#undef BG_CONV1
#undef BG_CONV2
#undef ITER_BGA2
#undef NOHOOK
}
#undef PK8
#undef SBAR
}

#define XB_TMO      128
#define XB_XCNT(j)  (256  + 64 * (j))
#define XB_XSUB(j)  (1280 + 64 * (j))
#define XB_XGEN(j)  (2304 + 64 * (j))
#define XB_TOP      3328
#define XB_TOPGEN   3392
#define XCD_BAR_WORDS 3456
#define XB_SPIN_CAP (1u << 18)
__device__ __forceinline__ unsigned xb_ld(unsigned* p)              { return __hip_atomic_load(p, __ATOMIC_RELAXED, __HIP_MEMORY_SCOPE_AGENT); }
__device__ __forceinline__ unsigned xb_add(unsigned* p, unsigned v) { return __hip_atomic_fetch_add(p, v, __ATOMIC_RELAXED, __HIP_MEMORY_SCOPE_AGENT); }
__device__ __forceinline__ unsigned xb_xcc_id() { return (unsigned)__builtin_amdgcn_s_getreg((3 << 11) | 20) & 0xFu; }
#define XB_SPIN(cond, bar) do { unsigned _sp = 0; while (cond) { __builtin_amdgcn_s_sleep(1); \
    if ((++_sp & 255u) == 0u) { if (xb_ld(&(bar)[XB_TMO])) break; if (_sp > XB_SPIN_CAP) { atomicAdd(&(bar)[XB_TMO], 1u); break; } } } } while (0)
struct XcdBarrier { unsigned* bar; unsigned x; volatile LAS unsigned* st; };
__device__ __forceinline__ XcdBarrier xcd_barrier_post(unsigned* bar, volatile LAS unsigned* st) {
    XcdBarrier b; b.bar = bar; b.x = xb_xcc_id(); b.st = st;
    if (threadIdx.x == 0) (void)xb_add(&bar[XB_XCNT(b.x)], 1u);
    return b;
}
__device__ __forceinline__ void xcd_barrier_complete(unsigned* bar, unsigned x, unsigned& nloc, unsigned& nx) {
    const unsigned G = gridDim.x * gridDim.y * gridDim.z;
    unsigned sum, cnt, mine, sp = 0u;
    for (;;) {
        sum = 0u; cnt = 0u; mine = 0u;
#pragma unroll
        for (unsigned j = 0; j < 16; ++j) { const unsigned c = xb_ld(&bar[XB_XCNT(j)]); sum += c; cnt += (c > 0u) ? 1u : 0u; mine = (j == x) ? c : mine; }
        if (sum == G) break;
        __builtin_amdgcn_s_sleep(1);
        if ((++sp & 255u) == 0u) { if (xb_ld(&bar[XB_TMO])) break; if (sp > XB_SPIN_CAP) { atomicAdd(&bar[XB_TMO], 1u); break; } }
    }
    nloc = mine > 0u ? mine : 1u; nx = cnt > 0u ? cnt : 1u;
}
__device__ __forceinline__ void xcd_barrier(const XcdBarrier& b) {
    asm volatile("s_waitcnt vmcnt(0)" ::: "memory");
    __syncthreads();
    if (threadIdx.x == 0) {
        unsigned* bar = b.bar;
        __builtin_amdgcn_s_waitcnt(0);
        unsigned nloc = b.st[0], nx = b.st[1];
        if (nloc == 0u) { xcd_barrier_complete(bar, b.x, nloc, nx); b.st[0] = nloc; b.st[1] = nx; }
        const unsigned old = xb_add(&bar[XB_XSUB(b.x)], 1u);
        const unsigned gen = old / nloc;
        if (old + 1u == (gen + 1u) * nloc) {
            __builtin_amdgcn_fence(__ATOMIC_RELEASE, "agent");
            asm volatile("s_waitcnt vmcnt(0)" ::: "memory");
            const unsigned og = xb_add(&bar[XB_TOP], 1u);
            const unsigned tg = og / nx;
            if (og + 1u == (tg + 1u) * nx) xb_add(&bar[XB_TOPGEN], 1u);
            else XB_SPIN(xb_ld(&bar[XB_TOPGEN]) == tg, bar);
            __builtin_amdgcn_fence(__ATOMIC_ACQUIRE, "agent");
            xb_add(&bar[XB_XGEN(b.x)], 1u);
            asm volatile("s_waitcnt vmcnt(0)" ::: "memory");
        } else {
            XB_SPIN(xb_ld(&bar[XB_XGEN(b.x)]) == gen, bar);
            __builtin_amdgcn_fence(__ATOMIC_ACQUIRE, "agent");
            asm volatile("s_waitcnt vmcnt(0)" ::: "memory");
        }
    }
    __syncthreads();
}

struct Args { const float* in[20]; float* out; unsigned char* ws; int ph_lo, ph_hi, li, pad; };
enum { I_X = 0, I_C, I_CTX, I_CCTX, I_WADA, I_BADA, I_G1, I_G2, I_WIN, I_GQ, I_GK, I_WCONV, I_WOUT, I_WR, I_BR, I_WGU, I_BGU, I_WDN, I_BDN, I_GF };

__device__ __forceinline__ void transpose_item64(const float* W, int ldw, bf16_t* WT, int Kd, int k0, int n0, int drow0, LAS float* scr, int lane) {
    const float* src = W + (size_t)k0 * ldw + n0 + lane;
    float v[64];
#pragma unroll
    for (int kk = 0; kk < 64; ++kk) v[kk] = src[(size_t)kk * ldw];
#pragma unroll
    for (int kk = 0; kk < 64; ++kk) scr[kk * 65 + lane] = v[kk];
    asm volatile("s_waitcnt lgkmcnt(0)" ::: "memory");
    const int c = lane & 7;
#pragma unroll
    for (int j = 0; j < 8; ++j) { const int n = (lane >> 3) + 8 * j; const LAS float* s = scr + (8 * c) * 65 + n;
        u32x4 o; o.x = cvt_pk_bf16(s[0 * 65], s[1 * 65]); o.y = cvt_pk_bf16(s[2 * 65], s[3 * 65]); o.z = cvt_pk_bf16(s[4 * 65], s[5 * 65]); o.w = cvt_pk_bf16(s[6 * 65], s[7 * 65]);
        *(GAS u32x4*)(WT + (size_t)(drow0 + n) * Kd + k0 + 8 * c) = o; }
    asm volatile("s_waitcnt lgkmcnt(0)" ::: "memory");
}
__device__ __forceinline__ void transpose_item64_f8(const float* W, int ldw, unsigned char* WT, int Kd, int k0, int n0, int drow0, float sc, LAS float* scr, int lane) {
    const float* src = W + (size_t)k0 * ldw + n0 + lane;
    float v[64];
#pragma unroll
    for (int kk = 0; kk < 64; ++kk) v[kk] = src[(size_t)kk * ldw];
#pragma unroll
    for (int kk = 0; kk < 64; ++kk) scr[kk * 65 + lane] = v[kk];
    asm volatile("s_waitcnt lgkmcnt(0)" ::: "memory");
    const int c = lane & 3;
#pragma unroll
    for (int j = 0; j < 4; ++j) { const int n = (lane >> 2) + 16 * j; const LAS float* sp = scr + (16 * c) * 65 + n;
        u32x4 o; o.x = pk4_fp8(sp[0 * 65] * sc, sp[1 * 65] * sc, sp[2 * 65] * sc, sp[3 * 65] * sc); o.y = pk4_fp8(sp[4 * 65] * sc, sp[5 * 65] * sc, sp[6 * 65] * sc, sp[7 * 65] * sc);
        o.z = pk4_fp8(sp[8 * 65] * sc, sp[9 * 65] * sc, sp[10 * 65] * sc, sp[11 * 65] * sc); o.w = pk4_fp8(sp[12 * 65] * sc, sp[13 * 65] * sc, sp[14 * 65] * sc, sp[15 * 65] * sc);
        *(GAS u32x4*)(WT + (size_t)(drow0 + n) * Kd + k0 + 16 * c) = o; }
    asm volatile("s_waitcnt lgkmcnt(0)" ::: "memory");
}
__device__ __forceinline__ int map_win(int n) { if (n < 1536) return n; if (n < 2048) { const int c = n - 1536; return 1536 + 256 * (c >> 7) + (c & 127); } const int c = n - 2048; return 1536 + 256 * (c >> 7) + 128 + (c & 127); }
__device__ __forceinline__ int map_gu(int n) { if (n < 1024) return 256 * (n >> 7) + (n & 127); const int c = n - 1024; return 256 * (c >> 7) + 128 + (c & 127); }

struct EpiQKV {
    static constexpr bool PERM = true; static constexpr int BMODE = 0;
    bf16_t *Q, *Kb, *Vb, *CB, *U; int pn0; float sc;
    __device__ __forceinline__ void operator()(const f32x4 (&acc)[2][2][4][2], const pg8::Unit& u, int wr, int wc, int fr, int fq) const {
        const int pn = u.pn + pn0, pm = u.pm, rloc = wr * 64 + fr, cl = wc * 32 + 8 * fq;
        if (pn >= 6) {
            bf16_t* base = U + (size_t)(pm * 256 + rloc) * CW + 128 * (pn - 6) + cl;
#pragma unroll
            for (int ai = 0; ai < 2; ++ai)
#pragma unroll
                for (int m = 0; m < 4; ++m) { const f32x4 v0 = acc[ai][0][m][0] * acc[ai][1][m][0], v1 = acc[ai][0][m][1] * acc[ai][1][m][1];
                    u32x4 w; w.x = cvt_pk_bf16(v0[0], v0[1]); w.y = cvt_pk_bf16(v0[2], v0[3]); w.z = cvt_pk_bf16(v1[0], v1[1]); w.w = cvt_pk_bf16(v1[2], v1[3]);
                    *(u32x4*)(base + (size_t)(ai * 128 + m * 16) * CW) = w; }
        } else {
            bf16_t* base; int ld;
            if (pn < 2) { base = Q + (size_t)(pm * 256) * QW + 256 * pn; ld = QW; }
            else if (pn < 4) { const int krow0 = pm < 128 ? (pm >> 6) * SKV + (pm & 63) * 256 : (pm - 128) * SKV + SEQ; base = (pn == 2 ? Kb : Vb) + (size_t)krow0 * KVW; ld = KVW; }
            else { base = CB + (size_t)(pm * 256) * CW + 256 * (pn - 4); ld = CW; }
            base += (size_t)rloc * ld + cl;
#pragma unroll
            for (int ai = 0; ai < 2; ++ai)
#pragma unroll
                for (int m = 0; m < 4; ++m)
#pragma unroll
                    for (int bj = 0; bj < 2; ++bj) { const f32x4 v0 = acc[ai][bj][m][0] * sc, v1 = acc[ai][bj][m][1] * sc;
                        u32x4 w; w.x = cvt_pk_bf16(v0[0], v0[1]); w.y = cvt_pk_bf16(v0[2], v0[3]); w.z = cvt_pk_bf16(v1[0], v1[1]); w.w = cvt_pk_bf16(v1[2], v1[3]);
                        *(u32x4*)(base + (size_t)(ai * 128 + m * 16) * ld + bj * 128) = w; }
        }
    }
};
struct QkvOrder {
    pg8::StaticOrder so;
    __device__ __forceinline__ bool next(int i, pg8::Unit& u) const {
        if (so.next(i, u)) return true;
        const long L = (long)i * so.G + so.c - so.nwg; if (L >= 4) return false;
        u.pm = 128 + (int)(L >> 1); u.pn = 2 + (int)(L & 1); u.e = 0; return true;
    }
};
struct EpiResid {
    static constexpr bool PERM = true; static constexpr int BMODE = 0;
    const float* gt; bf16_t* d1;
    __device__ __forceinline__ void operator()(const f32x4 (&acc)[2][2][4][2], const pg8::Unit& u, int wr, int wc, int fr, int fq) const {
        const int row0 = u.pm * 256 + wr * 64 + fr, col0 = u.pn * 256 + wc * 32 + 8 * fq, b = u.pm >> 6;
        f32x4 g[2][2];
#pragma unroll
        for (int bj = 0; bj < 2; ++bj)
#pragma unroll
            for (int n = 0; n < 2; ++n) g[bj][n] = *(const f32x4*)(gt + (size_t)b * NMOD + col0 + bj * 128 + n * 4);
#pragma unroll
        for (int ai = 0; ai < 2; ++ai)
#pragma unroll
            for (int m = 0; m < 4; ++m) { bf16_t* dp = d1 + (size_t)(row0 + ai * 128 + m * 16) * DM + col0;
#pragma unroll
                for (int bj = 0; bj < 2; ++bj) { const f32x4 v0 = g[bj][0] * acc[ai][bj][m][0], v1 = g[bj][1] * acc[ai][bj][m][1];
                    u32x4 w; w.x = cvt_pk_bf16(v0[0], v0[1]); w.y = cvt_pk_bf16(v0[2], v0[3]); w.z = cvt_pk_bf16(v1[0], v1[1]); w.w = cvt_pk_bf16(v1[2], v1[3]);
                    *(u32x4*)(dp + bj * 128) = w; } }
    }
};
struct EpiSwiglu {
    static constexpr bool PERM = true; static constexpr int BMODE = 0;
    const float* bgu; unsigned char* ACT;
    __device__ __forceinline__ void operator()(const f32x4 (&acc)[2][2][4][2], const pg8::Unit& u, int wr, int wc, int fr, int fq) const {
        const int cl = wc * 32 + 8 * fq, c0 = 128 * u.pn + cl;
        const float* bp = bgu + (size_t)u.e * 2048 + c0;
        f32x4 bg[2], bl[2];
#pragma unroll
        for (int n = 0; n < 2; ++n) { bg[n] = *(const f32x4*)(bp + 4 * n); bl[n] = *(const f32x4*)(bp + 1024 + 4 * n) + 1.0f; }
        unsigned char* base = ACT + (size_t)(u.pm * 256 + wr * 64 + fr) * DFF + c0;
#pragma unroll
        for (int ai = 0; ai < 2; ++ai)
#pragma unroll
            for (int m = 0; m < 4; ++m) { float o[8];
#pragma unroll
                for (int n = 0; n < 2; ++n)
#pragma unroll
                    for (int i = 0; i < 4; ++i) { float gv = acc[ai][0][m][n][i] * WINV + bg[n][i], lv = acc[ai][1][m][n][i] * WINV + bl[n][i];
                        gv = fminf(gv, 7.0f); lv = fminf(fmaxf(lv, -6.0f), 8.0f);
                        const float sg = __builtin_amdgcn_rcpf(1.0f + __builtin_amdgcn_exp2f(gv * (-1.702f * 1.4426950408889634f)));
                        o[n * 4 + i] = gv * sg * lv; }
                u32x2 w; w.x = pk4_fp8(o[0], o[1], o[2], o[3]); w.y = pk4_fp8(o[4], o[5], o[6], o[7]);
                *(u32x2*)(base + (size_t)(ai * 128 + m * 16) * DFF) = w; }
    }
};
struct EpiDown {
    static constexpr bool PERM = true; static constexpr int BMODE = 1;
    const float* bd; const int* pinfo; const float* pgate; const unsigned* cnt; const LAS int* ts; unsigned char* YP;
    __device__ __forceinline__ void operator()(const f32x4 (&acc)[2][2][4][2], const pg8::Unit& u, int wr, int wc, int fr, int fq) const {
        const int c0 = 256 * u.pn + 64 * wc + 16 * fq, pos0 = (u.pm - ts[u.e]) * 256 + wr * 64 + fr, cn = (int)cnt[u.e];
        const float* bp = bd + (size_t)u.e * DM + c0;
        int dd[2][4]; float gg[2][4];
#pragma unroll
        for (int ai = 0; ai < 2; ++ai)
#pragma unroll
            for (int m = 0; m < 4; ++m) { const int pos = pos0 + ai * 128 + m * 16; const bool ok = pos < cn; const size_t ix = (size_t)u.e * NTOK + (ok ? pos : 0);
                const int di = pinfo[ix]; const float gi = pgate[ix]; dd[ai][m] = ok ? di : -1; gg[ai][m] = gi; }
        f32x4 bv[2][2];
#pragma unroll
        for (int bj = 0; bj < 2; ++bj)
#pragma unroll
            for (int n = 0; n < 2; ++n) bv[bj][n] = *(const f32x4*)(bp + 8 * bj + 4 * n);
#pragma unroll
        for (int ai = 0; ai < 2; ++ai)
#pragma unroll
            for (int m = 0; m < 4; ++m) { const int d = dd[ai][m]; const float gt = gg[ai][m];
                if (d >= 0) { u32x4 w;
                    { const f32x4 v0 = (acc[ai][0][m][0] * WINV + bv[0][0]) * gt, v1 = (acc[ai][0][m][1] * WINV + bv[0][1]) * gt; w.x = pk4_fp8(v0[0], v0[1], v0[2], v0[3]); w.y = pk4_fp8(v1[0], v1[1], v1[2], v1[3]); }
                    { const f32x4 v0 = (acc[ai][1][m][0] * WINV + bv[1][0]) * gt, v1 = (acc[ai][1][m][1] * WINV + bv[1][1]) * gt; w.z = pk4_fp8(v0[0], v0[1], v0[2], v0[3]); w.w = pk4_fp8(v1[0], v1[1], v1[2], v1[3]); }
                    *(u32x4*)(YP + (size_t)d * DM + c0) = w; } }
    }
};
struct MoeOrder {
    pg8::StaticOrder so; const LAS int* te;
    __device__ __forceinline__ bool next(int i, pg8::Unit& u) const {
        if (!so.next(i, u)) return false;
        u.e = __builtin_amdgcn_readfirstlane(te[u.pm]); return true;
    }
};
__device__ __forceinline__ int moe_tables(const unsigned* cnt, LAS int* ts, LAS int* te) {
    __syncthreads();
    if (threadIdx.x == 0) { int s = 0; for (int e = 0; e < NEXP; ++e) { ts[e] = s; s += ((int)cnt[e] + 255) >> 8; } ts[NEXP] = s; }
    __syncthreads();
    const int T = ts[NEXP];
    for (int t = threadIdx.x; t < T; t += 512) { int e = 0; while (e < NEXP - 1 && t >= ts[e + 1]) ++e; te[t] = e; }
    __syncthreads();
    return T;
}

__global__ void __launch_bounds__(512, 2) fwd_kernel(Args args) {
    extern __shared__ __attribute__((aligned(16))) unsigned char lds[];
    LAS unsigned char* L = (LAS unsigned char*)lds;
    LAS unsigned* MISC = (LAS unsigned*)(L + MISC_OFF);
    const int wave = __builtin_amdgcn_readfirstlane(threadIdx.x >> 6);
#define PHASE_IDS int tid = threadIdx.x; asm volatile("" : "+v"(tid)); const int lane = tid & 63; (void)lane
    const int G = gridDim.x, bx = blockIdx.x;
    const int vcu = (G % 8 == 0) ? (bx % 8) * (G / 8) + bx / 8 : bx;
    const int gw = vcu * 8 + wave, NGW = G * 8;
    const bool bg_on = G * 2 * attn8::BG_TILES == NEXP * (16 * 32 + 16 * 16);
    unsigned char* ws = args.ws;
    unsigned* ctl = (unsigned*)(ws + WS_CTL);
    const float* x = args.in[I_X];
    float* mod = (float*)(ws + WS_MOD); float* rope = (float*)(ws + WS_ROPE); float* wrt = (float*)(ws + WS_WRT);
    unsigned char* WIN8 = ws + WS_WIN8; unsigned char* H8 = ws + WS_H8;
    bf16_t* WIN = (bf16_t*)(ws + WS_WIN); bf16_t* WOUT = (bf16_t*)(ws + WS_WOUT); unsigned char* WGU8 = ws + WS_WGU; unsigned char* WDN8 = ws + WS_WDN;
    bf16_t* Hb = (bf16_t*)(ws + WS_H); bf16_t* Qb = (bf16_t*)(ws + WS_Q); bf16_t* Kb = (bf16_t*)(ws + WS_K); bf16_t* Vb = (bf16_t*)(ws + WS_V);
    unsigned char* Q8 = ws + WS_Q8; unsigned char* K8 = ws + WS_K8; unsigned char* V8T = ws + WS_V8T;
    bf16_t* CBb = (bf16_t*)(ws + WS_CB); bf16_t* Ub = (bf16_t*)(ws + WS_U); bf16_t* MIX = (bf16_t*)(ws + WS_MIX);
    bf16_t* D1 = (bf16_t*)(ws + WS_X1); bf16_t* X1B = (bf16_t*)(ws + WS_X1 + 64 * MiB); unsigned char* H28 = ws + WS_H2;
    int* PINFO = (int*)(ws + WS_PINFO); float* PGATE = (float*)(ws + WS_PGATE);
    unsigned char* ACT8 = ws + WS_ACT; unsigned char* YP = ws + WS_YP;
    unsigned* cnt = ctl + CW_CNT;

    for (int u = threadIdx.x; u < (LDS_BYTES - MISC_OFF) / 4; u += 512) MISC[u] = 0u;
    __syncthreads();
    XcdBarrier bar; bar.bar = ctl + CW_BAR + args.li * XCD_BAR_WORDS; bar.x = 0; bar.st = nullptr;
#if !MK_PER_PHASE
    bar = xcd_barrier_post(ctl + CW_BAR + args.li * XCD_BAR_WORDS, (volatile LAS unsigned*)(MISC + MO_BAR / 4));
#endif
    const int lo = args.ph_lo, hi = args.ph_hi;
#define IN(k) (lo <= (k) && (k) < hi)
#if MK_PER_PHASE
#define SEAM(k) do { } while (0)
#else
#define SEAM(k) do { if (IN(k) && IN((k) + 1)) xcd_barrier(bar); } while (0)
#endif

    if (IN(0)) {
        PHASE_IDS;
        {
            LAS float* sv = (LAS float*)L;
            LAS float* red = sv + 3 * DM;
            const float* w_ada = args.in[I_WADA]; const float* b_ada = args.in[I_BADA];
            for (int item = bx; item < NMOD / 32; item += G) {
                __syncthreads();
                for (int i = tid; i < 3 * DM; i += 512) { const int j = i >> 10, k = i & 1023; const float cv = j < 2 ? args.in[I_C][j * DM + k] : args.in[I_CCTX][k];
                    sv[i] = cv / (1.0f + __expf(-cv)); }
                __syncthreads();
                const int c0 = item * 32, col = lane & 31, ks = lane >> 5;
                float a0 = 0.f, a1 = 0.f, a2 = 0.f;
                const float* wp = w_ada + (size_t)(wave * 128 + ks) * NMOD + c0 + col;
#pragma unroll 16
                for (int i = 0; i < 64; ++i) { const float wv = wp[(size_t)(2 * i) * NMOD]; const int k = wave * 128 + 2 * i + ks;
                    a0 += sv[k] * wv; a1 += sv[DM + k] * wv; a2 += sv[2 * DM + k] * wv; }
                a0 += __shfl_xor(a0, 32); a1 += __shfl_xor(a1, 32); a2 += __shfl_xor(a2, 32);
                if (lane < 32) { red[(wave * 3 + 0) * 32 + col] = a0; red[(wave * 3 + 1) * 32 + col] = a1; red[(wave * 3 + 2) * 32 + col] = a2; }
                __syncthreads();
                if (tid < 96) { const int j = tid >> 5, cc = tid & 31; float s = b_ada[c0 + cc];
#pragma unroll
                    for (int w = 0; w < 8; ++w) s += red[(w * 3 + j) * 32 + cc];
                    mod[(size_t)j * NMOD + c0 + cc] = s; }
            }
            __syncthreads();
        }
        for (int idx = vcu * 512 + tid; idx < 256 * 32; idx += G * 512) {
            const int pos = idx >> 5, i = idx & 31;
            const float invf = exp2f(-(float)(2 * i) * (13.287712379549449f / 64.0f));
            const float ang = (float)pos * invf;
            const double rev = (double)ang * 0.15915494309189535;
            const float fr_ = (float)(rev - rint(rev));
            rope[2 * idx] = __builtin_amdgcn_cosf(fr_); rope[2 * idx + 1] = __builtin_amdgcn_sinf(fr_);
        }
        for (int idx = vcu * 512 + tid; idx < NEXP * DM; idx += G * 512) { const int e = idx >> 10, k = idx & 1023; wrt[idx] = args.in[I_WR][k * NEXP + e]; }
        {
            LAS float* scr = (LAS float*)(L + wave * 16640);
            constexpr int I_IN = 16 * 40, I_OUT = 16 * 16, I_GU1 = 16 * 32, I_DN1 = 16 * 16;
            constexpr int NITEMS = I_IN + I_OUT + NEXP * I_GU1 + NEXP * I_DN1;
            const int nitems = bg_on ? I_IN + I_OUT : NITEMS;
            for (int it = gw; it < nitems; it += NGW) {
                int r = it;
                if (r < I_IN) { const int kb = r / 40, nb = r % 40; if (nb < 16) transpose_item64_f8(args.in[I_WIN], INC, WIN8, DM, 64 * kb, 64 * nb, 64 * nb, WSCALE, scr, lane);
                    else transpose_item64(args.in[I_WIN], INC, WIN, DM, 64 * kb, 64 * nb, map_win(64 * nb), scr, lane); continue; } r -= I_IN;
                if (r < I_OUT) { const int kb = r / 16, nb = r % 16; transpose_item64(args.in[I_WOUT], DM, WOUT, DM, 64 * kb, 64 * nb, 64 * nb, scr, lane); continue; } r -= I_OUT;
                if (r < NEXP * I_GU1) { const int e = r / I_GU1, q = r % I_GU1, kb = q / 32, nb = q % 32;
                    transpose_item64_f8(args.in[I_WGU] + (size_t)e * DM * 2048, 2048, WGU8 + (size_t)e * 2048 * DM, DM, 64 * kb, 64 * nb, map_gu(64 * nb), WSCALE, scr, lane); continue; } r -= NEXP * I_GU1;
                { const int e = r / I_DN1, q = r % I_DN1, kb = q / 16, nb = q % 16;
                    transpose_item64_f8(args.in[I_WDN] + (size_t)e * DFF * DM, DM, WDN8 + (size_t)e * DM * DFF, DFF, 64 * kb, 64 * nb, 64 * nb, WSCALE, scr, lane); }
            }
        }
    }
    SEAM(0);

    if (IN(1)) {
        PHASE_IDS;
        const float* g1 = args.in[I_G1];
        int curm = -1; f32x4 gs[4], sh[4];
        for (int r0 = gw * 2; r0 < MROWS; r0 += NGW * 2) {
            const int mb = r0 < NTOK ? (r0 >> 14) : 2;
            if (mb != curm) { curm = mb;
#pragma unroll
                for (int j = 0; j < 4; ++j) { const int c = 4 * lane + 256 * j; const f32x4 g = *(const f32x4*)(g1 + c), s = *(const f32x4*)(mod + (size_t)mb * NMOD + DM + c);
                    gs[j] = g * (s + 1.0f); sh[j] = *(const f32x4*)(mod + (size_t)mb * NMOD + c); } }
            f32x4 v[2][4]; float ss[2] = {0.f, 0.f};
#pragma unroll
            for (int q = 0; q < 2; ++q) { const int r = r0 + q;
                const float* src = r < NTOK ? x + (size_t)r * DM : args.in[I_CTX] + (size_t)(r - NTOK) * DM;
                const GAS f32x4* xr = (const GAS f32x4*)src + lane;
#pragma unroll
                for (int j = 0; j < 4; ++j) { v[q][j] = xr[64 * j]; ss[q] += (v[q][j].x * v[q][j].x + v[q][j].y * v[q][j].y) + (v[q][j].z * v[q][j].z + v[q][j].w * v[q][j].w); } }
#pragma unroll
            for (int q = 0; q < 2; ++q) { const int r = r0 + q;
                const float rstd = rsqrtf(wave_sum(ss[q]) * (1.f / DM) + NORM_EPS);
                GAS u32x2* o8 = (GAS u32x2*)(Hb + (size_t)r * DM) + lane;
                GAS unsigned* o4 = (GAS unsigned*)(H8 + (size_t)r * DM) + lane;
#pragma unroll
                for (int j = 0; j < 4; ++j) { const f32x4 y = v[q][j] * rstd * gs[j] + sh[j]; u32x2 w; w.x = cvt_pk_bf16(y.x, y.y); w.y = cvt_pk_bf16(y.z, y.w); o8[64 * j] = w; o4[64 * j] = pk4_fp8(y.x, y.y, y.z, y.w); } }
        }
    }
    SEAM(1);

    if (IN(2)) {
        {
            pg8::Gemm g{(const bf16_t*)H8, (const bf16_t*)WIN8, MROWS, 1024, DM / 2, 0, nullptr, nullptr, nullptr, 0};
            QkvOrder S; S.so.init(NTOK / 256, 4, G, bx);
            EpiQKV E{Qb, Kb, Vb, CBb, Ub, 0, WINV};
            pg8::gemm_phase<EpiQKV, QkvOrder, true, true, true>(L, g, S, E);
        }
        {
            pg8::Gemm g{Hb, WIN + (size_t)1024 * DM, NTOK, INC - 1024, DM, 0, nullptr, nullptr, nullptr, 0};
            pg8::StaticOrder S; S.init(NTOK / 256, 6, G, bx);
            EpiQKV E{Qb, Kb, Vb, CBb, Ub, 4, 1.0f};
            pg8::gemm_phase<EpiQKV, pg8::StaticOrder, true, true>(L, g, S, E);
        }
    }
    SEAM(2);

    if (IN(3)) {
        PHASE_IDS;
        const float* gq = args.in[I_GQ]; const float* gk = args.in[I_GK]; const float* wconv = args.in[I_WCONV];
        const f32x2 gq2 = *(const f32x2*)(gq + 2 * lane), gk2 = *(const f32x2*)(gk + 2 * lane);
        float cw0[8], cw1[8], cw2[8];
#pragma unroll
        for (int i = 0; i < 8; ++i) { cw0[i] = wconv[8 * lane + i]; cw1[i] = wconv[CW + 8 * lane + i]; cw2[i] = wconv[2 * CW + 8 * lane + i]; }
        const int hb4 = (lane >> 4) & 1;
        for (int chunk = gw; chunk < NTOK / 16; chunk += NGW) {
            const int r0 = chunk * 16;
            u32x4 up, uc, un; { const int t0 = r0 & (SEQ - 1); up = t0 == 0 ? (u32x4){0, 0, 0, 0} : *(const u32x4*)(Ub + (size_t)(r0 - 1) * CW + 8 * lane); uc = *(const u32x4*)(Ub + (size_t)r0 * CW + 8 * lane); }
            for (int rr = 0; rr < 16; ++rr) {
                const int r = r0 + rr, b = r >> 14, t = r & (SEQ - 1), prow = t >> 6, pcol = t & 63;
                un = t == SEQ - 1 ? (u32x4){0, 0, 0, 0} : *(const u32x4*)(Ub + (size_t)(r + 1) * CW + 8 * lane);
                const f32x4 cs = *(const f32x4*)(rope + ((size_t)((lane >> 5) ? pcol : prow) * 32 + 2 * (lane & 15)) * 2);
                unsigned qv[4], kv[2];
#pragma unroll
                for (int h = 0; h < 4; ++h) qv[h] = *(const unsigned*)(Qb + (size_t)r * QW + h * HD + 2 * lane);
                bf16_t* krow = Kb + ((size_t)b * SKV + t) * KVW;
#pragma unroll
                for (int h = 0; h < 2; ++h) kv[h] = *(const unsigned*)(krow + h * HD + 2 * lane);
#pragma unroll
                for (int h = 0; h < 6; ++h) {
                    const unsigned w = h < 4 ? qv[h] : kv[h - 4]; const f32x2 g2 = h < 4 ? gq2 : gk2;
                    float a = bf_lo(w), c = bf_hi(w);
                    const float rstd = rsqrtf(wave_sum(a * a + c * c) * (1.f / HD) + NORM_EPS);
                    a = a * rstd * g2.x; c = c * rstd * g2.y;
                    const float pa = __shfl_xor(a, 16), pc = __shfl_xor(c, 16);
                    const float oa = hb4 ? a * cs.x + pa * cs.y : a * cs.x - pa * cs.y;
                    const float oc = hb4 ? c * cs.z + pc * cs.w : c * cs.z - pc * cs.w;
                    if (h < 4) *(unsigned short*)(Q8 + (size_t)r * QW + h * HD + 2 * lane) = (unsigned short)__builtin_amdgcn_cvt_pk_fp8_f32(oa * (QSCALE * attn8::YS), oc * (QSCALE * attn8::YS), 0, false);
                    else *(unsigned short*)(K8 + ((size_t)b * SKV + t) * KVW + (h - 4) * HD + 2 * lane) = (unsigned short)__builtin_amdgcn_cvt_pk_fp8_f32(oa, oc, 0, false);
                }
                const u32x4 cbv = *(const u32x4*)(CBb + (size_t)r * CW + 8 * lane);
                u32x4 ov;
#pragma unroll
                for (int q = 0; q < 4; ++q) {
                    const float y0 = bf_lo(up[q]) * cw0[2 * q] + bf_lo(uc[q]) * cw1[2 * q] + bf_lo(un[q]) * cw2[2 * q];
                    const float y1 = bf_hi(up[q]) * cw0[2 * q + 1] + bf_hi(uc[q]) * cw1[2 * q + 1] + bf_hi(un[q]) * cw2[2 * q + 1];
                    ov[q] = cvt_pk_bf16(bf_lo(cbv[q]) * y0, bf_hi(cbv[q]) * y1);
                }
                *(u32x4*)(MIX + (size_t)r * DM + QW + 8 * lane) = ov;
                up = uc; uc = un;
            }
        }
        for (int cr = gw; cr < NCTX; cr += NGW) {
            bf16_t* krow = Kb + ((size_t)(cr >> 8) * SKV + SEQ + (cr & 255)) * KVW;
#pragma unroll
            for (int h = 0; h < 2; ++h) { const unsigned w = *(const unsigned*)(krow + h * HD + 2 * lane); float a = bf_lo(w), c = bf_hi(w);
                const float rstd = rsqrtf(wave_sum(a * a + c * c) * (1.f / HD) + NORM_EPS);
                *(unsigned short*)(K8 + ((size_t)(cr >> 8) * SKV + SEQ + (cr & 255)) * KVW + h * HD + 2 * lane) = (unsigned short)__builtin_amdgcn_cvt_pk_fp8_f32(a * rstd * gk2.x, c * rstd * gk2.y, 0, false); }
        }
        {
            LAS unsigned short* vt = (LAS unsigned short*)L;
            for (int item = bx; item < BATCH * (SKV / 64); item += G) {
                const int b = item / (SKV / 64), t64 = item % (SKV / 64);
                __syncthreads();
#pragma unroll
                for (int i = 0; i < 4; ++i) { const int cid = tid + 512 * i, row = cid >> 5, c16 = cid & 31;
                    *(LAS u32x4*)(vt + row * 264 + c16 * 8) = *(const u32x4*)(Vb + ((size_t)b * SKV + 64 * t64 + row) * KVW + c16 * 8); }
                __syncthreads();
                const int dr = tid >> 1, h = tid & 1; unsigned w[8];
#pragma unroll
                for (int q = 0; q < 8; ++q) { float f[4];
#pragma unroll
                    for (int i = 0; i < 4; ++i) { const int j = 4 * q + i, r = j & 15, key = 32 * (j >> 4) + (r & 3) + 8 * (r >> 2) + 4 * h; f[i] = __uint_as_float((unsigned)vt[key * 264 + dr] << 16); }
                    w[q] = pk4_fp8(f[0], f[1], f[2], f[3]); }
                unsigned char* dst = V8T + ((size_t)(b * 2 + (dr >> 7)) * HD + (dr & 127)) * SKV + 64 * t64 + 32 * h;
                *(u32x4*)dst = (u32x4){w[0], w[1], w[2], w[3]}; *(u32x4*)(dst + 16) = (u32x4){w[4], w[5], w[6], w[7]};
            }
            __syncthreads();
        }
    }
    SEAM(3);

    if (IN(4)) {
        PHASE_IDS;
        for (int i = 0;; ++i) {
            const int U = i * G + vcu; if (U >= BATCH * NQH * (SEQ / 256)) break;
            const int combo = U >> 7, hl = (U >> 6) & 1, qb = U & 63, b = combo >> 1, kvh = combo & 1, hq = kvh * 2 + hl;
            attn8::bf16* Op = (attn8::bf16*)MIX + ((size_t)(b * SEQ + qb * 256)) * DM + hq * HD;
            if (bg_on && i < 2) attn8::attn_body<true>(Q8 + ((size_t)(b * SEQ + qb * 256)) * QW + hq * HD, K8 + (size_t)b * SKV * KVW + kvh * HD, V8T + (size_t)(b * 2 + kvh) * HD * SKV, Op, SKV, (char*)lds,
                (vcu * 2 + i) * attn8::BG_TILES, args.in[I_WGU], args.in[I_WDN], WGU8, WDN8, ws + WS_ACT + 150 * MiB);
            else attn8::attn_body<false>(Q8 + ((size_t)(b * SEQ + qb * 256)) * QW + hq * HD, K8 + (size_t)b * SKV * KVW + kvh * HD, V8T + (size_t)(b * 2 + kvh) * HD * SKV, Op, SKV, (char*)lds,
                0, nullptr, nullptr, nullptr, nullptr, nullptr);
            __syncthreads();
        }
    }
    SEAM(4);

    if (IN(5)) {
#if MK_ATTN_CHECK
        {
            PHASE_IDS;
            LAS float* red = (LAS float*)L;
            LAS unsigned* mx = (LAS unsigned*)(L + 8192);
            for (int ci = 0; ci < 4; ++ci) {
                const unsigned U = (unsigned)bx * 4u + (unsigned)ci; const int b = U & 1, hq = (U >> 1) & 3, kvh = hq >> 1, t = (int)((U * 2654435761u >> 7) % (unsigned)SEQ);
                __syncthreads(); if (tid < 2) mx[tid] = 0u; __syncthreads();
                const unsigned qw = *(const unsigned short*)(Q8 + ((size_t)(b * SEQ + t)) * QW + hq * HD + 2 * lane); const float q0 = __builtin_amdgcn_cvt_f32_fp8((int)qw, 0), q1 = __builtin_amdgcn_cvt_f32_fp8((int)qw, 1);
                float lsum = 0.f, o0 = 0.f, o1 = 0.f;
                for (int key = wave; key < SKV; key += 8) {
                    const unsigned kw = *(const unsigned short*)(K8 + ((size_t)b * SKV + key) * KVW + kvh * HD + 2 * lane);
                    const int kl = key & 63, tt = kl >> 5, cc = kl & 31, hh = (cc >> 2) & 1, rr2 = (cc & 3) + 4 * (cc >> 3), pos = (key & ~63) + 32 * hh + 16 * tt + rr2;
                    const unsigned char* vp = V8T + ((size_t)(b * 2 + kvh) * HD + 2 * lane) * SKV + pos;
                    const float v0 = __builtin_amdgcn_cvt_f32_fp8((int)vp[0], 0), v1 = __builtin_amdgcn_cvt_f32_fp8((int)vp[SKV], 0);
                    const float dot = wave_sum(q0 * __builtin_amdgcn_cvt_f32_fp8((int)kw, 0) + q1 * __builtin_amdgcn_cvt_f32_fp8((int)kw, 1)); const float p = exp2f(dot * (1.0f / attn8::YS));
                    lsum += p; o0 += p * v0; o1 += p * v1; }
                red[wave * 132 + 2 * lane] = o0; red[wave * 132 + 2 * lane + 1] = o1; if (lane == 0) red[wave * 132 + 128] = lsum;
                __syncthreads();
                if (tid < 128) { float os = 0.f, ls = 0.f;
                    for (int w = 0; w < 8; ++w) { os += red[w * 132 + tid]; ls += red[w * 132 + 128]; }
                    const float ref = os / ls; const unsigned short mv = *(const unsigned short*)(MIX + ((size_t)(b * SEQ + t)) * DM + hq * HD + tid); const float got = __uint_as_float((unsigned)mv << 16);
                    float err = fabsf(got - ref); if (!(err == err)) err = 1e30f;
                    atomicMax((unsigned*)&mx[0], __float_as_uint(err)); atomicMax((unsigned*)&mx[1], __float_as_uint(fabsf(ref))); }
                __syncthreads();
                if (tid == 0) { const float e = __uint_as_float(mx[0]), r = __uint_as_float(mx[1]); if (e > 0.08f * r + 1e-5f) atomicOr(ctl + CW_FLAG, 1u); }
            }
            __syncthreads();
        }
#endif
        pg8::Gemm g{MIX, WOUT, NTOK, DM, DM, 0, nullptr, nullptr, nullptr, 0};
        pg8::StaticOrder S; S.init(NTOK / 256, DM / 256, G, bx);
        EpiResid E{mod + 2 * DM, D1};
        pg8::gemm_phase<EpiResid, pg8::StaticOrder, true, true>(L, g, S, E);
    }
    SEAM(5);

    if (IN(6)) {
        PHASE_IDS;
        LAS float* wl = (LAS float*)L;
        for (int i = tid; i < NEXP * DM / 4; i += 512) ((LAS f32x4*)wl)[i] = ((const f32x4*)wrt)[i];
        LAS int* hist = (LAS int*)(MISC + MO_HIST / 4); LAS int* baseL = (LAS int*)(MISC + MO_BASE / 4);
        LAS int* sele = (LAS int*)(MISC + MO_SELE / 4); LAS float* selg = (LAS float*)(MISC + MO_SELG / 4);
        const float* g2 = args.in[I_G2]; const float* brt = args.in[I_BR];
        const float br_l = brt[8 * (lane >> 4) + (lane & 7)];
        if (bx == 0 && tid < 64) ((u32x4*)(H28 + (size_t)NTOK * DM))[tid] = (u32x4){0, 0, 0, 0};
        for (int tb = bx; tb < NTOK / 128; tb += G) {
            __syncthreads();
            if (tid < NEXP) hist[tid] = 0;
            __syncthreads();
            const int b = (tb * 128) >> 14;
            f32x4 gs[4], sh[4];
            { int lo_ = lane; asm volatile("" : "+v"(lo_));
#pragma unroll
              for (int j = 0; j < 4; ++j) { const int c = 4 * lo_ + 256 * j; const f32x4 g = *(const f32x4*)(g2 + c), s = *(const f32x4*)(mod + (size_t)b * NMOD + 4 * DM + c);
                gs[j] = g * (s + 1.0f); sh[j] = *(const f32x4*)(mod + (size_t)b * NMOD + 3 * DM + c); } }
            f32x4 xq[2][4]; u32x2 dq[2][4];
#define P6_LOAD(G_) do { _Pragma("unroll") for (int rr = 0; rr < 2; ++rr) { const int r = tb * 128 + wave * 16 + (G_) * 2 + rr; \
                const GAS f32x4* xr = (const GAS f32x4*)(x + (size_t)r * DM) + lane; const GAS u32x2* dr = (const GAS u32x2*)(D1 + (size_t)r * DM) + lane; \
                _Pragma("unroll") for (int j = 0; j < 4; ++j) { xq[rr][j] = xr[64 * j]; dq[rr][j] = dr[64 * j]; } } } while (0)
            P6_LOAD(0);
#pragma unroll 1
            for (int grp = 0; grp < 8; ++grp) {
                const int tl0 = wave * 16 + grp * 2;
                f32x4 v[2][4];
#pragma unroll
                for (int rr = 0; rr < 2; ++rr)
#pragma unroll
                    for (int j = 0; j < 4; ++j) v[rr][j] = xq[rr][j] + (f32x4){bf_lo(dq[rr][j].x), bf_hi(dq[rr][j].x), bf_lo(dq[rr][j].y), bf_hi(dq[rr][j].y)};
                __builtin_amdgcn_sched_barrier(0);
                { const int gn = grp + 1 < 8 ? grp + 1 : 7; P6_LOAD(gn); }
                __builtin_amdgcn_sched_barrier(0);
#pragma unroll
                for (int rr = 0; rr < 2; ++rr) { const int r = tb * 128 + tl0 + rr; float s = 0.f;
#pragma unroll
                    for (int j = 0; j < 4; ++j) s += (v[rr][j].x * v[rr][j].x + v[rr][j].y * v[rr][j].y) + (v[rr][j].z * v[rr][j].z + v[rr][j].w * v[rr][j].w);
                    const float rstd = rsqrtf(wave_sum(s) * (1.f / DM) + NORM_EPS);
                    GAS unsigned* o4 = (GAS unsigned*)(H28 + (size_t)r * DM) + lane;
                    GAS u32x2* x1w = (GAS u32x2*)(X1B + (size_t)r * DM) + lane;
#pragma unroll
                    for (int j = 0; j < 4; ++j) { x1w[64 * j] = (u32x2){cvt_pk_bf16(v[rr][j].x, v[rr][j].y), cvt_pk_bf16(v[rr][j].z, v[rr][j].w)};
                        v[rr][j] = v[rr][j] * rstd * gs[j] + sh[j]; o4[64 * j] = pk4_fp8(v[rr][j].x, v[rr][j].y, v[rr][j].z, v[rr][j].w); } }
                float lg[2];
                {
                    float q[2][16];
#pragma unroll
                    for (int i = 0; i < 16; ++i) {
                        float pa[2], pb[2];
#pragma unroll
                        for (int h2 = 0; h2 < 2; ++h2) { const int e = i + 16 * h2;
                            f32x4 w[4];
#pragma unroll
                            for (int j = 0; j < 4; ++j) w[j] = *(const LAS f32x4*)(wl + e * DM + 4 * lane + 256 * j);
#pragma unroll
                            for (int rr = 0; rr < 2; ++rr) {
                                f32x2 a = __builtin_shufflevector(v[rr][0], v[rr][0], 0, 1) * __builtin_shufflevector(w[0], w[0], 0, 1);
                                a = __builtin_elementwise_fma(__builtin_shufflevector(v[rr][0], v[rr][0], 2, 3), __builtin_shufflevector(w[0], w[0], 2, 3), a);
#pragma unroll
                                for (int j = 1; j < 4; ++j) { a = __builtin_elementwise_fma(__builtin_shufflevector(v[rr][j], v[rr][j], 0, 1), __builtin_shufflevector(w[j], w[j], 0, 1), a);
                                    a = __builtin_elementwise_fma(__builtin_shufflevector(v[rr][j], v[rr][j], 2, 3), __builtin_shufflevector(w[j], w[j], 2, 3), a); }
                                (h2 ? pb : pa)[rr] = a.x + a.y; } }
#pragma unroll
                        for (int rr = 0; rr < 2; ++rr) { auto r = __builtin_amdgcn_permlane32_swap(__float_as_uint(pa[rr]), __float_as_uint(pb[rr]), false, false); q[rr][i] = __uint_as_float(r[0]) + __uint_as_float(r[1]); }
                        __builtin_amdgcn_sched_barrier(0);
                    }
#pragma unroll
                    for (int rr = 0; rr < 2; ++rr) {
                        float t8[8];
#pragma unroll
                        for (int i = 0; i < 8; ++i) { auto r = __builtin_amdgcn_permlane16_swap(__float_as_uint(q[rr][i]), __float_as_uint(q[rr][i + 8]), false, false); float t = __uint_as_float(r[0]) + __uint_as_float(r[1]);
                            t += dpp_f<0xB1>(t); t += dpp_f<0x4E>(t); t += dpp_f<0x141>(t); t += dpp_f<0x140>(t); t8[i] = t; }
                        const float a0 = (lane & 1) ? t8[1] : t8[0], a1 = (lane & 1) ? t8[3] : t8[2], a2 = (lane & 1) ? t8[5] : t8[4], a3 = (lane & 1) ? t8[7] : t8[6];
                        const float b0 = (lane & 2) ? a1 : a0, b1 = (lane & 2) ? a3 : a2;
                        lg[rr] = (lane & 4) ? b1 : b0;
                    }
                }
                const int e_l = 8 * (lane >> 4) + (lane & 7);
#pragma unroll
                for (int rr = 0; rr < 2; ++rr) {
                    float val = lg[rr] + br_l; int si[4]; float sv4[4];
#pragma unroll
                    for (int k = 0; k < 4; ++k) { float m = half_max(val);
                        { auto r = __builtin_amdgcn_permlane32_swap(__float_as_uint(m), __float_as_uint(m), false, false); m = fmaxf(__uint_as_float(r[0]), __uint_as_float(r[1])); }
                        const unsigned long long bal = __ballot(val == m);
                        const int fl = __builtin_amdgcn_readfirstlane(__ffsll((long long)bal) - 1);
                        const int idx = 8 * (fl >> 4) + (fl & 7);
                        si[k] = idx; sv4[k] = m;
                        if (e_l == idx) val = -INFINITY; }
                    const float e1 = __expf(sv4[1] - sv4[0]), e2 = __expf(sv4[2] - sv4[0]), e3 = __expf(sv4[3] - sv4[0]);
                    const float inv = 1.0f / (1.0f + e1 + e2 + e3);
                    if (lane < 4) { const int e = lane == 0 ? si[0] : lane == 1 ? si[1] : lane == 2 ? si[2] : si[3];
                        const float gt = (lane == 0 ? 1.0f : lane == 1 ? e1 : lane == 2 ? e2 : e3) * inv;
                        const int rank = __hip_atomic_fetch_add(hist + e, 1, __ATOMIC_RELAXED, __HIP_MEMORY_SCOPE_WORKGROUP);
                        sele[(tl0 + rr) * 4 + lane] = e | (rank << 8); selg[(tl0 + rr) * 4 + lane] = gt; }
                }
            }
#undef P6_LOAD
            __syncthreads();
            if (tid < NEXP) baseL[tid] = (int)atomicAdd(&cnt[tid], (unsigned)hist[tid]);
            __syncthreads();
            { const int v = sele[tid], e = v & 31, pos = baseL[e] + (v >> 8);
              PINFO[(size_t)e * NTOK + pos] = (tb * 128 + (tid >> 2)) * 4 + (tid & 3); PGATE[(size_t)e * NTOK + pos] = selg[tid]; }
        }
    }
    SEAM(6);


    if (IN(8)) {
        LAS int* ts = (LAS int*)(MISC + MO_TS / 4); LAS int* te = (LAS int*)(MISC + MO_TE / 4);
        const int T = moe_tables(cnt, ts, te);
        pg8::Gemm g{(const bf16_t*)H28, (const bf16_t*)WGU8, T * 256, 2048, DM / 2, (size_t)2048 * DM, PINFO, cnt, ts, NTOK};
        MoeOrder S; S.so.init(T, 8, G, bx); S.te = te;
        EpiSwiglu E{args.in[I_BGU], ACT8};
        pg8::gemm_phase<EpiSwiglu, MoeOrder, true, true, true, true>(L, g, S, E);
    }
    SEAM(8);

    if (IN(9)) {
        LAS int* ts = (LAS int*)(MISC + MO_TS / 4); LAS int* te = (LAS int*)(MISC + MO_TE / 4);
        const int T = moe_tables(cnt, ts, te);
        pg8::Gemm g{(const bf16_t*)ACT8, (const bf16_t*)WDN8, T * 256, DM, DFF / 2, (size_t)DM * DFF, nullptr, nullptr, nullptr, 0};
        MoeOrder S; S.so.init(T, 4, G, bx); S.te = te;
        EpiDown E{args.in[I_BDN], PINFO, PGATE, cnt, ts, YP};
        pg8::gemm_phase<EpiDown, MoeOrder, true, true, true>(L, g, S, E);
    }
    SEAM(9);

    if (IN(10)) {
        PHASE_IDS;
        const float* gf = args.in[I_GF];
        f32x4 gfv[4];
#pragma unroll
        for (int j = 0; j < 4; ++j) gfv[j] = *(const f32x4*)(gf + 4 * lane + 256 * j);
        int curb = -1; f32x4 gtv[4];
        for (int r0 = gw * 2; r0 < NTOK; r0 += NGW * 2) {
            const int b = r0 >> 14;
            if (b != curb) { curb = b;
#pragma unroll
                for (int j = 0; j < 4; ++j) gtv[j] = *(const f32x4*)(mod + (size_t)b * NMOD + 5 * DM + 4 * lane + 256 * j); }
            f32x4 v[2][4]; float s[2] = {0.f, 0.f};
#pragma unroll
            for (int q = 0; q < 2; ++q) { const int r = r0 + q;
                const GAS u32x2* dr = (const GAS u32x2*)(X1B + (size_t)r * DM) + lane;
#pragma unroll
                for (int j = 0; j < 4; ++j) {
                    f32x4 y = {0.f, 0.f, 0.f, 0.f};
#pragma unroll
                    for (int k = 0; k < 4; ++k) { const int w = (int)((const GAS unsigned*)(YP + ((size_t)r * 4 + k) * DM))[lane + 64 * j];
                        y.x += __builtin_amdgcn_cvt_f32_fp8(w, 0); y.y += __builtin_amdgcn_cvt_f32_fp8(w, 1); y.z += __builtin_amdgcn_cvt_f32_fp8(w, 2); y.w += __builtin_amdgcn_cvt_f32_fp8(w, 3); }
                    const u32x2 dw = dr[64 * j];
                    v[q][j] = (f32x4){bf_lo(dw.x), bf_hi(dw.x), bf_lo(dw.y), bf_hi(dw.y)} + gtv[j] * y;
                    s[q] += (v[q][j].x * v[q][j].x + v[q][j].y * v[q][j].y) + (v[q][j].z * v[q][j].z + v[q][j].w * v[q][j].w);
                } }
#pragma unroll
            for (int q = 0; q < 2; ++q) { const int r = r0 + q;
                const float rstd = rsqrtf(wave_sum(s[q]) * (1.f / DM) + NORM_EPS);
                GAS f32x4* o = (GAS f32x4*)(args.out + (size_t)r * DM) + lane;
#if MK_ATTN_CHECK
                const float poison = ctl[CW_FLAG] ? __builtin_nanf("") : 0.f;
#pragma unroll
                for (int j = 0; j < 4; ++j) o[64 * j] = v[q][j] * rstd * gfv[j] + poison;
#else
#pragma unroll
                for (int j = 0; j < 4; ++j) o[64 * j] = v[q][j] * rstd * gfv[j];
#endif
            }
        }
    }
#undef IN
#undef SEAM
#undef PHASE_IDS
}

extern "C" void kernel_launch(void* const* d_in, const int* in_sizes, int n_in, void* d_out, int out_size, void* d_ws, size_t ws_size, hipStream_t stream) {
    static int grid = 0;
    if (grid == 0) {
        if (n_in != 20 || in_sizes[0] != NTOK * DM || out_size != NTOK * DM || ws_size < WS_END) {
            fprintf(stderr, "kernel_launch: shape mismatch (n_in %d, in0 %d, out %d, ws %zu; need ws >= %zu); nothing launched\n", n_in, n_in > 0 ? in_sizes[0] : -1, out_size, ws_size, (size_t)WS_END); grid = -1; return; }
        int dev = 0, cus = 0, per_cu = 0;
        if (hipGetDevice(&dev) != hipSuccess || hipDeviceGetAttribute(&cus, hipDeviceAttributeMultiprocessorCount, dev) != hipSuccess) { grid = -1; return; }
        if (hipFuncSetAttribute((const void*)fwd_kernel, hipFuncAttributeMaxDynamicSharedMemorySize, LDS_BYTES) != hipSuccess) { fprintf(stderr, "kernel_launch: hipFuncSetAttribute failed\n"); grid = -1; return; }
        if (hipOccupancyMaxActiveBlocksPerMultiprocessor(&per_cu, (const void*)fwd_kernel, 512, LDS_BYTES) != hipSuccess || per_cu < 1)
            fprintf(stderr, "kernel_launch: note: occupancy query reports %d workgroups per CU\n", per_cu);
        (void)hipGetLastError();
        grid = cus;
    }
    if (grid < 0) return;
    if (hipMemsetAsync((char*)d_ws + WS_CTL, 0, CTL_ZERO_BYTES, stream) != hipSuccess) return;
    Args a{};
    for (int i = 0; i < 20; ++i) a.in[i] = (const float*)d_in[i];
    a.out = (float*)d_out; a.ws = (unsigned char*)d_ws;
#if MK_PER_PHASE
    for (int p = 0; p < NPHASE; ++p) { a.ph_lo = p; a.ph_hi = p + 1; hipLaunchKernelGGL(fwd_kernel, dim3(grid), dim3(512), LDS_BYTES, stream, a); }
#elif MK_DUP >= 0
    a.ph_lo = 0; a.ph_hi = MK_DUP + 1; a.li = 0; hipLaunchKernelGGL(fwd_kernel, dim3(grid), dim3(512), LDS_BYTES, stream, a);
    a.ph_lo = MK_DUP; a.ph_hi = NPHASE; a.li = 1; hipLaunchKernelGGL(fwd_kernel, dim3(grid), dim3(512), LDS_BYTES, stream, a);
#else
    a.ph_lo = 0; a.ph_hi = NPHASE;
    hipLaunchKernelGGL(fwd_kernel, dim3(grid), dim3(512), LDS_BYTES, stream, a);
#endif
    const hipError_t le = hipPeekAtLastError();
    if (le != hipSuccess) fprintf(stderr, "kernel_launch: launch failed: %s\n", hipGetErrorName(le));
}
```

```cpp
#include <hip/hip_runtime.h>
#include <hip/hip_bf16.h>
#include <cstdio>
#include <cstdint>

#ifndef MK_DUP
#define MK_DUP (-1)
#endif
#ifndef MK_ATTN_CHECK
#define MK_ATTN_CHECK 0
#endif
#ifndef MK_PER_PHASE
#define MK_PER_PHASE 0
#endif

constexpr int BATCH = 2, SEQ = 16384, DM = 1024, NTOK = BATCH * SEQ, CTXL = 256, NCTX = BATCH * CTXL, MROWS = NTOK + NCTX;
constexpr int SKV = SEQ + CTXL;
constexpr int HD = 128, NQH = 4, NKVH = 2, QW = NQH * HD  , KVW = NKVH * HD  , CW = 512;
constexpr int INC = 2560, NMOD = 6 * DM;
constexpr int NEXP = 32, TOPK = 4, DFF = 1024;
constexpr float NORM_EPS = 1e-6f;
constexpr float WSCALE = 32.0f, WINV = 1.0f / 32.0f;
constexpr int MAXTILES = (NTOK * TOPK) / 256 + NEXP;
constexpr int MAXROWS = MAXTILES * 256;
constexpr int NPHASE = 11;

constexpr size_t MiB = 1u << 20;
constexpr size_t WS_CTL = 0, CTL_ZERO_BYTES = 1 * MiB;
constexpr size_t WS_MOD = 1 * MiB;
constexpr size_t WS_ROPE = WS_MOD + 128 * 1024;
constexpr size_t WS_WRT = WS_ROPE + 128 * 1024;
constexpr size_t WS_WIN8 = WS_MOD + 512 * 1024;
constexpr size_t WS_WIN = 3 * MiB;
constexpr size_t WS_WOUT = 8 * MiB;
constexpr size_t WS_WGU = 10 * MiB;
constexpr size_t WS_WDN = 138 * MiB;
constexpr size_t WS_X1 = 202 * MiB;
constexpr size_t WS_H2 = 330 * MiB;
constexpr size_t WS_PINFO = 395 * MiB;
constexpr size_t WS_PGATE = 399 * MiB;
constexpr size_t WS_R1 = 404 * MiB;
constexpr size_t WS_H = WS_R1;
constexpr size_t WS_Q = WS_R1 + 65 * MiB;
constexpr size_t WS_K = WS_Q + 32 * MiB;
constexpr size_t WS_V = WS_K + 17 * MiB;
constexpr size_t WS_CB = WS_V + 17 * MiB;
constexpr size_t WS_U = WS_CB + 32 * MiB;
constexpr size_t WS_MIX = WS_U + 32 * MiB;
constexpr size_t WS_Q8 = WS_H, WS_K8 = WS_H + 16 * MiB, WS_V8T = WS_H + 26 * MiB;
constexpr size_t WS_YP = WS_R1;
constexpr size_t WS_ACT = 676 * MiB;
constexpr size_t WS_H8 = WS_ACT;
constexpr size_t WS_END = 948 * MiB;
static_assert(WS_MIX + 64 * MiB <= WS_R1 + 272 * MiB && (size_t)MAXROWS * 2048 <= 272 * MiB, "ws map");
constexpr int CW_FLAG = 32;
constexpr int CW_CNT = 64;
constexpr int CW_BAR = 4096;

constexpr int LDS_BYTES = 163840;
constexpr int MISC_OFF = 155648;
constexpr int MO_BAR = 0, MO_TS = 64, MO_TE = 256, MO_HIST = 2816, MO_BASE = 2944, MO_SELE = 3072, MO_SELG = 5120;

#define GAS __attribute__((address_space(1)))
#define LAS __attribute__((address_space(3)))
typedef unsigned short bf16_t;
typedef short bf16x8 __attribute__((ext_vector_type(8)));
typedef float f32x4 __attribute__((ext_vector_type(4)));
typedef float f32x2 __attribute__((ext_vector_type(2)));
typedef unsigned u32x4 __attribute__((ext_vector_type(4)));
typedef unsigned u32x2 __attribute__((ext_vector_type(2)));
typedef int i32x4_t __attribute__((ext_vector_type(4)));
typedef int i32x8_t __attribute__((ext_vector_type(8)));

__device__ __forceinline__ unsigned cvt_pk_bf16(float lo, float hi) { unsigned r; asm volatile("v_cvt_pk_bf16_f32 %0, %1, %2" : "=v"(r) : "v"(lo), "v"(hi)); return r; }
__device__ __forceinline__ unsigned pk4_fp8(float a, float b, float c, float d) { unsigned w = 0; w = __builtin_amdgcn_cvt_pk_fp8_f32(a, b, w, false); w = __builtin_amdgcn_cvt_pk_fp8_f32(c, d, w, true); return w; }
__device__ __forceinline__ float bf_lo(unsigned w) { return __uint_as_float(w << 16); }
__device__ __forceinline__ float bf_hi(unsigned w) { return __uint_as_float(w & 0xffff0000u); }
template <int CTRL> __device__ __forceinline__ float dpp_f(float v) { return __builtin_bit_cast(float, __builtin_amdgcn_update_dpp(0, __builtin_bit_cast(int, v), CTRL, 0xf, 0xf, true)); }
__device__ __forceinline__ float wave_sum(float v) {
    v += dpp_f<0xB1>(v); v += dpp_f<0x4E>(v); v += dpp_f<0x141>(v); v += dpp_f<0x140>(v);
    { auto r = __builtin_amdgcn_permlane16_swap(__float_as_uint(v), __float_as_uint(v), false, false); v = __uint_as_float(r[0]) + __uint_as_float(r[1]); }
    { auto r = __builtin_amdgcn_permlane32_swap(__float_as_uint(v), __float_as_uint(v), false, false); v = __uint_as_float(r[0]) + __uint_as_float(r[1]); }
    return v;
}
__device__ __forceinline__ float half_max(float v) {
    v = fmaxf(v, dpp_f<0xB1>(v)); v = fmaxf(v, dpp_f<0x4E>(v)); v = fmaxf(v, dpp_f<0x141>(v)); v = fmaxf(v, dpp_f<0x140>(v));
    { auto r = __builtin_amdgcn_permlane16_swap(__float_as_uint(v), __float_as_uint(v), false, false); v = fmaxf(__uint_as_float(r[0]), __uint_as_float(r[1])); }
    return v;
}

namespace pg8 {
constexpr int BM = 256, BK = 64, HALF = 128, HTB = HALF * BK * 2, STAGE_BYTES = 8 * HTB, NXCD = 8, WGM = 8;
__host__ __device__ __forceinline__ int lds_byte(int r, int c) { const int st = (r >> 4) * 2 + (c >> 5), rr = r & 15, cc = c & 31, ob = rr * 64 + cc * 2; return st * 1024 + (ob ^ (((ob >> 9) & 1) << 5)); }
__host__ __device__ __forceinline__ void stage_rc(int b, int& R, int& C) { const int st = b / 1024, sb = b % 1024, swz = sb ^ (((sb >> 9) & 1) << 5); R = (st >> 1) * 16 + swz / 64; C = (st & 1) * 32 + (swz % 64) / 2; }
__host__ __device__ __forceinline__ int perm32(int rho) { const int n = rho >> 4, i = rho & 15; return 8 * (i >> 2) + 4 * n + (i & 3); }

struct Unit { int pm, pn, e; };
struct Gemm { const bf16_t* A; const bf16_t* Bt; int M, N, K; size_t estride;
              const int* pinfo; const unsigned* cnt; const LAS int* ts; int ntok; };

struct StaticOrder {
    int nM, nN, nwg, G, c;
    __device__ void init(int nM_, int nN_, int G_, int c_) { nM = nM_; nN = nN_; nwg = nM * nN; G = G_; c = c_; }
    __device__ bool next(int i, Unit& u) const {
        const long L = (long)i * G + c; if (L >= nwg) return false;
        int wgid = (int)L; { const int q = nwg / NXCD, r = nwg % NXCD, xcd = wgid % NXCD, off = wgid / NXCD; wgid = (xcd < r ? xcd * (q + 1) : r * (q + 1) + (xcd - r) * q) + off; }
        const int nig = WGM * nN, gid = wgid / nig, fm = gid * WGM, gsz = (nM - fm) < WGM ? (nM - fm) : WGM;
        u.pm = fm + ((wgid % nig) % gsz); u.pn = (wgid % nig) / gsz; u.e = 0; return true;
    }
};

template <class Epi, class Sched, bool ALIGN_EPI = false, bool SP2 = false, bool FP8 = false, bool GATHER = false>
__device__ __forceinline__ void gemm_phase(LAS unsigned char* lds, const Gemm g, const Sched& S, const Epi& E) {
    int tid = threadIdx.x; asm volatile("" : "+v"(tid));
    const int wid = __builtin_amdgcn_readfirstlane(tid >> 6), lane = tid & 63, wr = wid >> 2, wc = wid & 3, fr = lane & 15, fq = lane >> 4;
    const int K = g.K, nt = K / BK;
    unsigned voffA[2], voffB[2], voffB1[2]; int Rrow[2]; unsigned cbyte[2];
#pragma unroll
    for (int i = 0; i < 2; ++i) { int R, C; stage_rc(tid * 16 + i * 8192, R, C); const int Rb = Epi::PERM ? ((R & ~31) + perm32(R & 31)) : R;
        voffA[i] = (unsigned)(R * K + C) * 2u; voffB[i] = (unsigned)(Rb * K + C) * 2u; Rrow[i] = R; cbyte[i] = (unsigned)C * 2u;
        if constexpr (Epi::BMODE == 1) {
            const int Rm = 64 * (R >> 5) + 16 * ((R & 15) >> 2) + 4 * ((R >> 4) & 1) + (R & 3);
            voffB[i] = (unsigned)(Rm * K + C) * 2u; voffB1[i] = (unsigned)((Rm + 8) * K + C) * 2u; } }
    unsigned gC[2][2], gN[2][2]; int gR[2][2];
#define PG8_GISSUE(u_) do { const int e_ = (u_).e; const int p0_ = ((u_).pm - g.ts[e_]) * 256; const int c_ = (int)g.cnt[e_]; \
        _Pragma("unroll") for (int h_ = 0; h_ < 2; ++h_) _Pragma("unroll") for (int i_ = 0; i_ < 2; ++i_) { const int pos_ = p0_ + 128 * h_ + Rrow[i_]; \
            const int* ap_ = g.pinfo + (size_t)e_ * g.ntok + (pos_ < c_ ? pos_ : 0); asm volatile("global_load_dword %0, %1, off" : "=v"(gR[h_][i_]) : "v"(ap_) : "memory"); } } while (0)
#define PG8_GCONV(u_, dst_) do { const int e_ = (u_).e; const int p0_ = ((u_).pm - g.ts[e_]) * 256; const int c_ = (int)g.cnt[e_]; \
        asm volatile("" : "+v"(gR[0][0]), "+v"(gR[0][1]), "+v"(gR[1][0]), "+v"(gR[1][1])); \
        _Pragma("unroll") for (int h_ = 0; h_ < 2; ++h_) _Pragma("unroll") for (int i_ = 0; i_ < 2; ++i_) { const int pos_ = p0_ + 128 * h_ + Rrow[i_]; \
            const int tok_ = pos_ < c_ ? (gR[h_][i_] >> 2) : g.ntok; dst_[h_][i_] = (unsigned)tok_ * (unsigned)(K * 2) + cbyte[i_]; } } while (0)
#define PG8_STAGE_B(bufoff, bbase, bj) do { if constexpr (Epi::BMODE == 1) { if ((bj) == 0) PG8_STAGE(bufoff, bbase, voffB); else PG8_STAGE(bufoff, bbase, voffB1); } \
        else { PG8_STAGE(bufoff, (bbase) + (bj) * hstep, voffB); } } while (0)
#define PG8_STAGE_A(bufoff, abase, h, nx) do { if constexpr (GATHER) { unsigned vs_[2] = {(nx) ? gN[h][0] : gC[h][0], (nx) ? gN[h][1] : gC[h][1]}; PG8_STAGE(bufoff, abase, vs_); } \
        else { PG8_STAGE(bufoff, (abase) + (h) * hstep, voffA); } } while (0)
    const size_t kstep = (size_t)(BK * 2);
    const size_t hstep = (size_t)HALF * K * 2;
    const size_t tstep = 2 * hstep;
    const unsigned ldsw = (unsigned)wid * 1024u;
    int aoff = lds_byte(wr * 64 + fr, fq * 8), boff = lds_byte(wc * 32 + fr, fq * 8) + 4 * HTB;
    asm volatile("" : "+v"(aoff), "+v"(boff));
#define PG8_SA(b, h) (((b) * 2 + (h)) * HTB)
#define PG8_SB(b, h) ((4 + (b) * 2 + (h)) * HTB)
#define PG8_STAGE(bufoff, gbase, voff) do { _Pragma("unroll") for (int _i = 0; _i < 2; ++_i) \
        __builtin_amdgcn_global_load_lds((const unsigned*)((const char*)(gbase) + (voff)[_i]), (LAS unsigned*)(lds + (bufoff) + ldsw + _i * 8192), 16, 0, 0); } while (0)
#define PG8_LD16(off) (*(const LAS i32x4_t*)(lds + (off)))
#define PG8_LDA(dst, b, h) do { _Pragma("unroll") for (int m = 0; m < 4; ++m) dst[m] = __builtin_shufflevector(PG8_LD16(aoff + PG8_SA(b, h) + m * 2048), PG8_LD16(aoff + PG8_SA(b, h) + m * 2048 + 1024), 0, 1, 2, 3, 4, 5, 6, 7); } while (0)
#define PG8_LDB(dst, b, h) do { _Pragma("unroll") for (int n = 0; n < 2; ++n) dst[n] = __builtin_shufflevector(PG8_LD16(boff + ((b) * 2 + (h)) * HTB + n * 2048), PG8_LD16(boff + ((b) * 2 + (h)) * HTB + n * 2048 + 1024), 0, 1, 2, 3, 4, 5, 6, 7); } while (0)
#define PG8_LOH(x) __builtin_bit_cast(bf16x8, __builtin_shufflevector((x), (x), 0, 1, 2, 3))
#define PG8_HIH(x) __builtin_bit_cast(bf16x8, __builtin_shufflevector((x), (x), 4, 5, 6, 7))
#define PG8_MMA(ai, bj, At, Bt) do { __builtin_amdgcn_s_setprio(1); if constexpr (FP8) { _Pragma("unroll") for (int m = 0; m < 4; ++m) _Pragma("unroll") for (int n = 0; n < 2; ++n) \
        asm volatile("v_mfma_f32_16x16x128_f8f6f4 %0, %1, %2, %0" : "+v"(acc[ai][bj][m][n]) : "v"(Bt[n]), "v"(At[m])); } else { \
        _Pragma("unroll") for (int m = 0; m < 4; ++m) _Pragma("unroll") for (int n = 0; n < 2; ++n) { \
        acc[ai][bj][m][n] = __builtin_amdgcn_mfma_f32_16x16x32_bf16(PG8_LOH(Bt[n]), PG8_LOH(At[m]), acc[ai][bj][m][n], 0, 0, 0); \
        acc[ai][bj][m][n] = __builtin_amdgcn_mfma_f32_16x16x32_bf16(PG8_HIH(Bt[n]), PG8_HIH(At[m]), acc[ai][bj][m][n], 0, 0, 0); } } __builtin_amdgcn_s_setprio(0); } while (0)
#define PG8_WAIT_V(n) asm volatile("s_waitcnt vmcnt(" #n ")" ::: "memory")
#define PG8_WAIT_L(n) asm volatile("s_waitcnt lgkmcnt(" #n ")" ::: "memory")
#define PG8_BAR __builtin_amdgcn_s_barrier()
#define PG8_SCHED __builtin_amdgcn_sched_barrier(0)
    Unit cur, nxt; int ui = 0;
    if (!S.next(0, cur)) return;
    f32x4 acc[2][2][4][2];
#pragma unroll
    for (int a = 0; a < 2; ++a)
#pragma unroll
        for (int b = 0; b < 2; ++b)
#pragma unroll
            for (int m = 0; m < 4; ++m)
#pragma unroll
                for (int n = 0; n < 2; ++n) acc[a][b][m][n] = (f32x4){0.f, 0.f, 0.f, 0.f};
    i32x8_t At[4], B0[2], B1[2];
    const char* cA = (const char*)g.A + (GATHER ? (size_t)0 : (size_t)cur.pm * tstep); const char* cB = (const char*)g.Bt + (size_t)cur.e * g.estride + (size_t)cur.pn * tstep;
    if constexpr (GATHER) { PG8_GISSUE(cur); asm volatile("s_waitcnt vmcnt(0)" ::: "memory"); PG8_GCONV(cur, gC);
#pragma unroll
        for (int h_ = 0; h_ < 2; ++h_)
#pragma unroll
            for (int i_ = 0; i_ < 2; ++i_) gN[h_][i_] = gC[h_][i_]; }
    if constexpr (SP2) {
        PG8_STAGE_B(PG8_SB(0, 0), cB, 0); PG8_STAGE_B(PG8_SB(0, 1), cB, 1); PG8_STAGE_A(PG8_SA(0, 0), cA, 0, false); PG8_STAGE_A(PG8_SA(0, 1), cA, 1, false);
        if (wr == 1) PG8_BAR;
        PG8_WAIT_V(2); PG8_BAR;
        PG8_STAGE_B(PG8_SB(1, 0), cB + kstep, 0); PG8_STAGE_A(PG8_SA(1, 0), cA + kstep, 0, false); PG8_STAGE_B(PG8_SB(1, 1), cB + kstep, 1);
        PG8_WAIT_V(6); PG8_BAR;
    } else {
        PG8_STAGE(PG8_SB(0, 0), cB, voffB); PG8_STAGE(PG8_SA(0, 0), cA, voffA); PG8_STAGE(PG8_SB(0, 1), cB + hstep, voffB); PG8_STAGE(PG8_SA(0, 1), cA + hstep, voffA);
        if (wr == 1) PG8_BAR;
        PG8_WAIT_V(4); PG8_BAR;
        PG8_STAGE(PG8_SB(1, 0), cB + kstep, voffB); PG8_STAGE(PG8_SA(1, 0), cA + kstep, voffA); PG8_STAGE(PG8_SB(1, 1), cB + hstep + kstep, voffB);
        PG8_WAIT_V(6); PG8_BAR;
    }
    typename Epi::Pre epre;
    if constexpr (Epi::PRE) E.pre(cur, wr, wc, fr, fq, epre);
    for (;;) {
        const bool has_next = S.next(ui + 1, nxt);
        const char* nA = (has_next && !GATHER) ? (const char*)g.A + (size_t)nxt.pm * tstep : cA; const char* nB = has_next ? (const char*)g.Bt + (size_t)nxt.e * g.estride + (size_t)nxt.pn * tstep : cB;
        if constexpr (GATHER) { if (has_next) PG8_GISSUE(nxt); }
#pragma unroll 1
        for (int t = 0; t < nt; t += 2) {
            const bool last = (t == nt - 2);
            const char* a1 = cA + (size_t)(t + 1) * kstep;
            const char* a2 = last ? nA : cA + (size_t)(t + 2) * kstep; const char* b2 = last ? nB : cB + (size_t)(t + 2) * kstep;
            const char* a3 = a2 + kstep; const char* b3 = b2 + kstep;
            if constexpr (GATHER) { if (last && has_next) PG8_GCONV(nxt, gN); }
            if constexpr (SP2) {
            PG8_LDB(B0, 0, 0); PG8_LDB(B1, 0, 1); PG8_SCHED; PG8_LDA(At, 0, 0); PG8_STAGE_A(PG8_SA(1, 1), a1, 1, false);
            PG8_WAIT_V(8); PG8_WAIT_L(0); PG8_BAR; PG8_MMA(0, 0, At, B0); PG8_MMA(0, 1, At, B1); PG8_BAR; PG8_SCHED;
            PG8_LDA(At, 0, 1); PG8_STAGE_B(PG8_SB(0, 0), b2, 0); PG8_STAGE_B(PG8_SB(0, 1), b2, 1); PG8_STAGE_A(PG8_SA(0, 0), a2, 0, last);
            PG8_WAIT_V(8); PG8_WAIT_L(0); PG8_BAR; PG8_MMA(1, 0, At, B0); PG8_MMA(1, 1, At, B1); PG8_BAR; PG8_SCHED;
            PG8_LDB(B0, 1, 0); PG8_LDB(B1, 1, 1); PG8_SCHED; PG8_LDA(At, 1, 0); PG8_STAGE_A(PG8_SA(0, 1), a2, 1, last);
            PG8_WAIT_V(8); PG8_WAIT_L(0); PG8_BAR; PG8_MMA(0, 0, At, B0); PG8_MMA(0, 1, At, B1); PG8_BAR; PG8_SCHED;
            PG8_LDA(At, 1, 1); PG8_STAGE_B(PG8_SB(1, 0), b3, 0); PG8_STAGE_B(PG8_SB(1, 1), b3, 1); PG8_STAGE_A(PG8_SA(1, 0), a3, 0, last);
            PG8_WAIT_V(8); PG8_WAIT_L(0); PG8_BAR; PG8_MMA(1, 0, At, B0); PG8_MMA(1, 1, At, B1); PG8_BAR; PG8_SCHED;
            } else {
            PG8_LDB(B0, 0, 0); PG8_SCHED; PG8_LDA(At, 0, 0); PG8_STAGE(PG8_SA(1, 1), a1 + hstep, voffA);
            PG8_WAIT_L(8); PG8_BAR; PG8_WAIT_L(0); PG8_MMA(0, 0, At, B0); PG8_BAR; PG8_SCHED;
            PG8_LDB(B1, 0, 1); PG8_STAGE(PG8_SB(0, 0), b2, voffB);
            PG8_BAR; PG8_WAIT_L(0); PG8_MMA(0, 1, At, B1); PG8_BAR;
            PG8_LDA(At, 0, 1); PG8_STAGE(PG8_SA(0, 0), a2, voffA);
            PG8_BAR; PG8_WAIT_L(0); PG8_MMA(1, 0, At, B0); PG8_BAR; PG8_SCHED;
            PG8_STAGE(PG8_SB(0, 1), b2 + hstep, voffB);
            PG8_WAIT_V(6); PG8_BAR; PG8_MMA(1, 1, At, B1); PG8_BAR;
            PG8_LDB(B0, 1, 0); PG8_SCHED; PG8_LDA(At, 1, 0); PG8_STAGE(PG8_SA(0, 1), a2 + hstep, voffA);
            PG8_WAIT_L(8); PG8_BAR; PG8_WAIT_L(0); PG8_MMA(0, 0, At, B0); PG8_BAR; PG8_SCHED;
            PG8_LDB(B1, 1, 1); PG8_STAGE(PG8_SB(1, 0), b3, voffB);
            PG8_BAR; PG8_WAIT_L(0); PG8_MMA(0, 1, At, B1); PG8_BAR;
            PG8_LDA(At, 1, 1); PG8_STAGE(PG8_SA(1, 0), a3, voffA);
            PG8_BAR; PG8_WAIT_L(0); PG8_MMA(1, 0, At, B0); PG8_BAR; PG8_SCHED;
            PG8_STAGE(PG8_SB(1, 1), b3 + hstep, voffB);
            PG8_WAIT_V(6); PG8_BAR; PG8_MMA(1, 1, At, B1); PG8_BAR;
            }
        }
        if constexpr (ALIGN_EPI) { if (wr == 0) PG8_BAR; }
        if constexpr (FP8) { asm volatile("s_nop 15\n\ts_nop 15\n\ts_nop 15" ::: "memory"); PG8_SCHED; }
        if constexpr (Epi::PRE) E(acc, cur, wr, wc, fr, fq, epre); else E(acc, cur, wr, wc, fr, fq);
        if (!has_next) break;
#pragma unroll
        for (int a = 0; a < 2; ++a)
#pragma unroll
            for (int b = 0; b < 2; ++b)
#pragma unroll
                for (int m = 0; m < 4; ++m)
#pragma unroll
                    for (int n = 0; n < 2; ++n) acc[a][b][m][n] = (f32x4){0.f, 0.f, 0.f, 0.f};
        cur = nxt; cA = nA; cB = nB; ++ui;
        if constexpr (Epi::PRE) E.pre(cur, wr, wc, fr, fq, epre);
        if constexpr (GATHER) {
#pragma unroll
            for (int h_ = 0; h_ < 2; ++h_)
#pragma unroll
                for (int i_ = 0; i_ < 2; ++i_) gC[h_][i_] = gN[h_][i_]; }
        if constexpr (ALIGN_EPI) { if (wr == 1) PG8_BAR; }
    }
    PG8_WAIT_V(0);
    if constexpr (!ALIGN_EPI) { if (wr == 0) PG8_BAR; }
    PG8_BAR;
#undef PG8_SA
#undef PG8_SB
#undef PG8_STAGE
#undef PG8_STAGE_A
#undef PG8_STAGE_B
#undef PG8_GISSUE
#undef PG8_GCONV
#undef PG8_LDA
#undef PG8_LDB
#undef PG8_MMA
#undef PG8_LOH
#undef PG8_HIH
#undef PG8_LD16
#undef PG8_WAIT_V
#undef PG8_WAIT_L
#undef PG8_BAR
#undef PG8_SCHED
}
}

constexpr float QSCALE = 0.088388347648318440f * 1.4426950408889634f;

namespace attn8 {
using bf16 = __hip_bfloat16;
constexpr int NW = 8, QBLK = 32, KVBLK = 64, LDO = DM;
constexpr int LDQB = QW, LDKB = KVW;
constexpr float YS = 8.f, Y0 = 56.f;
constexpr float THRY = Y0 + 8.f * YS;
constexpr int SLOT = 8192, NKS = 2, NVS = 4;
constexpr int LDS_KR = 0, LDS_VR = NKS * SLOT, LDS_WS = (NKS + NVS) * SLOT, SHM_ATTN = LDS_WS + NW * 256;
constexpr int LDS_BG = SHM_ATTN, BGT = 16384, BG_TILES = 48, BG_LAG = 4;
using f32x16 = __attribute__((ext_vector_type(16))) float;
using u32x4g = __attribute__((ext_vector_type(4))) unsigned;
typedef __attribute__((address_space(3))) const char* lds_cptr;
#define SBAR() __builtin_amdgcn_sched_barrier(0)
__device__ __forceinline__ int crow(int r, int hi) { return (r & 3) + 8 * (r >> 2) + 4 * hi; }
__device__ __forceinline__ i32x8_t ld32(lds_cptr p0, lds_cptr p1) { return __builtin_shufflevector(*(const LAS i32x4_t*)p0, *(const LAS i32x4_t*)p1, 0, 1, 2, 3, 4, 5, 6, 7); }
__device__ __forceinline__ void mfma8_init(f32x16& d, const i32x8_t& a, const i32x8_t& b, const f32x16& c) { asm volatile("v_mfma_f32_32x32x64_f8f6f4 %0, %1, %2, %3" : "=&v"(d) : "v"(a), "v"(b), "v"(c)); }
__device__ __forceinline__ void mfma8_acc(f32x16& d, const i32x8_t& a, const i32x8_t& b) { asm volatile("v_mfma_f32_32x32x64_f8f6f4 %0, %1, %2, %0" : "+v"(d) : "v"(a), "v"(b)); }
__device__ __forceinline__ void mfma8_acc_pad(f32x16& d, const i32x8_t& a, const i32x8_t& b) { asm volatile("s_nop 3\n\tv_mfma_f32_32x32x64_f8f6f4 %0, %1, %2, %0" : "+v"(d) : "v"(a), "v"(b)); }
#define PK8(P, B) __builtin_amdgcn_cvt_pk_u8_f32(P[B + 3], 3u, __builtin_amdgcn_cvt_pk_u8_f32(P[B + 2], 2u, __builtin_amdgcn_cvt_pk_u8_f32(P[B + 1], 1u, __builtin_amdgcn_cvt_pk_u8_f32(P[B], 0u, 0u))))

template <bool BG>
__device__ __forceinline__ void attn_body(const unsigned char* __restrict__ Q8, const unsigned char* __restrict__ K8, const unsigned char* __restrict__ V8T, bf16* __restrict__ Ob, int seq, char* lds,
    int bg_t0, const float* __restrict__ bg_wgu, const float* __restrict__ bg_wdn, unsigned char* __restrict__ bg_gu8, unsigned char* __restrict__ bg_dn8, unsigned char* __restrict__ bg_dump) {
  int tid = threadIdx.x; asm volatile("" : "+v"(tid));
  const int lane = tid & 63, r32 = lane & 31, hi = lane >> 5; const int wid = __builtin_amdgcn_readfirstlane(tid >> 6);
  const lds_cptr L3 = (lds_cptr)lds;
  float* ws = (float*)(lds + LDS_WS) + wid * 64; float* li_l = ws; float* al_l = ws + 32;
  const bool kvw = wid < 4;
  unsigned koff, voff;
  { const int row = (wid & 3) * 16 + (lane >> 3), c = (lane & 7) ^ ((row >> 1) & 7); koff = (unsigned)(row * LDKB + c * 16); }
  { const int d = (wid & 3) * 32 + (lane >> 2), c = (lane & 3) ^ ((d >> 2) & 3); voff = (unsigned)(d * SKV + c * 16); }
  const unsigned pdst = (unsigned)(wid & 3) * 2048u;
#define DMA_PIECE(p, t, kslot, vslot) do { if (kvw) { \
    if ((p) == 0) { const char* sb_ = (const char*)K8 + (size_t)(t) * (KVBLK * LDKB); asm volatile("" : "+s"(sb_)); \
      __builtin_amdgcn_global_load_lds((const unsigned*)(sb_ + koff), (LAS unsigned*)((LAS unsigned char*)lds + LDS_KR + (kslot) * SLOT + pdst), 16, 0, 0); \
      __builtin_amdgcn_global_load_lds((const unsigned*)(sb_ + ((koff ^ 64u) + 8u * LDKB)), (LAS unsigned*)((LAS unsigned char*)lds + LDS_KR + (kslot) * SLOT + pdst + 1024u), 16, 0, 0); } \
    if ((p) == 1) { const char* sb_ = (const char*)V8T + (size_t)(t) * KVBLK; asm volatile("" : "+s"(sb_)); \
      __builtin_amdgcn_global_load_lds((const unsigned*)(sb_ + voff), (LAS unsigned*)((LAS unsigned char*)lds + LDS_VR + (vslot) * SLOT + pdst), 16, 0, 0); \
      __builtin_amdgcn_global_load_lds((const unsigned*)(sb_ + (voff + 16u * SKV)), (LAS unsigned*)((LAS unsigned char*)lds + LDS_VR + (vslot) * SLOT + pdst + 1024u), 16, 0, 0); } } } while (0)
#define DMA_ALL(t, kslot, vslot) do { DMA_PIECE(0, t, kslot, vslot); DMA_PIECE(1, t, kslot, vslot); } while (0)
  int ka[4], va[2];
#pragma unroll
  for (int q = 0; q < 4; ++q) ka[q] = LDS_KR + r32 * 128 + ((((q >> 1) * 4 + 2 * hi + (q & 1)) ^ ((r32 >> 1) & 7)) << 4);
#pragma unroll
  for (int i = 0; i < 2; ++i) va[i] = LDS_VR + r32 * 64 + (((2 * hi + i) ^ ((r32 >> 2) & 3)) << 4);
  const int NT = seq / KVBLK;
  DMA_ALL(0, 0, 0); DMA_ALL(1, 1, 1);
  i32x8_t q8[2];
  { const unsigned char* qp = Q8 + (size_t)(wid * QBLK + r32) * LDQB + 32 * hi;
    q8[0] = __builtin_shufflevector(*(const i32x4_t*)qp, *(const i32x4_t*)(qp + 16), 0, 1, 2, 3, 4, 5, 6, 7);
    q8[1] = __builtin_shufflevector(*(const i32x4_t*)(qp + 64), *(const i32x4_t*)(qp + 80), 0, 1, 2, 3, 4, 5, 6, 7); }
  float m_reg = 0.f; f32x16 o[4]; f32x16 lacc; f32x16 negm; f32x16 pA0, pA1, pB0, pB1; i32x8_t p8;
  const i32x8_t ones8 = {0x38383838, 0x38383838, 0x38383838, 0x38383838, 0x38383838, 0x38383838, 0x38383838, 0x38383838};
  asm volatile("s_waitcnt vmcnt(0) lgkmcnt(0)\n\ts_barrier" ::: "memory");
  { float y0 = Y0; asm volatile("" : "+v"(y0));
#pragma unroll
    for (int r = 0; r < 16; ++r) negm[r] = y0; }
  lacc = (f32x16){}; o[0] = (f32x16){}; o[1] = (f32x16){}; o[2] = (f32x16){}; o[3] = (f32x16){};
#define KFR(kbase, kh, s) ld32(L3 + (kbase) + ka[2 * (s)] + (kh) * 4096, L3 + (kbase) + ka[2 * (s) + 1] + (kh) * 4096)
#define VFR(vbase, db) ld32(L3 + (vbase) + va[0] + (db) * 2048, L3 + (vbase) + va[1] + (db) * 2048)
#define QK_TILE(C0, C1, kbase) do { const i32x8_t k00 = KFR(kbase, 0, 0), k01 = KFR(kbase, 0, 1), k10 = KFR(kbase, 1, 0), k11 = KFR(kbase, 1, 1); \
    mfma8_init(C0, k00, q8[0], negm); mfma8_acc(C0, k01, q8[1]); mfma8_init(C1, k10, q8[0], negm); mfma8_acc(C1, k11, q8[1]); } while (0)
#define ROWMAX_A(C0) float rm_ = fmaxf(C0[0], C0[1]); _Pragma("unroll") for (int r = 2; r < 16; ++r) rm_ = fmaxf(rm_, C0[r]);
#define ROWMAX_B(C1) _Pragma("unroll") for (int r = 0; r < 16; ++r) rm_ = fmaxf(rm_, C1[r]); \
    { auto rr = __builtin_amdgcn_permlane32_swap(__float_as_uint(rm_), __float_as_uint(rm_), false, false); rm_ = fmaxf(__uint_as_float(rr[0]), __uint_as_float(rr[1])); }
#define DECIDE(C0, C1, FIRST) do { if ((FIRST) || __builtin_expect(__any(rm_ > THRY), 0)) { const float dl = (FIRST) ? rm_ - Y0 : fmaxf(rm_ - Y0, 0.f); m_reg += dl; \
      _Pragma("unroll") for (int r = 0; r < 16; ++r) { C0[r] -= dl; C1[r] -= dl; } \
      _Pragma("unroll") for (int r = 0; r < 16; ++r) negm[r] = Y0 - m_reg; \
      if (!(FIRST)) { const float f = __builtin_amdgcn_exp2f(dl * (-1.0f / YS)); if (hi == 0) al_l[r32] = f; asm volatile("s_nop 15\n\ts_nop 15\n\ts_nop 15\n\ts_nop 15\n\ts_nop 15\n\ts_nop 15\n\ts_waitcnt lgkmcnt(0)" ::: "memory"); \
        _Pragma("unroll") for (int r = 0; r < 16; ++r) { const float fr_ = al_l[crow(r, hi)]; o[0][r] *= fr_; o[1][r] *= fr_; o[2][r] *= fr_; o[3][r] *= fr_; lacc[r] *= fr_; } } } } while (0)
#define FINISH(P0, P1) do { \
    p8[0] = PK8(P0, 0); p8[1] = PK8(P0, 4); p8[2] = PK8(P0, 8); p8[3] = PK8(P0, 12); p8[4] = PK8(P1, 0); p8[5] = PK8(P1, 4); p8[6] = PK8(P1, 8); p8[7] = PK8(P1, 12); } while (0)
#define PV_TILE(vbase) do { const i32x8_t v0_ = VFR(vbase, 0), v1_ = VFR(vbase, 1), v2_ = VFR(vbase, 2), v3_ = VFR(vbase, 3); \
    mfma8_acc_pad(o[0], p8, v0_); mfma8_acc(o[1], p8, v1_); mfma8_acc(o[2], p8, v2_); mfma8_acc(o[3], p8, v3_); mfma8_acc(lacc, p8, ones8); } while (0)
#define ITER_(C0, C1, P0, P1, KS, jj, TBAR, HOOK0, HOOK, RD, PF) do { const int vprev_ = (((jj) - 1) & 3) * SLOT; const int tn_ = (jj) + 2 < NT ? (jj) + 2 : NT - 1; const int vs2_ = ((jj) + 2) & 3; \
    if (RD) { kf0 = KFR((KS) * SLOT, 0, 0); kf1 = KFR((KS) * SLOT, 0, 1); } \
    const i32x8_t k10 = KFR((KS) * SLOT, 1, 0), k11 = KFR((KS) * SLOT, 1, 1); \
    mfma8_init(C0, kf0, q8[0], negm); p8[0] = PK8(P0, 0); p8[1] = PK8(P0, 4); SBAR(); \
    mfma8_acc(C0, kf1, q8[1]); p8[2] = PK8(P0, 8); p8[3] = PK8(P0, 12); SBAR(); \
    mfma8_init(C1, k10, q8[0], negm); p8[4] = PK8(P1, 0); p8[5] = PK8(P1, 4); SBAR(); \
    mfma8_acc(C1, k11, q8[1]); p8[6] = PK8(P1, 8); p8[7] = PK8(P1, 12); SBAR(); \
    TBAR; \
    i32x8_t va_ = VFR(vprev_, 0), vb_ = VFR(vprev_, 1); \
    mfma8_acc_pad(o[0], p8, va_); asm volatile("s_nop 7" ::: "memory"); ROWMAX_A(C0); SBAR(); \
    mfma8_acc(o[1], p8, vb_); va_ = VFR(vprev_, 2); vb_ = VFR(vprev_, 3); ROWMAX_B(C1); SBAR(); \
    mfma8_acc(o[2], p8, va_); DMA_PIECE(0, tn_, KS, vs2_); DMA_PIECE(1, tn_, KS, vs2_); SBAR(); \
    mfma8_acc(o[3], p8, vb_); SBAR(); f32x16 bgw; HOOK0; \
    mfma8_acc(lacc, p8, ones8); if (PF) { kf0 = KFR((1 - (KS)) * SLOT, 0, 0); kf1 = KFR((1 - (KS)) * SLOT, 0, 1); } SBAR(); HOOK; \
    DECIDE(C0, C1, false); SBAR(); } while (0)
#define TB0 asm volatile("s_waitcnt vmcnt(0)\n\ts_barrier" ::: "memory")
#define TBK do { if (kvw) asm volatile("s_waitcnt vmcnt(0)" ::: "memory"); asm volatile("s_barrier" ::: "memory"); } while (0)
#define NOHOOK do { } while (0)
#define ITER(C0, C1, P0, P1, KS, jj) ITER_(C0, C1, P0, P1, KS, jj, TB0, NOHOOK, NOHOOK, 0, 1)
  int bg_k = 0, bq = 0, bg_nsh = 12; const char* bg_src = (const char*)bg_wgu; unsigned char* bg_dst = bg_dump;
#define BG_DECODE_SRC(tt) do { int t_ = (tt); \
    if (t_ < 16384) { const int e_ = t_ >> 9, nb_ = (t_ >> 4) & 31, kb_ = t_ & 15; bg_src = (const char*)(bg_wgu + (size_t)e_ * (DM * 2048) + (size_t)kb_ * (64 * 2048) + nb_ * 64); bg_nsh = 13; } \
    else { t_ -= 16384; const int e_ = t_ >> 8, nb_ = (t_ >> 4) & 15, kb_ = t_ & 15; bg_src = (const char*)(bg_wdn + (size_t)e_ * (DFF * DM) + (size_t)kb_ * (64 * 1024) + nb_ * 64); bg_nsh = 12; } } while (0)
#define BG_DECODE_DST(tt) do { int t_ = (tt); \
    if (t_ < 16384) { const int e_ = t_ >> 9, nb_ = (t_ >> 4) & 31, kb_ = t_ & 15; bg_dst = bg_gu8 + (size_t)e_ * (2048 * DM) + (size_t)(256 * ((nb_ & 15) >> 1) + 128 * (nb_ >> 4) + 64 * (nb_ & 1)) * 1024 + kb_ * 64; } \
    else { t_ -= 16384; const int e_ = t_ >> 8, nb_ = (t_ >> 4) & 15, kb_ = t_ & 15; bg_dst = bg_dn8 + (size_t)e_ * (DM * DFF) + (size_t)(nb_ * 64) * 1024 + kb_ * 64; } } while (0)
#define BG_LOAD() do { if (!kvw) { \
    asm volatile("s_waitcnt vmcnt(%0)" :: "n"(5 * (BG_LAG - 1)) : "memory"); \
    int ln_ = __builtin_amdgcn_mbcnt_hi(~0u, __builtin_amdgcn_mbcnt_lo(~0u, 0u)); asm volatile("" : "+v"(ln_)); \
    const LAS float* cp_ = (const LAS float*)((LAS unsigned char*)lds + LDS_BG + bq * BGT + (wid - 4) * 4096) + ln_; \
    _Pragma("unroll") for (int r_ = 0; r_ < 16; ++r_) bgw[r_] = cp_[r_ * 64]; } else { asm volatile("" : "=v"(bgw)); } SBAR(); } while (0)
#define BG_CONV() do { if (!kvw) { \
    const int c_ = bg_k - BG_LAG; if (c_ < 0) bg_dst = bg_dump; else if ((c_ & 15) == 0) BG_DECODE_DST(bg_t0 + c_); else bg_dst += 64; \
    int ln_ = __builtin_amdgcn_mbcnt_hi(~0u, __builtin_amdgcn_mbcnt_lo(~0u, 0u)); asm volatile("" : "+v"(ln_)); \
    const f32x16 ws_ = bgw * WSCALE; u32x4g o_; \
    o_.x = pk4_fp8(ws_[0], ws_[1], ws_[2], ws_[3]); o_.y = pk4_fp8(ws_[4], ws_[5], ws_[6], ws_[7]); o_.z = pk4_fp8(ws_[8], ws_[9], ws_[10], ws_[11]); o_.w = pk4_fp8(ws_[12], ws_[13], ws_[14], ws_[15]); \
    __builtin_nontemporal_store(o_, (u32x4g*)(bg_dst + (unsigned)(ln_ * 1024 + (wid - 4) * 16))); } SBAR(); } while (0)
#define BG_DMA() do { if (!kvw) { \
    if (bg_k < BG_TILES) { if ((bg_k & 15) == 0) BG_DECODE_SRC(bg_t0 + bg_k); else bg_src += (64u << bg_nsh); } \
    int ln_ = __builtin_amdgcn_mbcnt_hi(~0u, __builtin_amdgcn_mbcnt_lo(~0u, 0u)); asm volatile("" : "+v"(ln_)); \
    const unsigned so_ = ((unsigned)((wid - 4) * 16 + (ln_ >> 4)) << bg_nsh) + (unsigned)(ln_ & 15) * 16u; \
    LAS unsigned char* lb_ = (LAS unsigned char*)lds + LDS_BG + bq * BGT + (wid - 4) * 4096; \
    __builtin_amdgcn_global_load_lds((const unsigned*)(bg_src + so_), (LAS unsigned*)lb_, 16, 0, 2); \
    __builtin_amdgcn_global_load_lds((const unsigned*)(bg_src + so_ + (4u << bg_nsh)), (LAS unsigned*)(lb_ + 1024), 16, 0, 2); \
    __builtin_amdgcn_global_load_lds((const unsigned*)(bg_src + so_ + (8u << bg_nsh)), (LAS unsigned*)(lb_ + 2048), 16, 0, 2); \
    __builtin_amdgcn_global_load_lds((const unsigned*)(bg_src + so_ + (12u << bg_nsh)), (LAS unsigned*)(lb_ + 3072), 16, 0, 2); } \
    bq = bq == BG_LAG - 1 ? 0 : bq + 1; ++bg_k; SBAR(); } while (0)
#define ITER_BGA(C0, C1, P0, P1, KS, jj) ITER_(C0, C1, P0, P1, KS, jj, TBK, BG_LOAD(), BG_CONV(), 0, 0)
#define ITER_BGB(C0, C1, P0, P1, KS, jj) ITER_(C0, C1, P0, P1, KS, jj, TBK, BG_DMA(), NOHOOK, 1, 1)
#define ITER_BGP(C0, C1, P0, P1, KS, jj) ITER_(C0, C1, P0, P1, KS, jj, TBK, NOHOOK, NOHOOK, 0, 1)
  i32x8_t kf0, kf1;

  QK_TILE(pA0, pA1, 0);
  { asm volatile("s_nop 15\n\ts_nop 15" ::: "memory"); SBAR(); ROWMAX_A(pA0); ROWMAX_B(pA1); DECIDE(pA0, pA1, true); }
  kf0 = KFR(SLOT, 0, 0); kf1 = KFR(SLOT, 0, 1);
  asm volatile("s_waitcnt vmcnt(0)\n\ts_barrier" ::: "memory");
  DMA_ALL(2, 0, 2);
  int j = 1;
  if constexpr (BG) {
    for (; j < 1 + 4 * (BG_TILES + BG_LAG); j += 4) { ITER_BGA(pB0, pB1, pA0, pA1, 1, j); ITER_BGB(pA0, pA1, pB0, pB1, 0, j + 1); ITER_BGP(pB0, pB1, pA0, pA1, 1, j + 2); ITER_BGP(pA0, pA1, pB0, pB1, 0, j + 3); }
  }
  for (; j + 1 < NT; j += 2) { ITER(pB0, pB1, pA0, pA1, 1, j); ITER(pA0, pA1, pB0, pB1, 0, j + 1); }
  ITER(pB0, pB1, pA0, pA1, 1, j);
  FINISH(pB0, pB1); SBAR();
  PV_TILE(((NT - 1) & 3) * SLOT);
  asm volatile("s_nop 15\n\ts_nop 15" ::: "memory"); SBAR();
  asm volatile("s_nop 15\n\ts_nop 15\n\ts_nop 15\n\ts_nop 15" ::: "memory"); SBAR();
  float rli[16];
#pragma unroll
  for (int r = 0; r < 16; ++r) rli[r] = __builtin_amdgcn_rcpf(lacc[r]);
  { int tid2 = threadIdx.x; asm volatile("" : "+v"(tid2));
    const int hi2 = (tid2 >> 5) & 1; bf16* Ow = Ob + (size_t)((tid2 >> 6) * QBLK) * LDO + (tid2 & 31);
#pragma unroll
    for (int r = 0; r < 16; ++r) { const int orow = crow(r, hi2);
#pragma unroll
      for (int d0 = 0; d0 < 4; ++d0) Ow[(long)orow * LDO + d0 * 32] = __float2bfloat16(o[d0][r] * rli[r]); } }
  asm volatile("s_waitcnt vmcnt(0) lgkmcnt(0)\n\ts_barrier" ::: "memory");
#undef DMA_PIECE
#undef DMA_ALL
#undef KFR
#undef VFR
#undef QK_TILE
#undef ROWMAX_A
#undef ROWMAX_B
#undef DECIDE
#undef FINISH
#undef PV_TILE
#undef ITER
#undef ITER_
#undef ITER_BGA
#undef ITER_BGB
#undef ITER_BGP
#undef TB0
#undef TBK
#undef BG_CONV
#undef BG_DMA
#undef BG_DECODE_SRC
#undef BG_DECODE_DST
#undef BG_LOAD
#undef NOHOOK
}
#undef PK8
#undef SBAR
}

#define XB_TMO      128
#define XB_XCNT(j)  (256  + 64 * (j))
#define XB_XSUB(j)  (1280 + 64 * (j))
#define XB_XGEN(j)  (2304 + 64 * (j))
#define XB_TOP      3328
#define XB_TOPGEN   3392
#define XCD_BAR_WORDS 3456
#define XB_SPIN_CAP (1u << 18)
__device__ __forceinline__ unsigned xb_ld(unsigned* p)              { return __hip_atomic_load(p, __ATOMIC_RELAXED, __HIP_MEMORY_SCOPE_AGENT); }
__device__ __forceinline__ unsigned xb_add(unsigned* p, unsigned v) { return __hip_atomic_fetch_add(p, v, __ATOMIC_RELAXED, __HIP_MEMORY_SCOPE_AGENT); }
__device__ __forceinline__ unsigned xb_xcc_id() { return (unsigned)__builtin_amdgcn_s_getreg((3 << 11) | 20) & 0xFu; }
#define XB_SPIN(cond, bar) do { unsigned _sp = 0; while (cond) { __builtin_amdgcn_s_sleep(1); \
    if ((++_sp & 255u) == 0u) { if (xb_ld(&(bar)[XB_TMO])) break; if (_sp > XB_SPIN_CAP) { atomicAdd(&(bar)[XB_TMO], 1u); break; } } } } while (0)
struct XcdBarrier { unsigned* bar; unsigned x; volatile LAS unsigned* st; };
__device__ __forceinline__ XcdBarrier xcd_barrier_post(unsigned* bar, volatile LAS unsigned* st) {
    XcdBarrier b; b.bar = bar; b.x = xb_xcc_id(); b.st = st;
    if (threadIdx.x == 0) (void)xb_add(&bar[XB_XCNT(b.x)], 1u);
    return b;
}
__device__ __forceinline__ void xcd_barrier_complete(unsigned* bar, unsigned x, unsigned& nloc, unsigned& nx) {
    const unsigned G = gridDim.x * gridDim.y * gridDim.z;
    unsigned sum, cnt, mine, sp = 0u;
    for (;;) {
        sum = 0u; cnt = 0u; mine = 0u;
#pragma unroll
        for (unsigned j = 0; j < 16; ++j) { const unsigned c = xb_ld(&bar[XB_XCNT(j)]); sum += c; cnt += (c > 0u) ? 1u : 0u; mine = (j == x) ? c : mine; }
        if (sum == G) break;
        __builtin_amdgcn_s_sleep(1);
        if ((++sp & 255u) == 0u) { if (xb_ld(&bar[XB_TMO])) break; if (sp > XB_SPIN_CAP) { atomicAdd(&bar[XB_TMO], 1u); break; } }
    }
    nloc = mine > 0u ? mine : 1u; nx = cnt > 0u ? cnt : 1u;
}
__device__ __forceinline__ void xcd_barrier(const XcdBarrier& b) {
    asm volatile("s_waitcnt vmcnt(0)" ::: "memory");
    __syncthreads();
    if (threadIdx.x == 0) {
        unsigned* bar = b.bar;
        __builtin_amdgcn_s_waitcnt(0);
        unsigned nloc = b.st[0], nx = b.st[1];
        if (nloc == 0u) { xcd_barrier_complete(bar, b.x, nloc, nx); b.st[0] = nloc; b.st[1] = nx; }
        const unsigned old = xb_add(&bar[XB_XSUB(b.x)], 1u);
        const unsigned gen = old / nloc;
        if (old + 1u == (gen + 1u) * nloc) {
            __builtin_amdgcn_fence(__ATOMIC_RELEASE, "agent");
            asm volatile("s_waitcnt vmcnt(0)" ::: "memory");
            const unsigned og = xb_add(&bar[XB_TOP], 1u);
            const unsigned tg = og / nx;
            if (og + 1u == (tg + 1u) * nx) xb_add(&bar[XB_TOPGEN], 1u);
            else XB_SPIN(xb_ld(&bar[XB_TOPGEN]) == tg, bar);
            __builtin_amdgcn_fence(__ATOMIC_ACQUIRE, "agent");
            xb_add(&bar[XB_XGEN(b.x)], 1u);
            asm volatile("s_waitcnt vmcnt(0)" ::: "memory");
        } else {
            XB_SPIN(xb_ld(&bar[XB_XGEN(b.x)]) == gen, bar);
            __builtin_amdgcn_fence(__ATOMIC_ACQUIRE, "agent");
            asm volatile("s_waitcnt vmcnt(0)" ::: "memory");
        }
    }
    __syncthreads();
}

struct Args { const float* in[20]; float* out; unsigned char* ws; int ph_lo, ph_hi, li, pad; };
enum { I_X = 0, I_C, I_CTX, I_CCTX, I_WADA, I_BADA, I_G1, I_G2, I_WIN, I_GQ, I_GK, I_WCONV, I_WOUT, I_WR, I_BR, I_WGU, I_BGU, I_WDN, I_BDN, I_GF };

__device__ __forceinline__ void transpose_item64(const float* W, int ldw, bf16_t* WT, int Kd, int k0, int n0, int drow0, LAS float* scr, int lane) {
    const float* src = W + (size_t)k0 * ldw + n0 + lane;
    float v[64];
#pragma unroll
    for (int kk = 0; kk < 64; ++kk) v[kk] = src[(size_t)kk * ldw];
#pragma unroll
    for (int kk = 0; kk < 64; ++kk) scr[kk * 65 + lane] = v[kk];
    asm volatile("s_waitcnt lgkmcnt(0)" ::: "memory");
    const int c = lane & 7;
#pragma unroll
    for (int j = 0; j < 8; ++j) { const int n = (lane >> 3) + 8 * j; const LAS float* s = scr + (8 * c) * 65 + n;
        u32x4 o; o.x = cvt_pk_bf16(s[0 * 65], s[1 * 65]); o.y = cvt_pk_bf16(s[2 * 65], s[3 * 65]); o.z = cvt_pk_bf16(s[4 * 65], s[5 * 65]); o.w = cvt_pk_bf16(s[6 * 65], s[7 * 65]);
        *(GAS u32x4*)(WT + (size_t)(drow0 + n) * Kd + k0 + 8 * c) = o; }
    asm volatile("s_waitcnt lgkmcnt(0)" ::: "memory");
}
__device__ __forceinline__ void transpose_item64_f8(const float* W, int ldw, unsigned char* WT, int Kd, int k0, int n0, int drow0, float sc, LAS float* scr, int lane) {
    const float* src = W + (size_t)k0 * ldw + n0 + lane;
    float v[64];
#pragma unroll
    for (int kk = 0; kk < 64; ++kk) v[kk] = src[(size_t)kk * ldw];
#pragma unroll
    for (int kk = 0; kk < 64; ++kk) scr[kk * 65 + lane] = v[kk];
    asm volatile("s_waitcnt lgkmcnt(0)" ::: "memory");
    const int c = lane & 3;
#pragma unroll
    for (int j = 0; j < 4; ++j) { const int n = (lane >> 2) + 16 * j; const LAS float* sp = scr + (16 * c) * 65 + n;
        u32x4 o; o.x = pk4_fp8(sp[0 * 65] * sc, sp[1 * 65] * sc, sp[2 * 65] * sc, sp[3 * 65] * sc); o.y = pk4_fp8(sp[4 * 65] * sc, sp[5 * 65] * sc, sp[6 * 65] * sc, sp[7 * 65] * sc);
        o.z = pk4_fp8(sp[8 * 65] * sc, sp[9 * 65] * sc, sp[10 * 65] * sc, sp[11 * 65] * sc); o.w = pk4_fp8(sp[12 * 65] * sc, sp[13 * 65] * sc, sp[14 * 65] * sc, sp[15 * 65] * sc);
        *(GAS u32x4*)(WT + (size_t)(drow0 + n) * Kd + k0 + 16 * c) = o; }
    asm volatile("s_waitcnt lgkmcnt(0)" ::: "memory");
}
__device__ __forceinline__ int map_win(int n) { if (n < 1536) return n; if (n < 2048) { const int c = n - 1536; return 1536 + 256 * (c >> 7) + (c & 127); } const int c = n - 2048; return 1536 + 256 * (c >> 7) + 128 + (c & 127); }
__device__ __forceinline__ int map_gu(int n) { if (n < 1024) return 256 * (n >> 7) + (n & 127); const int c = n - 1024; return 256 * (c >> 7) + 128 + (c & 127); }

struct EpiNoPre { };
struct EpiQKV {
    static constexpr bool PERM = true; static constexpr int BMODE = 0; static constexpr bool PRE = false; using Pre = EpiNoPre;
    bf16_t *Q, *Kb, *Vb, *CB, *U; int pn0; float sc;
    __device__ __forceinline__ void operator()(const f32x4 (&acc)[2][2][4][2], const pg8::Unit& u, int wr, int wc, int fr, int fq) const {
        const int pn = u.pn + pn0, pm = u.pm, rloc = wr * 64 + fr, cl = wc * 32 + 8 * fq;
        if (pn >= 6) {
            bf16_t* base = U + (size_t)(pm * 256 + rloc) * CW + 128 * (pn - 6) + cl;
#pragma unroll
            for (int ai = 0; ai < 2; ++ai)
#pragma unroll
                for (int m = 0; m < 4; ++m) { const f32x4 v0 = acc[ai][0][m][0] * acc[ai][1][m][0], v1 = acc[ai][0][m][1] * acc[ai][1][m][1];
                    u32x4 w; w.x = cvt_pk_bf16(v0[0], v0[1]); w.y = cvt_pk_bf16(v0[2], v0[3]); w.z = cvt_pk_bf16(v1[0], v1[1]); w.w = cvt_pk_bf16(v1[2], v1[3]);
                    *(u32x4*)(base + (size_t)(ai * 128 + m * 16) * CW) = w; }
        } else {
            bf16_t* base; int ld;
            if (pn < 2) { base = Q + (size_t)(pm * 256) * QW + 256 * pn; ld = QW; }
            else if (pn < 4) { const int krow0 = pm < 128 ? (pm >> 6) * SKV + (pm & 63) * 256 : (pm - 128) * SKV + SEQ; base = (pn == 2 ? Kb : Vb) + (size_t)krow0 * KVW; ld = KVW; }
            else { base = CB + (size_t)(pm * 256) * CW + 256 * (pn - 4); ld = CW; }
            base += (size_t)rloc * ld + cl;
#pragma unroll
            for (int ai = 0; ai < 2; ++ai)
#pragma unroll
                for (int m = 0; m < 4; ++m)
#pragma unroll
                    for (int bj = 0; bj < 2; ++bj) { const f32x4 v0 = acc[ai][bj][m][0] * sc, v1 = acc[ai][bj][m][1] * sc;
                        u32x4 w; w.x = cvt_pk_bf16(v0[0], v0[1]); w.y = cvt_pk_bf16(v0[2], v0[3]); w.z = cvt_pk_bf16(v1[0], v1[1]); w.w = cvt_pk_bf16(v1[2], v1[3]);
                        *(u32x4*)(base + (size_t)(ai * 128 + m * 16) * ld + bj * 128) = w; }
        }
    }
};
struct QkvOrder {
    pg8::StaticOrder so;
    __device__ __forceinline__ bool next(int i, pg8::Unit& u) const {
        if (so.next(i, u)) return true;
        const long L = (long)i * so.G + so.c - so.nwg; if (L >= 4) return false;
        u.pm = 128 + (int)(L >> 1); u.pn = 2 + (int)(L & 1); u.e = 0; return true;
    }
};
struct EpiResid {
    static constexpr bool PERM = true; static constexpr int BMODE = 0; static constexpr bool PRE = false; using Pre = EpiNoPre;
    const float* gt; bf16_t* d1;
    __device__ __forceinline__ void operator()(const f32x4 (&acc)[2][2][4][2], const pg8::Unit& u, int wr, int wc, int fr, int fq) const {
        const int row0 = u.pm * 256 + wr * 64 + fr, col0 = u.pn * 256 + wc * 32 + 8 * fq, b = u.pm >> 6;
        f32x4 g[2][2];
#pragma unroll
        for (int bj = 0; bj < 2; ++bj)
#pragma unroll
            for (int n = 0; n < 2; ++n) g[bj][n] = *(const f32x4*)(gt + (size_t)b * NMOD + col0 + bj * 128 + n * 4);
#pragma unroll
        for (int ai = 0; ai < 2; ++ai)
#pragma unroll
            for (int m = 0; m < 4; ++m) { bf16_t* dp = d1 + (size_t)(row0 + ai * 128 + m * 16) * DM + col0;
#pragma unroll
                for (int bj = 0; bj < 2; ++bj) { const f32x4 v0 = g[bj][0] * acc[ai][bj][m][0], v1 = g[bj][1] * acc[ai][bj][m][1];
                    u32x4 w; w.x = cvt_pk_bf16(v0[0], v0[1]); w.y = cvt_pk_bf16(v0[2], v0[3]); w.z = cvt_pk_bf16(v1[0], v1[1]); w.w = cvt_pk_bf16(v1[2], v1[3]);
                    *(u32x4*)(dp + bj * 128) = w; } }
    }
};
struct EpiSwiglu {
    static constexpr bool PERM = true; static constexpr int BMODE = 0; static constexpr bool PRE = true;
    struct Pre { f32x4 bg[2], bl[2]; };
    const float* bgu; unsigned char* ACT;
    __device__ __forceinline__ void pre(const pg8::Unit& u, int wr, int wc, int fr, int fq, Pre& p) const {
        const float* bp = bgu + (size_t)u.e * 2048 + 128 * u.pn + wc * 32 + 8 * fq;
#pragma unroll
        for (int n = 0; n < 2; ++n) { p.bg[n] = *(const f32x4*)(bp + 4 * n); p.bl[n] = *(const f32x4*)(bp + 1024 + 4 * n); }
    }
    __device__ __forceinline__ void operator()(const f32x4 (&acc)[2][2][4][2], const pg8::Unit& u, int wr, int wc, int fr, int fq, const Pre& p) const {
        const int cl = wc * 32 + 8 * fq, c0 = 128 * u.pn + cl;
        f32x4 bg[2], bl[2];
#pragma unroll
        for (int n = 0; n < 2; ++n) { bg[n] = p.bg[n]; bl[n] = p.bl[n] + 1.0f; }
        unsigned char* base = ACT + (size_t)(u.pm * 256 + wr * 64 + fr) * DFF + c0;
#pragma unroll
        for (int ai = 0; ai < 2; ++ai)
#pragma unroll
            for (int m = 0; m < 4; ++m) { float o[8];
#pragma unroll
                for (int n = 0; n < 2; ++n)
#pragma unroll
                    for (int i = 0; i < 4; ++i) { float gv = acc[ai][0][m][n][i] * WINV + bg[n][i], lv = acc[ai][1][m][n][i] * WINV + bl[n][i];
                        gv = fminf(gv, 7.0f); lv = fminf(fmaxf(lv, -6.0f), 8.0f);
                        const float sg = __builtin_amdgcn_rcpf(1.0f + __builtin_amdgcn_exp2f(gv * (-1.702f * 1.4426950408889634f)));
                        o[n * 4 + i] = gv * sg * lv; }
                u32x2 w; w.x = pk4_fp8(o[0], o[1], o[2], o[3]); w.y = pk4_fp8(o[4], o[5], o[6], o[7]);
                *(u32x2*)(base + (size_t)(ai * 128 + m * 16) * DFF) = w; }
    }
};
struct EpiDown {
    static constexpr bool PERM = true; static constexpr int BMODE = 1; static constexpr bool PRE = true;
    struct Pre { int dd[2][4]; float gg[2][4]; };
    const float* bd; const int* pinfo; const float* pgate; const LAS int* cntL; const LAS int* ts; unsigned char* YP;
    __device__ __forceinline__ void pre(const pg8::Unit& u, int wr, int wc, int fr, int fq, Pre& p) const {
        const int pos0 = (u.pm - ts[u.e]) * 256 + wr * 64 + fr, cn = cntL[u.e];
#pragma unroll
        for (int ai = 0; ai < 2; ++ai)
#pragma unroll
            for (int m = 0; m < 4; ++m) { const int pos = pos0 + ai * 128 + m * 16; const bool ok = pos < cn; const size_t ix = (size_t)u.e * NTOK + (ok ? pos : 0);
                const int di = pinfo[ix]; const float gi = pgate[ix]; p.dd[ai][m] = ok ? di : -1; p.gg[ai][m] = gi; }
    }
    __device__ __forceinline__ void operator()(const f32x4 (&acc)[2][2][4][2], const pg8::Unit& u, int wr, int wc, int fr, int fq, const Pre& p) const {
        const int c0 = 256 * u.pn + 64 * wc + 16 * fq;
        const float* bp = bd + (size_t)u.e * DM + c0;
        f32x4 bv[2][2];
#pragma unroll
        for (int bj = 0; bj < 2; ++bj)
#pragma unroll
            for (int n = 0; n < 2; ++n) bv[bj][n] = *(const f32x4*)(bp + 8 * bj + 4 * n);
#pragma unroll
        for (int ai = 0; ai < 2; ++ai)
#pragma unroll
            for (int m = 0; m < 4; ++m) { const int d = p.dd[ai][m]; const float gt = p.gg[ai][m];
                if (d >= 0) { u32x4 w;
                    { const f32x4 v0 = (acc[ai][0][m][0] * WINV + bv[0][0]) * gt, v1 = (acc[ai][0][m][1] * WINV + bv[0][1]) * gt; w.x = pk4_fp8(v0[0], v0[1], v0[2], v0[3]); w.y = pk4_fp8(v1[0], v1[1], v1[2], v1[3]); }
                    { const f32x4 v0 = (acc[ai][1][m][0] * WINV + bv[1][0]) * gt, v1 = (acc[ai][1][m][1] * WINV + bv[1][1]) * gt; w.z = pk4_fp8(v0[0], v0[1], v0[2], v0[3]); w.w = pk4_fp8(v1[0], v1[1], v1[2], v1[3]); }
                    *(u32x4*)(YP + (size_t)d * DM + c0) = w; } }
    }
};
struct MoeOrder {
    pg8::StaticOrder so; const LAS int* te;
    __device__ __forceinline__ bool next(int i, pg8::Unit& u) const {
        if (!so.next(i, u)) return false;
        u.e = __builtin_amdgcn_readfirstlane(te[u.pm]); return true;
    }
};
__device__ __forceinline__ int moe_tables(const unsigned* cnt, LAS int* ts, LAS int* te, LAS int* cntL) {
    __syncthreads();
    if (threadIdx.x == 0) { int s = 0; for (int e = 0; e < NEXP; ++e) { const int c = (int)cnt[e]; cntL[e] = c; ts[e] = s; s += (c + 255) >> 8; } ts[NEXP] = s; }
    __syncthreads();
    const int T = ts[NEXP];
    for (int t = threadIdx.x; t < T; t += 512) { int e = 0; while (e < NEXP - 1 && t >= ts[e + 1]) ++e; te[t] = e; }
    __syncthreads();
    return T;
}

__global__ void __launch_bounds__(512, 2) fwd_kernel(Args args) {
    extern __shared__ __attribute__((aligned(16))) unsigned char lds[];
    LAS unsigned char* L = (LAS unsigned char*)lds;
    LAS unsigned* MISC = (LAS unsigned*)(L + MISC_OFF);
    const int wave = __builtin_amdgcn_readfirstlane(threadIdx.x >> 6);
#define PHASE_IDS int tid = threadIdx.x; asm volatile("" : "+v"(tid)); const int lane = tid & 63; (void)lane
    const int G = gridDim.x, bx = blockIdx.x;
    const int vcu = (G % 8 == 0) ? (bx % 8) * (G / 8) + bx / 8 : bx;
    const int gw = vcu * 8 + wave, NGW = G * 8;
    const bool bg_on = G * 2 * attn8::BG_TILES == NEXP * (16 * 32 + 16 * 16);
    unsigned char* ws = args.ws;
    unsigned* ctl = (unsigned*)(ws + WS_CTL);
    const float* x = args.in[I_X];
    float* mod = (float*)(ws + WS_MOD); float* rope = (float*)(ws + WS_ROPE); float* wrt = (float*)(ws + WS_WRT);
    unsigned char* WIN8 = ws + WS_WIN8; unsigned char* H8 = ws + WS_H8;
    bf16_t* WIN = (bf16_t*)(ws + WS_WIN); bf16_t* WOUT = (bf16_t*)(ws + WS_WOUT); unsigned char* WGU8 = ws + WS_WGU; unsigned char* WDN8 = ws + WS_WDN;
    bf16_t* Hb = (bf16_t*)(ws + WS_H); bf16_t* Qb = (bf16_t*)(ws + WS_Q); bf16_t* Kb = (bf16_t*)(ws + WS_K); bf16_t* Vb = (bf16_t*)(ws + WS_V);
    unsigned char* Q8 = ws + WS_Q8; unsigned char* K8 = ws + WS_K8; unsigned char* V8T = ws + WS_V8T;
    bf16_t* CBb = (bf16_t*)(ws + WS_CB); bf16_t* Ub = (bf16_t*)(ws + WS_U); bf16_t* MIX = (bf16_t*)(ws + WS_MIX);
    bf16_t* D1 = (bf16_t*)(ws + WS_X1); bf16_t* X1B = (bf16_t*)(ws + WS_X1 + 64 * MiB); unsigned char* H28 = ws + WS_H2;
    int* PINFO = (int*)(ws + WS_PINFO); float* PGATE = (float*)(ws + WS_PGATE);
    unsigned char* ACT8 = ws + WS_ACT; unsigned char* YP = ws + WS_YP;
    unsigned* cnt = ctl + CW_CNT;

    for (int u = threadIdx.x; u < (LDS_BYTES - MISC_OFF) / 4; u += 512) MISC[u] = 0u;
    __syncthreads();
    XcdBarrier bar; bar.bar = ctl + CW_BAR + args.li * XCD_BAR_WORDS; bar.x = 0; bar.st = nullptr;
#if !MK_PER_PHASE
    bar = xcd_barrier_post(ctl + CW_BAR + args.li * XCD_BAR_WORDS, (volatile LAS unsigned*)(MISC + MO_BAR / 4));
#endif
    const int lo = args.ph_lo, hi = args.ph_hi;
#define IN(k) (lo <= (k) && (k) < hi)
#if MK_PER_PHASE
#define SEAM(k) do { } while (0)
#else
#define SEAM(k) do { if (IN(k) && IN((k) + 1)) xcd_barrier(bar); } while (0)
#endif

    if (IN(0)) {
        PHASE_IDS;
        {
            LAS float* sv = (LAS float*)L;
            LAS float* red = sv + 3 * DM;
            const float* w_ada = args.in[I_WADA]; const float* b_ada = args.in[I_BADA];
            for (int item = bx; item < NMOD / 32; item += G) {
                __syncthreads();
                for (int i = tid; i < 3 * DM; i += 512) { const int j = i >> 10, k = i & 1023; const float cv = j < 2 ? args.in[I_C][j * DM + k] : args.in[I_CCTX][k];
                    sv[i] = cv / (1.0f + __expf(-cv)); }
                __syncthreads();
                const int c0 = item * 32, col = lane & 31, ks = lane >> 5;
                float a0 = 0.f, a1 = 0.f, a2 = 0.f;
                const float* wp = w_ada + (size_t)(wave * 128 + ks) * NMOD + c0 + col;
#pragma unroll 16
                for (int i = 0; i < 64; ++i) { const float wv = wp[(size_t)(2 * i) * NMOD]; const int k = wave * 128 + 2 * i + ks;
                    a0 += sv[k] * wv; a1 += sv[DM + k] * wv; a2 += sv[2 * DM + k] * wv; }
                a0 += __shfl_xor(a0, 32); a1 += __shfl_xor(a1, 32); a2 += __shfl_xor(a2, 32);
                if (lane < 32) { red[(wave * 3 + 0) * 32 + col] = a0; red[(wave * 3 + 1) * 32 + col] = a1; red[(wave * 3 + 2) * 32 + col] = a2; }
                __syncthreads();
                if (tid < 96) { const int j = tid >> 5, cc = tid & 31; float s = b_ada[c0 + cc];
#pragma unroll
                    for (int w = 0; w < 8; ++w) s += red[(w * 3 + j) * 32 + cc];
                    mod[(size_t)j * NMOD + c0 + cc] = s; }
            }
            __syncthreads();
        }
        for (int idx = vcu * 512 + tid; idx < 256 * 32; idx += G * 512) {
            const int pos = idx >> 5, i = idx & 31;
            const float invf = exp2f(-(float)(2 * i) * (13.287712379549449f / 64.0f));
            const float ang = (float)pos * invf;
            const double rev = (double)ang * 0.15915494309189535;
            const float fr_ = (float)(rev - rint(rev));
            rope[2 * idx] = __builtin_amdgcn_cosf(fr_); rope[2 * idx + 1] = __builtin_amdgcn_sinf(fr_);
        }
        for (int idx = vcu * 512 + tid; idx < NEXP * DM; idx += G * 512) { const int e = idx >> 10, k = idx & 1023; wrt[idx] = args.in[I_WR][k * NEXP + e]; }
        {
            LAS float* scr = (LAS float*)(L + wave * 16640);
            constexpr int I_IN = 16 * 40, I_OUT = 16 * 16, I_GU1 = 16 * 32, I_DN1 = 16 * 16;
            constexpr int NITEMS = I_IN + I_OUT + NEXP * I_GU1 + NEXP * I_DN1;
            const int nitems = bg_on ? I_IN + I_OUT : NITEMS;
            for (int it = gw; it < nitems; it += NGW) {
                int r = it;
                if (r < I_IN) { const int kb = r / 40, nb = r % 40; if (nb < 16) transpose_item64_f8(args.in[I_WIN], INC, WIN8, DM, 64 * kb, 64 * nb, 64 * nb, WSCALE, scr, lane);
                    else transpose_item64(args.in[I_WIN], INC, WIN, DM, 64 * kb, 64 * nb, map_win(64 * nb), scr, lane); continue; } r -= I_IN;
                if (r < I_OUT) { const int kb = r / 16, nb = r % 16; transpose_item64(args.in[I_WOUT], DM, WOUT, DM, 64 * kb, 64 * nb, 64 * nb, scr, lane); continue; } r -= I_OUT;
                if (r < NEXP * I_GU1) { const int e = r / I_GU1, q = r % I_GU1, kb = q / 32, nb = q % 32;
                    transpose_item64_f8(args.in[I_WGU] + (size_t)e * DM * 2048, 2048, WGU8 + (size_t)e * 2048 * DM, DM, 64 * kb, 64 * nb, map_gu(64 * nb), WSCALE, scr, lane); continue; } r -= NEXP * I_GU1;
                { const int e = r / I_DN1, q = r % I_DN1, kb = q / 16, nb = q % 16;
                    transpose_item64_f8(args.in[I_WDN] + (size_t)e * DFF * DM, DM, WDN8 + (size_t)e * DM * DFF, DFF, 64 * kb, 64 * nb, 64 * nb, WSCALE, scr, lane); }
            }
        }
    }
    SEAM(0);

    if (IN(1)) {
        PHASE_IDS;
        const float* g1 = args.in[I_G1];
        int curm = -1; f32x4 gs[4], sh[4];
        for (int r0 = gw * 2; r0 < MROWS; r0 += NGW * 2) {
            const int mb = r0 < NTOK ? (r0 >> 14) : 2;
            if (mb != curm) { curm = mb;
#pragma unroll
                for (int j = 0; j < 4; ++j) { const int c = 4 * lane + 256 * j; const f32x4 g = *(const f32x4*)(g1 + c), s = *(const f32x4*)(mod + (size_t)mb * NMOD + DM + c);
                    gs[j] = g * (s + 1.0f); sh[j] = *(const f32x4*)(mod + (size_t)mb * NMOD + c); } }
            f32x4 v[2][4]; float ss[2] = {0.f, 0.f};
#pragma unroll
            for (int q = 0; q < 2; ++q) { const int r = r0 + q;
                const float* src = r < NTOK ? x + (size_t)r * DM : args.in[I_CTX] + (size_t)(r - NTOK) * DM;
                const GAS f32x4* xr = (const GAS f32x4*)src + lane;
#pragma unroll
                for (int j = 0; j < 4; ++j) { v[q][j] = xr[64 * j]; ss[q] += (v[q][j].x * v[q][j].x + v[q][j].y * v[q][j].y) + (v[q][j].z * v[q][j].z + v[q][j].w * v[q][j].w); } }
#pragma unroll
            for (int q = 0; q < 2; ++q) { const int r = r0 + q;
                const float rstd = rsqrtf(wave_sum(ss[q]) * (1.f / DM) + NORM_EPS);
                GAS u32x2* o8 = (GAS u32x2*)(Hb + (size_t)r * DM) + lane;
                GAS unsigned* o4 = (GAS unsigned*)(H8 + (size_t)r * DM) + lane;
#pragma unroll
                for (int j = 0; j < 4; ++j) { const f32x4 y = v[q][j] * rstd * gs[j] + sh[j]; u32x2 w; w.x = cvt_pk_bf16(y.x, y.y); w.y = cvt_pk_bf16(y.z, y.w); o8[64 * j] = w; o4[64 * j] = pk4_fp8(y.x, y.y, y.z, y.w); } }
        }
    }
    SEAM(1);

    if (IN(2)) {
        {
            pg8::Gemm g{(const bf16_t*)H8, (const bf16_t*)WIN8, MROWS, 1024, DM / 2, 0, nullptr, nullptr, nullptr, 0};
            QkvOrder S; S.so.init(NTOK / 256, 4, G, bx);
            EpiQKV E{Qb, Kb, Vb, CBb, Ub, 0, WINV};
            pg8::gemm_phase<EpiQKV, QkvOrder, true, true, true>(L, g, S, E);
        }
        {
            pg8::Gemm g{Hb, WIN + (size_t)1024 * DM, NTOK, INC - 1024, DM, 0, nullptr, nullptr, nullptr, 0};
            pg8::StaticOrder S; S.init(NTOK / 256, 6, G, bx);
            EpiQKV E{Qb, Kb, Vb, CBb, Ub, 4, 1.0f};
            pg8::gemm_phase<EpiQKV, pg8::StaticOrder, true, true>(L, g, S, E);
        }
    }
    SEAM(2);

    if (IN(3)) {
        PHASE_IDS;
        const float* gq = args.in[I_GQ]; const float* gk = args.in[I_GK]; const float* wconv = args.in[I_WCONV];
        const f32x2 gq2 = *(const f32x2*)(gq + 2 * lane), gk2 = *(const f32x2*)(gk + 2 * lane);
        float cw0[8], cw1[8], cw2[8];
#pragma unroll
        for (int i = 0; i < 8; ++i) { cw0[i] = wconv[8 * lane + i]; cw1[i] = wconv[CW + 8 * lane + i]; cw2[i] = wconv[2 * CW + 8 * lane + i]; }
        const int hb4 = (lane >> 4) & 1;
        for (int chunk = gw; chunk < NTOK / 16; chunk += NGW) {
            const int r0 = chunk * 16;
            u32x4 up, uc, un; { const int t0 = r0 & (SEQ - 1); up = t0 == 0 ? (u32x4){0, 0, 0, 0} : *(const u32x4*)(Ub + (size_t)(r0 - 1) * CW + 8 * lane); uc = *(const u32x4*)(Ub + (size_t)r0 * CW + 8 * lane); }
            for (int rr = 0; rr < 16; ++rr) {
                const int r = r0 + rr, b = r >> 14, t = r & (SEQ - 1), prow = t >> 6, pcol = t & 63;
                un = t == SEQ - 1 ? (u32x4){0, 0, 0, 0} : *(const u32x4*)(Ub + (size_t)(r + 1) * CW + 8 * lane);
                const f32x4 cs = *(const f32x4*)(rope + ((size_t)((lane >> 5) ? pcol : prow) * 32 + 2 * (lane & 15)) * 2);
                unsigned qv[4], kv[2];
#pragma unroll
                for (int h = 0; h < 4; ++h) qv[h] = *(const unsigned*)(Qb + (size_t)r * QW + h * HD + 2 * lane);
                bf16_t* krow = Kb + ((size_t)b * SKV + t) * KVW;
#pragma unroll
                for (int h = 0; h < 2; ++h) kv[h] = *(const unsigned*)(krow + h * HD + 2 * lane);
#pragma unroll
                for (int h = 0; h < 6; ++h) {
                    const unsigned w = h < 4 ? qv[h] : kv[h - 4]; const f32x2 g2 = h < 4 ? gq2 : gk2;
                    float a = bf_lo(w), c = bf_hi(w);
                    const float rstd = rsqrtf(wave_sum(a * a + c * c) * (1.f / HD) + NORM_EPS);
                    a = a * rstd * g2.x; c = c * rstd * g2.y;
                    const float pa = __shfl_xor(a, 16), pc = __shfl_xor(c, 16);
                    const float oa = hb4 ? a * cs.x + pa * cs.y : a * cs.x - pa * cs.y;
                    const float oc = hb4 ? c * cs.z + pc * cs.w : c * cs.z - pc * cs.w;
                    if (h < 4) *(unsigned short*)(Q8 + (size_t)r * QW + h * HD + 2 * lane) = (unsigned short)__builtin_amdgcn_cvt_pk_fp8_f32(oa * (QSCALE * attn8::YS), oc * (QSCALE * attn8::YS), 0, false);
                    else *(unsigned short*)(K8 + ((size_t)b * SKV + t) * KVW + (h - 4) * HD + 2 * lane) = (unsigned short)__builtin_amdgcn_cvt_pk_fp8_f32(oa, oc, 0, false);
                }
                const u32x4 cbv = *(const u32x4*)(CBb + (size_t)r * CW + 8 * lane);
                u32x4 ov;
#pragma unroll
                for (int q = 0; q < 4; ++q) {
                    const float y0 = bf_lo(up[q]) * cw0[2 * q] + bf_lo(uc[q]) * cw1[2 * q] + bf_lo(un[q]) * cw2[2 * q];
                    const float y1 = bf_hi(up[q]) * cw0[2 * q + 1] + bf_hi(uc[q]) * cw1[2 * q + 1] + bf_hi(un[q]) * cw2[2 * q + 1];
                    ov[q] = cvt_pk_bf16(bf_lo(cbv[q]) * y0, bf_hi(cbv[q]) * y1);
                }
                *(u32x4*)(MIX + (size_t)r * DM + QW + 8 * lane) = ov;
                up = uc; uc = un;
            }
        }
        for (int cr = gw; cr < NCTX; cr += NGW) {
            bf16_t* krow = Kb + ((size_t)(cr >> 8) * SKV + SEQ + (cr & 255)) * KVW;
#pragma unroll
            for (int h = 0; h < 2; ++h) { const unsigned w = *(const unsigned*)(krow + h * HD + 2 * lane); float a = bf_lo(w), c = bf_hi(w);
                const float rstd = rsqrtf(wave_sum(a * a + c * c) * (1.f / HD) + NORM_EPS);
                *(unsigned short*)(K8 + ((size_t)(cr >> 8) * SKV + SEQ + (cr & 255)) * KVW + h * HD + 2 * lane) = (unsigned short)__builtin_amdgcn_cvt_pk_fp8_f32(a * rstd * gk2.x, c * rstd * gk2.y, 0, false); }
        }
        {
            LAS unsigned short* vt = (LAS unsigned short*)L;
            for (int item = bx; item < BATCH * (SKV / 64); item += G) {
                const int b = item / (SKV / 64), t64 = item % (SKV / 64);
                __syncthreads();
#pragma unroll
                for (int i = 0; i < 4; ++i) { const int cid = tid + 512 * i, row = cid >> 5, c16 = cid & 31;
                    *(LAS u32x4*)(vt + row * 264 + c16 * 8) = *(const u32x4*)(Vb + ((size_t)b * SKV + 64 * t64 + row) * KVW + c16 * 8); }
                __syncthreads();
                const int dr = tid >> 1, h = tid & 1; unsigned w[8];
#pragma unroll
                for (int q = 0; q < 8; ++q) { float f[4];
#pragma unroll
                    for (int i = 0; i < 4; ++i) { const int j = 4 * q + i, r = j & 15, key = 32 * (j >> 4) + (r & 3) + 8 * (r >> 2) + 4 * h; f[i] = __uint_as_float((unsigned)vt[key * 264 + dr] << 16); }
                    w[q] = pk4_fp8(f[0], f[1], f[2], f[3]); }
                unsigned char* dst = V8T + ((size_t)(b * 2 + (dr >> 7)) * HD + (dr & 127)) * SKV + 64 * t64 + 32 * h;
                *(u32x4*)dst = (u32x4){w[0], w[1], w[2], w[3]}; *(u32x4*)(dst + 16) = (u32x4){w[4], w[5], w[6], w[7]};
            }
            __syncthreads();
        }
    }
    SEAM(3);

    if (IN(4)) {
        PHASE_IDS;
        for (int i = 0;; ++i) {
            const int U = i * G + vcu; if (U >= BATCH * NQH * (SEQ / 256)) break;
            const int combo = U >> 7, hl = (U >> 6) & 1, qb = U & 63, b = combo >> 1, kvh = combo & 1, hq = kvh * 2 + hl;
            attn8::bf16* Op = (attn8::bf16*)MIX + ((size_t)(b * SEQ + qb * 256)) * DM + hq * HD;
            if (bg_on && i < 2) attn8::attn_body<true>(Q8 + ((size_t)(b * SEQ + qb * 256)) * QW + hq * HD, K8 + (size_t)b * SKV * KVW + kvh * HD, V8T + (size_t)(b * 2 + kvh) * HD * SKV, Op, SKV, (char*)lds,
                (vcu * 2 + i) * attn8::BG_TILES, args.in[I_WGU], args.in[I_WDN], WGU8, WDN8, ws + WS_ACT + 150 * MiB);
            else attn8::attn_body<false>(Q8 + ((size_t)(b * SEQ + qb * 256)) * QW + hq * HD, K8 + (size_t)b * SKV * KVW + kvh * HD, V8T + (size_t)(b * 2 + kvh) * HD * SKV, Op, SKV, (char*)lds,
                0, nullptr, nullptr, nullptr, nullptr, nullptr);
            __syncthreads();
        }
    }
    SEAM(4);

    if (IN(5)) {
#if MK_ATTN_CHECK
        {
            PHASE_IDS;
            LAS float* red = (LAS float*)L;
            LAS unsigned* mx = (LAS unsigned*)(L + 8192);
            for (int ci = 0; ci < 4; ++ci) {
                const unsigned U = (unsigned)bx * 4u + (unsigned)ci; const int b = U & 1, hq = (U >> 1) & 3, kvh = hq >> 1, t = (int)((U * 2654435761u >> 7) % (unsigned)SEQ);
                __syncthreads(); if (tid < 2) mx[tid] = 0u; __syncthreads();
                const unsigned qw = *(const unsigned short*)(Q8 + ((size_t)(b * SEQ + t)) * QW + hq * HD + 2 * lane); const float q0 = __builtin_amdgcn_cvt_f32_fp8((int)qw, 0), q1 = __builtin_amdgcn_cvt_f32_fp8((int)qw, 1);
                float lsum = 0.f, o0 = 0.f, o1 = 0.f;
                for (int key = wave; key < SKV; key += 8) {
                    const unsigned kw = *(const unsigned short*)(K8 + ((size_t)b * SKV + key) * KVW + kvh * HD + 2 * lane);
                    const int kl = key & 63, tt = kl >> 5, cc = kl & 31, hh = (cc >> 2) & 1, rr2 = (cc & 3) + 4 * (cc >> 3), pos = (key & ~63) + 32 * hh + 16 * tt + rr2;
                    const unsigned char* vp = V8T + ((size_t)(b * 2 + kvh) * HD + 2 * lane) * SKV + pos;
                    const float v0 = __builtin_amdgcn_cvt_f32_fp8((int)vp[0], 0), v1 = __builtin_amdgcn_cvt_f32_fp8((int)vp[SKV], 0);
                    const float dot = wave_sum(q0 * __builtin_amdgcn_cvt_f32_fp8((int)kw, 0) + q1 * __builtin_amdgcn_cvt_f32_fp8((int)kw, 1)); const float p = exp2f(dot * (1.0f / attn8::YS));
                    lsum += p; o0 += p * v0; o1 += p * v1; }
                red[wave * 132 + 2 * lane] = o0; red[wave * 132 + 2 * lane + 1] = o1; if (lane == 0) red[wave * 132 + 128] = lsum;
                __syncthreads();
                if (tid < 128) { float os = 0.f, ls = 0.f;
                    for (int w = 0; w < 8; ++w) { os += red[w * 132 + tid]; ls += red[w * 132 + 128]; }
                    const float ref = os / ls; const unsigned short mv = *(const unsigned short*)(MIX + ((size_t)(b * SEQ + t)) * DM + hq * HD + tid); const float got = __uint_as_float((unsigned)mv << 16);
                    float err = fabsf(got - ref); if (!(err == err)) err = 1e30f;
                    atomicMax((unsigned*)&mx[0], __float_as_uint(err)); atomicMax((unsigned*)&mx[1], __float_as_uint(fabsf(ref))); }
                __syncthreads();
                if (tid == 0) { const float e = __uint_as_float(mx[0]), r = __uint_as_float(mx[1]); if (e > 0.08f * r + 1e-5f) atomicOr(ctl + CW_FLAG, 1u); }
            }
            __syncthreads();
        }
#endif
        pg8::Gemm g{MIX, WOUT, NTOK, DM, DM, 0, nullptr, nullptr, nullptr, 0};
        pg8::StaticOrder S; S.init(NTOK / 256, DM / 256, G, bx);
        EpiResid E{mod + 2 * DM, D1};
        pg8::gemm_phase<EpiResid, pg8::StaticOrder, true, true>(L, g, S, E);
    }
    SEAM(5);

    if (IN(6)) {
        PHASE_IDS;
        LAS float* wl = (LAS float*)L;
        for (int i = tid; i < NEXP * DM / 4; i += 512) ((LAS f32x4*)wl)[i] = ((const f32x4*)wrt)[i];
        LAS int* hist = (LAS int*)(MISC + MO_HIST / 4); LAS int* baseL = (LAS int*)(MISC + MO_BASE / 4);
        LAS int* sele = (LAS int*)(MISC + MO_SELE / 4); LAS float* selg = (LAS float*)(MISC + MO_SELG / 4);
        const float* g2 = args.in[I_G2]; const float* brt = args.in[I_BR];
        const float br_l = brt[8 * (lane >> 4) + (lane & 7)];
        if (bx == 0 && tid < 64) ((u32x4*)(H28 + (size_t)NTOK * DM))[tid] = (u32x4){0, 0, 0, 0};
        for (int tb = bx; tb < NTOK / 128; tb += G) {
            __syncthreads();
            if (tid < NEXP) hist[tid] = 0;
            __syncthreads();
            const int b = (tb * 128) >> 14;
            f32x4 gs[4], sh[4];
            { int lo_ = lane; asm volatile("" : "+v"(lo_));
#pragma unroll
              for (int j = 0; j < 4; ++j) { const int c = 4 * lo_ + 256 * j; const f32x4 g = *(const f32x4*)(g2 + c), s = *(const f32x4*)(mod + (size_t)b * NMOD + 4 * DM + c);
                gs[j] = g * (s + 1.0f); sh[j] = *(const f32x4*)(mod + (size_t)b * NMOD + 3 * DM + c); } }
            f32x4 xq[2][4]; u32x2 dq[2][4];
#define P6_LOAD(G_) do { _Pragma("unroll") for (int rr = 0; rr < 2; ++rr) { const int r = tb * 128 + wave * 16 + (G_) * 2 + rr; \
                const GAS f32x4* xr = (const GAS f32x4*)(x + (size_t)r * DM) + lane; const GAS u32x2* dr = (const GAS u32x2*)(D1 + (size_t)r * DM) + lane; \
                _Pragma("unroll") for (int j = 0; j < 4; ++j) { xq[rr][j] = xr[64 * j]; dq[rr][j] = dr[64 * j]; } } } while (0)
            P6_LOAD(0);
#pragma unroll 1
            for (int grp = 0; grp < 8; ++grp) {
                const int tl0 = wave * 16 + grp * 2;
                f32x4 v[2][4];
#pragma unroll
                for (int rr = 0; rr < 2; ++rr)
#pragma unroll
                    for (int j = 0; j < 4; ++j) v[rr][j] = xq[rr][j] + (f32x4){bf_lo(dq[rr][j].x), bf_hi(dq[rr][j].x), bf_lo(dq[rr][j].y), bf_hi(dq[rr][j].y)};
                __builtin_amdgcn_sched_barrier(0);
                { const int gn = grp + 1 < 8 ? grp + 1 : 7; P6_LOAD(gn); }
                __builtin_amdgcn_sched_barrier(0);
#pragma unroll
                for (int rr = 0; rr < 2; ++rr) { const int r = tb * 128 + tl0 + rr; float s = 0.f;
#pragma unroll
                    for (int j = 0; j < 4; ++j) s += (v[rr][j].x * v[rr][j].x + v[rr][j].y * v[rr][j].y) + (v[rr][j].z * v[rr][j].z + v[rr][j].w * v[rr][j].w);
                    const float rstd = rsqrtf(wave_sum(s) * (1.f / DM) + NORM_EPS);
                    GAS unsigned* o4 = (GAS unsigned*)(H28 + (size_t)r * DM) + lane;
                    GAS u32x2* x1w = (GAS u32x2*)(X1B + (size_t)r * DM) + lane;
#pragma unroll
                    for (int j = 0; j < 4; ++j) { x1w[64 * j] = (u32x2){cvt_pk_bf16(v[rr][j].x, v[rr][j].y), cvt_pk_bf16(v[rr][j].z, v[rr][j].w)};
                        v[rr][j] = v[rr][j] * rstd * gs[j] + sh[j]; o4[64 * j] = pk4_fp8(v[rr][j].x, v[rr][j].y, v[rr][j].z, v[rr][j].w); } }
                float lg[2];
                {
                    float q[2][16];
#pragma unroll
                    for (int i = 0; i < 16; ++i) {
                        float pa[2], pb[2];
#pragma unroll
                        for (int h2 = 0; h2 < 2; ++h2) { const int e = i + 16 * h2;
                            f32x4 w[4];
#pragma unroll
                            for (int j = 0; j < 4; ++j) w[j] = *(const LAS f32x4*)(wl + e * DM + 4 * lane + 256 * j);
#pragma unroll
                            for (int rr = 0; rr < 2; ++rr) {
                                f32x2 a = __builtin_shufflevector(v[rr][0], v[rr][0], 0, 1) * __builtin_shufflevector(w[0], w[0], 0, 1);
                                a = __builtin_elementwise_fma(__builtin_shufflevector(v[rr][0], v[rr][0], 2, 3), __builtin_shufflevector(w[0], w[0], 2, 3), a);
#pragma unroll
                                for (int j = 1; j < 4; ++j) { a = __builtin_elementwise_fma(__builtin_shufflevector(v[rr][j], v[rr][j], 0, 1), __builtin_shufflevector(w[j], w[j], 0, 1), a);
                                    a = __builtin_elementwise_fma(__builtin_shufflevector(v[rr][j], v[rr][j], 2, 3), __builtin_shufflevector(w[j], w[j], 2, 3), a); }
                                (h2 ? pb : pa)[rr] = a.x + a.y; } }
#pragma unroll
                        for (int rr = 0; rr < 2; ++rr) { auto r = __builtin_amdgcn_permlane32_swap(__float_as_uint(pa[rr]), __float_as_uint(pb[rr]), false, false); q[rr][i] = __uint_as_float(r[0]) + __uint_as_float(r[1]); }
                        __builtin_amdgcn_sched_barrier(0);
                    }
#pragma unroll
                    for (int rr = 0; rr < 2; ++rr) {
                        float t8[8];
#pragma unroll
                        for (int i = 0; i < 8; ++i) { auto r = __builtin_amdgcn_permlane16_swap(__float_as_uint(q[rr][i]), __float_as_uint(q[rr][i + 8]), false, false); float t = __uint_as_float(r[0]) + __uint_as_float(r[1]);
                            t += dpp_f<0xB1>(t); t += dpp_f<0x4E>(t); t += dpp_f<0x141>(t); t += dpp_f<0x140>(t); t8[i] = t; }
                        const float a0 = (lane & 1) ? t8[1] : t8[0], a1 = (lane & 1) ? t8[3] : t8[2], a2 = (lane & 1) ? t8[5] : t8[4], a3 = (lane & 1) ? t8[7] : t8[6];
                        const float b0 = (lane & 2) ? a1 : a0, b1 = (lane & 2) ? a3 : a2;
                        lg[rr] = (lane & 4) ? b1 : b0;
                    }
                }
                const int e_l = 8 * (lane >> 4) + (lane & 7);
#pragma unroll
                for (int rr = 0; rr < 2; ++rr) {
                    float val = lg[rr] + br_l; int si[4]; float sv4[4];
#pragma unroll
                    for (int k = 0; k < 4; ++k) { float m = half_max(val);
                        { auto r = __builtin_amdgcn_permlane32_swap(__float_as_uint(m), __float_as_uint(m), false, false); m = fmaxf(__uint_as_float(r[0]), __uint_as_float(r[1])); }
                        const unsigned long long bal = __ballot(val == m);
                        const int fl = __builtin_amdgcn_readfirstlane(__ffsll((long long)bal) - 1);
                        const int idx = 8 * (fl >> 4) + (fl & 7);
                        si[k] = idx; sv4[k] = m;
                        if (e_l == idx) val = -INFINITY; }
                    const float e1 = __expf(sv4[1] - sv4[0]), e2 = __expf(sv4[2] - sv4[0]), e3 = __expf(sv4[3] - sv4[0]);
                    const float inv = 1.0f / (1.0f + e1 + e2 + e3);
                    if (lane < 4) { const int e = lane == 0 ? si[0] : lane == 1 ? si[1] : lane == 2 ? si[2] : si[3];
                        const float gt = (lane == 0 ? 1.0f : lane == 1 ? e1 : lane == 2 ? e2 : e3) * inv;
                        const int rank = __hip_atomic_fetch_add(hist + e, 1, __ATOMIC_RELAXED, __HIP_MEMORY_SCOPE_WORKGROUP);
                        sele[(tl0 + rr) * 4 + lane] = e | (rank << 8); selg[(tl0 + rr) * 4 + lane] = gt; }
                }
            }
#undef P6_LOAD
            __syncthreads();
            if (tid < NEXP) baseL[tid] = (int)atomicAdd(&cnt[tid], (unsigned)hist[tid]);
            __syncthreads();
            { const int v = sele[tid], e = v & 31, pos = baseL[e] + (v >> 8);
              PINFO[(size_t)e * NTOK + pos] = (tb * 128 + (tid >> 2)) * 4 + (tid & 3); PGATE[(size_t)e * NTOK + pos] = selg[tid]; }
        }
    }
    SEAM(6);


    if (IN(8)) {
        LAS int* ts = (LAS int*)(MISC + MO_TS / 4); LAS int* te = (LAS int*)(MISC + MO_TE / 4);
        const int T = moe_tables(cnt, ts, te, (LAS int*)(MISC + MO_HIST / 4));
        pg8::Gemm g{(const bf16_t*)H28, (const bf16_t*)WGU8, T * 256, 2048, DM / 2, (size_t)2048 * DM, PINFO, cnt, ts, NTOK};
        MoeOrder S; S.so.init(T, 8, G, bx); S.te = te;
        EpiSwiglu E{args.in[I_BGU], ACT8};
        pg8::gemm_phase<EpiSwiglu, MoeOrder, true, true, true, true>(L, g, S, E);
    }
    SEAM(8);

    if (IN(9)) {
        LAS int* ts = (LAS int*)(MISC + MO_TS / 4); LAS int* te = (LAS int*)(MISC + MO_TE / 4);
        LAS int* cntL = (LAS int*)(MISC + MO_HIST / 4);
        const int T = moe_tables(cnt, ts, te, cntL);
        pg8::Gemm g{(const bf16_t*)ACT8, (const bf16_t*)WDN8, T * 256, DM, DFF / 2, (size_t)DM * DFF, nullptr, nullptr, nullptr, 0};
        MoeOrder S; S.so.init(T, 4, G, bx); S.te = te;
        EpiDown E{args.in[I_BDN], PINFO, PGATE, cntL, ts, YP};
        pg8::gemm_phase<EpiDown, MoeOrder, true, true, true>(L, g, S, E);
    }
    SEAM(9);

    if (IN(10)) {
        PHASE_IDS;
        const float* gf = args.in[I_GF];
        f32x4 gfv[4];
#pragma unroll
        for (int j = 0; j < 4; ++j) gfv[j] = *(const f32x4*)(gf + 4 * lane + 256 * j);
        int curb = -1; f32x4 gtv[4];
        for (int r0 = gw * 2; r0 < NTOK; r0 += NGW * 2) {
            const int b = r0 >> 14;
            if (b != curb) { curb = b;
#pragma unroll
                for (int j = 0; j < 4; ++j) gtv[j] = *(const f32x4*)(mod + (size_t)b * NMOD + 5 * DM + 4 * lane + 256 * j); }
            f32x4 v[2][4]; float s[2] = {0.f, 0.f};
#pragma unroll
            for (int q = 0; q < 2; ++q) { const int r = r0 + q;
                const GAS u32x2* dr = (const GAS u32x2*)(X1B + (size_t)r * DM) + lane;
#pragma unroll
                for (int j = 0; j < 4; ++j) {
                    f32x4 y = {0.f, 0.f, 0.f, 0.f};
#pragma unroll
                    for (int k = 0; k < 4; ++k) { const int w = (int)((const GAS unsigned*)(YP + ((size_t)r * 4 + k) * DM))[lane + 64 * j];
                        y.x += __builtin_amdgcn_cvt_f32_fp8(w, 0); y.y += __builtin_amdgcn_cvt_f32_fp8(w, 1); y.z += __builtin_amdgcn_cvt_f32_fp8(w, 2); y.w += __builtin_amdgcn_cvt_f32_fp8(w, 3); }
                    const u32x2 dw = dr[64 * j];
                    v[q][j] = (f32x4){bf_lo(dw.x), bf_hi(dw.x), bf_lo(dw.y), bf_hi(dw.y)} + gtv[j] * y;
                    s[q] += (v[q][j].x * v[q][j].x + v[q][j].y * v[q][j].y) + (v[q][j].z * v[q][j].z + v[q][j].w * v[q][j].w);
                } }
#pragma unroll
            for (int q = 0; q < 2; ++q) { const int r = r0 + q;
                const float rstd = rsqrtf(wave_sum(s[q]) * (1.f / DM) + NORM_EPS);
                GAS f32x4* o = (GAS f32x4*)(args.out + (size_t)r * DM) + lane;
#if MK_ATTN_CHECK
                const float poison = ctl[CW_FLAG] ? __builtin_nanf("") : 0.f;
#pragma unroll
                for (int j = 0; j < 4; ++j) o[64 * j] = v[q][j] * rstd * gfv[j] + poison;
#else
#pragma unroll
                for (int j = 0; j < 4; ++j) o[64 * j] = v[q][j] * rstd * gfv[j];
#endif
            }
        }
    }
#undef IN
#undef SEAM
#undef PHASE_IDS
}

extern "C" void kernel_launch(void* const* d_in, const int* in_sizes, int n_in, void* d_out, int out_size, void* d_ws, size_t ws_size, hipStream_t stream) {
    static int grid = 0;
    if (grid == 0) {
        if (n_in != 20 || in_sizes[0] != NTOK * DM || out_size != NTOK * DM || ws_size < WS_END) {
            fprintf(stderr, "kernel_launch: shape mismatch (n_in %d, in0 %d, out %d, ws %zu; need ws >= %zu); nothing launched\n", n_in, n_in > 0 ? in_sizes[0] : -1, out_size, ws_size, (size_t)WS_END); grid = -1; return; }
        int dev = 0, cus = 0, per_cu = 0;
        if (hipGetDevice(&dev) != hipSuccess || hipDeviceGetAttribute(&cus, hipDeviceAttributeMultiprocessorCount, dev) != hipSuccess) { grid = -1; return; }
        if (hipFuncSetAttribute((const void*)fwd_kernel, hipFuncAttributeMaxDynamicSharedMemorySize, LDS_BYTES) != hipSuccess) { fprintf(stderr, "kernel_launch: hipFuncSetAttribute failed\n"); grid = -1; return; }
        if (hipOccupancyMaxActiveBlocksPerMultiprocessor(&per_cu, (const void*)fwd_kernel, 512, LDS_BYTES) != hipSuccess || per_cu < 1)
            fprintf(stderr, "kernel_launch: note: occupancy query reports %d workgroups per CU\n", per_cu);
        (void)hipGetLastError();
        grid = cus;
    }
    if (grid < 0) return;
    if (hipMemsetAsync((char*)d_ws + WS_CTL, 0, CTL_ZERO_BYTES, stream) != hipSuccess) return;
    Args a{};
    for (int i = 0; i < 20; ++i) a.in[i] = (const float*)d_in[i];
    a.out = (float*)d_out; a.ws = (unsigned char*)d_ws;
#if MK_PER_PHASE
    for (int p = 0; p < NPHASE; ++p) { a.ph_lo = p; a.ph_hi = p + 1; hipLaunchKernelGGL(fwd_kernel, dim3(grid), dim3(512), LDS_BYTES, stream, a); }
#elif MK_DUP >= 0
    a.ph_lo = 0; a.ph_hi = MK_DUP + 1; a.li = 0; hipLaunchKernelGGL(fwd_kernel, dim3(grid), dim3(512), LDS_BYTES, stream, a);
    a.ph_lo = MK_DUP; a.ph_hi = NPHASE; a.li = 1; hipLaunchKernelGGL(fwd_kernel, dim3(grid), dim3(512), LDS_BYTES, stream, a);
#else
    a.ph_lo = 0; a.ph_hi = NPHASE;
    hipLaunchKernelGGL(fwd_kernel, dim3(grid), dim3(512), LDS_BYTES, stream, a);
#endif
    const hipError_t le = hipPeekAtLastError();
    if (le != hipSuccess) fprintf(stderr, "kernel_launch: launch failed: %s\n", hipGetErrorName(le));
}
```

```cpp
#include <hip/hip_runtime.h>
#include <hip/hip_bf16.h>
#include <cstdio>
#include <cstdint>

#ifndef MK_DUP
#define MK_DUP (-1)
#endif
#ifndef MK_ATTN_CHECK
#define MK_ATTN_CHECK 0
#endif
#ifndef MK_PER_PHASE
#define MK_PER_PHASE 0
#endif

constexpr int BATCH = 2, SEQ = 16384, DM = 1024, NTOK = BATCH * SEQ, CTXL = 256, NCTX = BATCH * CTXL, MROWS = NTOK + NCTX;
constexpr int SKV = SEQ + CTXL;
constexpr int HD = 128, NQH = 4, NKVH = 2, QW = NQH * HD  , KVW = NKVH * HD  , CW = 512;
constexpr int INC = 2560, NMOD = 6 * DM;
constexpr int NEXP = 32, TOPK = 4, DFF = 1024;
constexpr float NORM_EPS = 1e-6f;
constexpr float WSCALE = 32.0f, WINV = 1.0f / 32.0f;
constexpr int MAXTILES = (NTOK * TOPK) / 256 + NEXP;
constexpr int MAXROWS = MAXTILES * 256;
constexpr int NPHASE = 11;

constexpr size_t MiB = 1u << 20;
constexpr size_t WS_CTL = 0, CTL_ZERO_BYTES = 1 * MiB;
constexpr size_t WS_MOD = 1 * MiB;
constexpr size_t WS_ROPE = WS_MOD + 128 * 1024;
constexpr size_t WS_WRT = WS_ROPE + 128 * 1024;
constexpr size_t WS_WIN8 = WS_MOD + 512 * 1024;
constexpr size_t WS_WIN = 3 * MiB;
constexpr size_t WS_WOUT = 8 * MiB;
constexpr size_t WS_WGU = 10 * MiB;
constexpr size_t WS_WDN = 138 * MiB;
constexpr size_t WS_X1 = 202 * MiB;
constexpr size_t WS_H2 = 330 * MiB;
constexpr size_t WS_PINFO = 395 * MiB;
constexpr size_t WS_PGATE = 399 * MiB;
constexpr size_t WS_R1 = 404 * MiB;
constexpr size_t WS_H = WS_R1;
constexpr size_t WS_Q = WS_R1 + 65 * MiB;
constexpr size_t WS_K = WS_Q + 32 * MiB;
constexpr size_t WS_V = WS_K + 17 * MiB;
constexpr size_t WS_CB = WS_V + 17 * MiB;
constexpr size_t WS_U = WS_CB + 32 * MiB;
constexpr size_t WS_MIX = WS_U + 32 * MiB;
constexpr size_t WS_Q8 = WS_H, WS_K8 = WS_H + 16 * MiB, WS_V8T = WS_H + 26 * MiB;
constexpr size_t WS_YP = WS_R1;
constexpr size_t WS_ACT = 676 * MiB;
constexpr size_t WS_H8 = WS_ACT;
constexpr size_t WS_END = 948 * MiB;
static_assert(WS_MIX + 64 * MiB <= WS_R1 + 272 * MiB && (size_t)MAXROWS * 2048 <= 272 * MiB, "ws map");
constexpr int CW_FLAG = 32;
constexpr int CW_CNT = 64;
constexpr int CW_BAR = 4096;

constexpr int LDS_BYTES = 163840;
constexpr int MISC_OFF = 155648;
constexpr int MO_BAR = 0, MO_TS = 64, MO_TE = 256, MO_HIST = 2816, MO_BASE = 2944, MO_SELE = 3072, MO_SELG = 5120;

#define GAS __attribute__((address_space(1)))
#define LAS __attribute__((address_space(3)))
typedef unsigned short bf16_t;
typedef short bf16x8 __attribute__((ext_vector_type(8)));
typedef float f32x4 __attribute__((ext_vector_type(4)));
typedef float f32x2 __attribute__((ext_vector_type(2)));
typedef unsigned u32x4 __attribute__((ext_vector_type(4)));
typedef unsigned u32x2 __attribute__((ext_vector_type(2)));
typedef int i32x4_t __attribute__((ext_vector_type(4)));
typedef int i32x8_t __attribute__((ext_vector_type(8)));

__device__ __forceinline__ unsigned cvt_pk_bf16(float lo, float hi) { unsigned r; asm volatile("v_cvt_pk_bf16_f32 %0, %1, %2" : "=v"(r) : "v"(lo), "v"(hi)); return r; }
__device__ __forceinline__ unsigned pk4_fp8(float a, float b, float c, float d) { unsigned w = 0; w = __builtin_amdgcn_cvt_pk_fp8_f32(a, b, w, false); w = __builtin_amdgcn_cvt_pk_fp8_f32(c, d, w, true); return w; }
__device__ __forceinline__ float bf_lo(unsigned w) { return __uint_as_float(w << 16); }
__device__ __forceinline__ float bf_hi(unsigned w) { return __uint_as_float(w & 0xffff0000u); }
template <int CTRL> __device__ __forceinline__ float dpp_f(float v) { return __builtin_bit_cast(float, __builtin_amdgcn_update_dpp(0, __builtin_bit_cast(int, v), CTRL, 0xf, 0xf, true)); }
__device__ __forceinline__ float wave_sum(float v) {
    v += dpp_f<0xB1>(v); v += dpp_f<0x4E>(v); v += dpp_f<0x141>(v); v += dpp_f<0x140>(v);
    { auto r = __builtin_amdgcn_permlane16_swap(__float_as_uint(v), __float_as_uint(v), false, false); v = __uint_as_float(r[0]) + __uint_as_float(r[1]); }
    { auto r = __builtin_amdgcn_permlane32_swap(__float_as_uint(v), __float_as_uint(v), false, false); v = __uint_as_float(r[0]) + __uint_as_float(r[1]); }
    return v;
}
__device__ __forceinline__ float half_max(float v) {
    v = fmaxf(v, dpp_f<0xB1>(v)); v = fmaxf(v, dpp_f<0x4E>(v)); v = fmaxf(v, dpp_f<0x141>(v)); v = fmaxf(v, dpp_f<0x140>(v));
    { auto r = __builtin_amdgcn_permlane16_swap(__float_as_uint(v), __float_as_uint(v), false, false); v = fmaxf(__uint_as_float(r[0]), __uint_as_float(r[1])); }
    return v;
}

namespace pg8 {
constexpr int BM = 256, BK = 64, HALF = 128, HTB = HALF * BK * 2, STAGE_BYTES = 8 * HTB, NXCD = 8, WGM = 8;
__host__ __device__ __forceinline__ int lds_byte(int r, int c) { const int st = (r >> 4) * 2 + (c >> 5), rr = r & 15, cc = c & 31, ob = rr * 64 + cc * 2; return st * 1024 + (ob ^ (((ob >> 9) & 1) << 5)); }
__host__ __device__ __forceinline__ void stage_rc(int b, int& R, int& C) { const int st = b / 1024, sb = b % 1024, swz = sb ^ (((sb >> 9) & 1) << 5); R = (st >> 1) * 16 + swz / 64; C = (st & 1) * 32 + (swz % 64) / 2; }
__host__ __device__ __forceinline__ int perm32(int rho) { const int n = rho >> 4, i = rho & 15; return 8 * (i >> 2) + 4 * n + (i & 3); }

struct Unit { int pm, pn, e; };
struct Gemm { const bf16_t* A; const bf16_t* Bt; int M, N, K; size_t estride;
              const int* pinfo; const unsigned* cnt; const LAS int* ts; int ntok; };

struct StaticOrder {
    int nM, nN, nwg, G, c;
    __device__ void init(int nM_, int nN_, int G_, int c_) { nM = nM_; nN = nN_; nwg = nM * nN; G = G_; c = c_; }
    __device__ bool next(int i, Unit& u) const {
        const long L = (long)i * G + c; if (L >= nwg) return false;
        int wgid = (int)L; { const int q = nwg / NXCD, r = nwg % NXCD, xcd = wgid % NXCD, off = wgid / NXCD; wgid = (xcd < r ? xcd * (q + 1) : r * (q + 1) + (xcd - r) * q) + off; }
        const int nig = WGM * nN, gid = wgid / nig, fm = gid * WGM, gsz = (nM - fm) < WGM ? (nM - fm) : WGM;
        u.pm = fm + ((wgid % nig) % gsz); u.pn = (wgid % nig) / gsz; u.e = 0; return true;
    }
};

template <class Epi, class Sched, bool ALIGN_EPI = false, bool SP2 = false, bool FP8 = false, bool GATHER = false>
__device__ __forceinline__ void gemm_phase(LAS unsigned char* lds, const Gemm g, const Sched& S, const Epi& E) {
    int tid = threadIdx.x; asm volatile("" : "+v"(tid));
    const int wid = __builtin_amdgcn_readfirstlane(tid >> 6), lane = tid & 63, wr = wid >> 2, wc = wid & 3, fr = lane & 15, fq = lane >> 4;
    const int K = g.K, nt = K / BK;
    unsigned voffA[2], voffB[2], voffB1[2]; int Rrow[2]; unsigned cbyte[2];
#pragma unroll
    for (int i = 0; i < 2; ++i) { int R, C; stage_rc(tid * 16 + i * 8192, R, C); const int Rb = Epi::PERM ? ((R & ~31) + perm32(R & 31)) : R;
        voffA[i] = (unsigned)(R * K + C) * 2u; voffB[i] = (unsigned)(Rb * K + C) * 2u; Rrow[i] = R; cbyte[i] = (unsigned)C * 2u;
        if constexpr (Epi::BMODE == 1) {
            const int Rm = 64 * (R >> 5) + 16 * ((R & 15) >> 2) + 4 * ((R >> 4) & 1) + (R & 3);
            voffB[i] = (unsigned)(Rm * K + C) * 2u; voffB1[i] = (unsigned)((Rm + 8) * K + C) * 2u; } }
    unsigned gC[2][2], gN[2][2]; int gR[2][2];
#define PG8_GISSUE(u_) do { const int e_ = (u_).e; const int p0_ = ((u_).pm - g.ts[e_]) * 256; const int c_ = (int)g.cnt[e_]; \
        _Pragma("unroll") for (int h_ = 0; h_ < 2; ++h_) _Pragma("unroll") for (int i_ = 0; i_ < 2; ++i_) { const int pos_ = p0_ + 128 * h_ + Rrow[i_]; \
            const int* ap_ = g.pinfo + (size_t)e_ * g.ntok + (pos_ < c_ ? pos_ : 0); asm volatile("global_load_dword %0, %1, off" : "=v"(gR[h_][i_]) : "v"(ap_) : "memory"); } } while (0)
#define PG8_GCONV(u_, dst_) do { const int e_ = (u_).e; const int p0_ = ((u_).pm - g.ts[e_]) * 256; const int c_ = (int)g.cnt[e_]; \
        asm volatile("" : "+v"(gR[0][0]), "+v"(gR[0][1]), "+v"(gR[1][0]), "+v"(gR[1][1])); \
        _Pragma("unroll") for (int h_ = 0; h_ < 2; ++h_) _Pragma("unroll") for (int i_ = 0; i_ < 2; ++i_) { const int pos_ = p0_ + 128 * h_ + Rrow[i_]; \
            const int tok_ = pos_ < c_ ? (gR[h_][i_] >> 2) : g.ntok; dst_[h_][i_] = (unsigned)tok_ * (unsigned)(K * 2) + cbyte[i_]; } } while (0)
#define PG8_STAGE_B(bufoff, bbase, bj) do { if constexpr (Epi::BMODE == 1) { if ((bj) == 0) PG8_STAGE(bufoff, bbase, voffB); else PG8_STAGE(bufoff, bbase, voffB1); } \
        else { PG8_STAGE(bufoff, (bbase) + (bj) * hstep, voffB); } } while (0)
#define PG8_STAGE_A(bufoff, abase, h, nx) do { if constexpr (GATHER) { unsigned vs_[2] = {(nx) ? gN[h][0] : gC[h][0], (nx) ? gN[h][1] : gC[h][1]}; PG8_STAGE(bufoff, abase, vs_); } \
        else { PG8_STAGE(bufoff, (abase) + (h) * hstep, voffA); } } while (0)
    const size_t kstep = (size_t)(BK * 2);
    const size_t hstep = (size_t)HALF * K * 2;
    const size_t tstep = 2 * hstep;
    const unsigned ldsw = (unsigned)wid * 1024u;
    int aoff = lds_byte(wr * 64 + fr, fq * 8), boff = lds_byte(wc * 32 + fr, fq * 8) + 4 * HTB;
    asm volatile("" : "+v"(aoff), "+v"(boff));
#define PG8_SA(b, h) (((b) * 2 + (h)) * HTB)
#define PG8_SB(b, h) ((4 + (b) * 2 + (h)) * HTB)
#define PG8_STAGE(bufoff, gbase, voff) do { _Pragma("unroll") for (int _i = 0; _i < 2; ++_i) \
        __builtin_amdgcn_global_load_lds((const unsigned*)((const char*)(gbase) + (voff)[_i]), (LAS unsigned*)(lds + (bufoff) + ldsw + _i * 8192), 16, 0, 0); } while (0)
#define PG8_LD16(off) (*(const LAS i32x4_t*)(lds + (off)))
#define PG8_LDA(dst, b, h) do { _Pragma("unroll") for (int m = 0; m < 4; ++m) dst[m] = __builtin_shufflevector(PG8_LD16(aoff + PG8_SA(b, h) + m * 2048), PG8_LD16(aoff + PG8_SA(b, h) + m * 2048 + 1024), 0, 1, 2, 3, 4, 5, 6, 7); } while (0)
#define PG8_LDB(dst, b, h) do { _Pragma("unroll") for (int n = 0; n < 2; ++n) dst[n] = __builtin_shufflevector(PG8_LD16(boff + ((b) * 2 + (h)) * HTB + n * 2048), PG8_LD16(boff + ((b) * 2 + (h)) * HTB + n * 2048 + 1024), 0, 1, 2, 3, 4, 5, 6, 7); } while (0)
#define PG8_LOH(x) __builtin_bit_cast(bf16x8, __builtin_shufflevector((x), (x), 0, 1, 2, 3))
#define PG8_HIH(x) __builtin_bit_cast(bf16x8, __builtin_shufflevector((x), (x), 4, 5, 6, 7))
#define PG8_MMA(ai, bj, At, Bt) do { __builtin_amdgcn_s_setprio(1); if constexpr (FP8) { _Pragma("unroll") for (int m = 0; m < 4; ++m) _Pragma("unroll") for (int n = 0; n < 2; ++n) \
        asm volatile("v_mfma_f32_16x16x128_f8f6f4 %0, %1, %2, %0" : "+v"(acc[ai][bj][m][n]) : "v"(Bt[n]), "v"(At[m])); } else { \
        _Pragma("unroll") for (int m = 0; m < 4; ++m) _Pragma("unroll") for (int n = 0; n < 2; ++n) { \
        acc[ai][bj][m][n] = __builtin_amdgcn_mfma_f32_16x16x32_bf16(PG8_LOH(Bt[n]), PG8_LOH(At[m]), acc[ai][bj][m][n], 0, 0, 0); \
        acc[ai][bj][m][n] = __builtin_amdgcn_mfma_f32_16x16x32_bf16(PG8_HIH(Bt[n]), PG8_HIH(At[m]), acc[ai][bj][m][n], 0, 0, 0); } } __builtin_amdgcn_s_setprio(0); } while (0)
#define PG8_WAIT_V(n) asm volatile("s_waitcnt vmcnt(" #n ")" ::: "memory")
#define PG8_WAIT_L(n) asm volatile("s_waitcnt lgkmcnt(" #n ")" ::: "memory")
#define PG8_BAR __builtin_amdgcn_s_barrier()
#define PG8_SCHED __builtin_amdgcn_sched_barrier(0)
    Unit cur, nxt; int ui = 0;
    if (!S.next(0, cur)) return;
    f32x4 acc[2][2][4][2];
#pragma unroll
    for (int a = 0; a < 2; ++a)
#pragma unroll
        for (int b = 0; b < 2; ++b)
#pragma unroll
            for (int m = 0; m < 4; ++m)
#pragma unroll
                for (int n = 0; n < 2; ++n) acc[a][b][m][n] = (f32x4){0.f, 0.f, 0.f, 0.f};
    i32x8_t At[4], B0[2], B1[2];
    const char* cA = (const char*)g.A + (GATHER ? (size_t)0 : (size_t)cur.pm * tstep); const char* cB = (const char*)g.Bt + (size_t)cur.e * g.estride + (size_t)cur.pn * tstep;
    if constexpr (GATHER) { PG8_GISSUE(cur); asm volatile("s_waitcnt vmcnt(0)" ::: "memory"); PG8_GCONV(cur, gC);
#pragma unroll
        for (int h_ = 0; h_ < 2; ++h_)
#pragma unroll
            for (int i_ = 0; i_ < 2; ++i_) gN[h_][i_] = gC[h_][i_]; }
    if constexpr (SP2) {
        PG8_STAGE_B(PG8_SB(0, 0), cB, 0); PG8_STAGE_B(PG8_SB(0, 1), cB, 1); PG8_STAGE_A(PG8_SA(0, 0), cA, 0, false); PG8_STAGE_A(PG8_SA(0, 1), cA, 1, false);
        if (wr == 1) PG8_BAR;
        PG8_WAIT_V(2); PG8_BAR;
        PG8_STAGE_B(PG8_SB(1, 0), cB + kstep, 0); PG8_STAGE_A(PG8_SA(1, 0), cA + kstep, 0, false); PG8_STAGE_B(PG8_SB(1, 1), cB + kstep, 1);
        PG8_WAIT_V(6); PG8_BAR;
    } else {
        PG8_STAGE(PG8_SB(0, 0), cB, voffB); PG8_STAGE(PG8_SA(0, 0), cA, voffA); PG8_STAGE(PG8_SB(0, 1), cB + hstep, voffB); PG8_STAGE(PG8_SA(0, 1), cA + hstep, voffA);
        if (wr == 1) PG8_BAR;
        PG8_WAIT_V(4); PG8_BAR;
        PG8_STAGE(PG8_SB(1, 0), cB + kstep, voffB); PG8_STAGE(PG8_SA(1, 0), cA + kstep, voffA); PG8_STAGE(PG8_SB(1, 1), cB + hstep + kstep, voffB);
        PG8_WAIT_V(6); PG8_BAR;
    }
    typename Epi::Pre epre;
    if constexpr (Epi::PRE) E.pre(cur, wr, wc, fr, fq, epre);
    for (;;) {
        const bool has_next = S.next(ui + 1, nxt);
        const char* nA = (has_next && !GATHER) ? (const char*)g.A + (size_t)nxt.pm * tstep : cA; const char* nB = has_next ? (const char*)g.Bt + (size_t)nxt.e * g.estride + (size_t)nxt.pn * tstep : cB;
        if constexpr (GATHER) { if (has_next) PG8_GISSUE(nxt); }
#pragma unroll 1
        for (int t = 0; t < nt; t += 2) {
            const bool last = (t == nt - 2);
            const char* a1 = cA + (size_t)(t + 1) * kstep;
            const char* a2 = last ? nA : cA + (size_t)(t + 2) * kstep; const char* b2 = last ? nB : cB + (size_t)(t + 2) * kstep;
            const char* a3 = a2 + kstep; const char* b3 = b2 + kstep;
            if constexpr (GATHER) { if (last && has_next) PG8_GCONV(nxt, gN); }
            if constexpr (SP2) {
            PG8_LDB(B0, 0, 0); PG8_LDB(B1, 0, 1); PG8_SCHED; PG8_LDA(At, 0, 0); PG8_STAGE_A(PG8_SA(1, 1), a1, 1, false);
            PG8_WAIT_V(8); PG8_WAIT_L(0); PG8_BAR; PG8_MMA(0, 0, At, B0); PG8_MMA(0, 1, At, B1); PG8_BAR; PG8_SCHED;
            PG8_LDA(At, 0, 1); PG8_STAGE_B(PG8_SB(0, 0), b2, 0); PG8_STAGE_B(PG8_SB(0, 1), b2, 1); PG8_STAGE_A(PG8_SA(0, 0), a2, 0, last);
            PG8_WAIT_V(8); PG8_WAIT_L(0); PG8_BAR; PG8_MMA(1, 0, At, B0); PG8_MMA(1, 1, At, B1); PG8_BAR; PG8_SCHED;
            PG8_LDB(B0, 1, 0); PG8_LDB(B1, 1, 1); PG8_SCHED; PG8_LDA(At, 1, 0); PG8_STAGE_A(PG8_SA(0, 1), a2, 1, last);
            PG8_WAIT_V(8); PG8_WAIT_L(0); PG8_BAR; PG8_MMA(0, 0, At, B0); PG8_MMA(0, 1, At, B1); PG8_BAR; PG8_SCHED;
            PG8_LDA(At, 1, 1); PG8_STAGE_B(PG8_SB(1, 0), b3, 0); PG8_STAGE_B(PG8_SB(1, 1), b3, 1); PG8_STAGE_A(PG8_SA(1, 0), a3, 0, last);
            PG8_WAIT_V(8); PG8_WAIT_L(0); PG8_BAR; PG8_MMA(1, 0, At, B0); PG8_MMA(1, 1, At, B1); PG8_BAR; PG8_SCHED;
            } else {
            PG8_LDB(B0, 0, 0); PG8_SCHED; PG8_LDA(At, 0, 0); PG8_STAGE(PG8_SA(1, 1), a1 + hstep, voffA);
            PG8_WAIT_L(8); PG8_BAR; PG8_WAIT_L(0); PG8_MMA(0, 0, At, B0); PG8_BAR; PG8_SCHED;
            PG8_LDB(B1, 0, 1); PG8_STAGE(PG8_SB(0, 0), b2, voffB);
            PG8_BAR; PG8_WAIT_L(0); PG8_MMA(0, 1, At, B1); PG8_BAR;
            PG8_LDA(At, 0, 1); PG8_STAGE(PG8_SA(0, 0), a2, voffA);
            PG8_BAR; PG8_WAIT_L(0); PG8_MMA(1, 0, At, B0); PG8_BAR; PG8_SCHED;
            PG8_STAGE(PG8_SB(0, 1), b2 + hstep, voffB);
            PG8_WAIT_V(6); PG8_BAR; PG8_MMA(1, 1, At, B1); PG8_BAR;
            PG8_LDB(B0, 1, 0); PG8_SCHED; PG8_LDA(At, 1, 0); PG8_STAGE(PG8_SA(0, 1), a2 + hstep, voffA);
            PG8_WAIT_L(8); PG8_BAR; PG8_WAIT_L(0); PG8_MMA(0, 0, At, B0); PG8_BAR; PG8_SCHED;
            PG8_LDB(B1, 1, 1); PG8_STAGE(PG8_SB(1, 0), b3, voffB);
            PG8_BAR; PG8_WAIT_L(0); PG8_MMA(0, 1, At, B1); PG8_BAR;
            PG8_LDA(At, 1, 1); PG8_STAGE(PG8_SA(1, 0), a3, voffA);
            PG8_BAR; PG8_WAIT_L(0); PG8_MMA(1, 0, At, B0); PG8_BAR; PG8_SCHED;
            PG8_STAGE(PG8_SB(1, 1), b3 + hstep, voffB);
            PG8_WAIT_V(6); PG8_BAR; PG8_MMA(1, 1, At, B1); PG8_BAR;
            }
        }
        if constexpr (ALIGN_EPI) { if (wr == 0) PG8_BAR; }
        if constexpr (FP8) { asm volatile("s_nop 15\n\ts_nop 15\n\ts_nop 15" ::: "memory"); PG8_SCHED; }
        if constexpr (Epi::PRE) E(acc, cur, wr, wc, fr, fq, epre); else E(acc, cur, wr, wc, fr, fq);
        if (!has_next) break;
#pragma unroll
        for (int a = 0; a < 2; ++a)
#pragma unroll
            for (int b = 0; b < 2; ++b)
#pragma unroll
                for (int m = 0; m < 4; ++m)
#pragma unroll
                    for (int n = 0; n < 2; ++n) acc[a][b][m][n] = (f32x4){0.f, 0.f, 0.f, 0.f};
        cur = nxt; cA = nA; cB = nB; ++ui;
        if constexpr (Epi::PRE) E.pre(cur, wr, wc, fr, fq, epre);
        if constexpr (GATHER) {
#pragma unroll
            for (int h_ = 0; h_ < 2; ++h_)
#pragma unroll
                for (int i_ = 0; i_ < 2; ++i_) gC[h_][i_] = gN[h_][i_]; }
        if constexpr (ALIGN_EPI) { if (wr == 1) PG8_BAR; }
    }
    PG8_WAIT_V(0);
    if constexpr (!ALIGN_EPI) { if (wr == 0) PG8_BAR; }
    PG8_BAR;
#undef PG8_SA
#undef PG8_SB
#undef PG8_STAGE
#undef PG8_STAGE_A
#undef PG8_STAGE_B
#undef PG8_GISSUE
#undef PG8_GCONV
#undef PG8_LDA
#undef PG8_LDB
#undef PG8_MMA
#undef PG8_LOH
#undef PG8_HIH
#undef PG8_LD16
#undef PG8_WAIT_V
#undef PG8_WAIT_L
#undef PG8_BAR
#undef PG8_SCHED
}
}

constexpr float QSCALE = 0.088388347648318440f * 1.4426950408889634f;

namespace attn8 {
using bf16 = __hip_bfloat16;
constexpr int NW = 8, QBLK = 32, KVBLK = 64, LDO = DM;
constexpr int LDQB = QW, LDKB = KVW;
constexpr float YS = 8.f, Y0 = 56.f;
constexpr float THRY = Y0 + 8.f * YS;
constexpr int SLOT = 8192, NKS = 2, NVS = 4;
constexpr int LDS_KR = 0, LDS_VR = NKS * SLOT, LDS_WS = (NKS + NVS) * SLOT, SHM_ATTN = LDS_WS + NW * 256;
constexpr int LDS_BG = SHM_ATTN, BGT = 16384, BG_TILES = 48, BG_LAG = 4;
using f32x16 = __attribute__((ext_vector_type(16))) float;
using f32x8 = __attribute__((ext_vector_type(8))) float;
using u32x4g = __attribute__((ext_vector_type(4))) unsigned;
typedef __attribute__((address_space(3))) const char* lds_cptr;
#define SBAR() __builtin_amdgcn_sched_barrier(0)
__device__ __forceinline__ int crow(int r, int hi) { return (r & 3) + 8 * (r >> 2) + 4 * hi; }
__device__ __forceinline__ i32x8_t ld32(lds_cptr p0, lds_cptr p1) { return __builtin_shufflevector(*(const LAS i32x4_t*)p0, *(const LAS i32x4_t*)p1, 0, 1, 2, 3, 4, 5, 6, 7); }
__device__ __forceinline__ void mfma8_init(f32x16& d, const i32x8_t& a, const i32x8_t& b, const f32x16& c) { asm volatile("v_mfma_f32_32x32x64_f8f6f4 %0, %1, %2, %3" : "=&v"(d) : "v"(a), "v"(b), "v"(c)); }
__device__ __forceinline__ void mfma8_acc(f32x16& d, const i32x8_t& a, const i32x8_t& b) { asm volatile("v_mfma_f32_32x32x64_f8f6f4 %0, %1, %2, %0" : "+v"(d) : "v"(a), "v"(b)); }
__device__ __forceinline__ void mfma8_acc_pad(f32x16& d, const i32x8_t& a, const i32x8_t& b) { asm volatile("s_nop 3\n\tv_mfma_f32_32x32x64_f8f6f4 %0, %1, %2, %0" : "+v"(d) : "v"(a), "v"(b)); }
#define PK8(P, B) __builtin_amdgcn_cvt_pk_u8_f32(P[B + 3], 3u, __builtin_amdgcn_cvt_pk_u8_f32(P[B + 2], 2u, __builtin_amdgcn_cvt_pk_u8_f32(P[B + 1], 1u, __builtin_amdgcn_cvt_pk_u8_f32(P[B], 0u, 0u))))

template <bool BG>
__device__ __forceinline__ void attn_body(const unsigned char* __restrict__ Q8, const unsigned char* __restrict__ K8, const unsigned char* __restrict__ V8T, bf16* __restrict__ Ob, int seq, char* lds,
    int bg_t0, const float* __restrict__ bg_wgu, const float* __restrict__ bg_wdn, unsigned char* __restrict__ bg_gu8, unsigned char* __restrict__ bg_dn8, unsigned char* __restrict__ bg_dump) {
  int tid = threadIdx.x; asm volatile("" : "+v"(tid));
  const int lane = tid & 63, r32 = lane & 31, hi = lane >> 5; const int wid = __builtin_amdgcn_readfirstlane(tid >> 6);
  const lds_cptr L3 = (lds_cptr)lds;
  float* ws = (float*)(lds + LDS_WS) + wid * 64; float* li_l = ws; float* al_l = ws + 32;
  const bool kvw = wid < 4;
  unsigned koff, voff;
  { const int row = (wid & 3) * 16 + (lane >> 3), c = (lane & 7) ^ ((row >> 1) & 7); koff = (unsigned)(row * LDKB + c * 16); }
  { const int d = (wid & 3) * 32 + (lane >> 2), c = (lane & 3) ^ ((d >> 2) & 3); voff = (unsigned)(d * SKV + c * 16); }
  const unsigned pdst = (unsigned)(wid & 3) * 2048u;
#define DMA_PIECE(p, t, kslot, vslot) do { if (kvw) { \
    if ((p) == 0) { const char* sb_ = (const char*)K8 + (size_t)(t) * (KVBLK * LDKB); asm volatile("" : "+s"(sb_)); \
      __builtin_amdgcn_global_load_lds((const unsigned*)(sb_ + koff), (LAS unsigned*)((LAS unsigned char*)lds + LDS_KR + (kslot) * SLOT + pdst), 16, 0, 0); \
      __builtin_amdgcn_global_load_lds((const unsigned*)(sb_ + ((koff ^ 64u) + 8u * LDKB)), (LAS unsigned*)((LAS unsigned char*)lds + LDS_KR + (kslot) * SLOT + pdst + 1024u), 16, 0, 0); } \
    if ((p) == 1) { const char* sb_ = (const char*)V8T + (size_t)(t) * KVBLK; asm volatile("" : "+s"(sb_)); \
      __builtin_amdgcn_global_load_lds((const unsigned*)(sb_ + voff), (LAS unsigned*)((LAS unsigned char*)lds + LDS_VR + (vslot) * SLOT + pdst), 16, 0, 0); \
      __builtin_amdgcn_global_load_lds((const unsigned*)(sb_ + (voff + 16u * SKV)), (LAS unsigned*)((LAS unsigned char*)lds + LDS_VR + (vslot) * SLOT + pdst + 1024u), 16, 0, 0); } } } while (0)
#define DMA_ALL(t, kslot, vslot) do { DMA_PIECE(0, t, kslot, vslot); DMA_PIECE(1, t, kslot, vslot); } while (0)
  int ka[4], va[2];
#pragma unroll
  for (int q = 0; q < 4; ++q) ka[q] = LDS_KR + r32 * 128 + ((((q >> 1) * 4 + 2 * hi + (q & 1)) ^ ((r32 >> 1) & 7)) << 4);
#pragma unroll
  for (int i = 0; i < 2; ++i) va[i] = LDS_VR + r32 * 64 + (((2 * hi + i) ^ ((r32 >> 2) & 3)) << 4);
  const int NT = seq / KVBLK;
  DMA_ALL(0, 0, 0); DMA_ALL(1, 1, 1);
  i32x8_t q8[2];
  { const unsigned char* qp = Q8 + (size_t)(wid * QBLK + r32) * LDQB + 32 * hi;
    q8[0] = __builtin_shufflevector(*(const i32x4_t*)qp, *(const i32x4_t*)(qp + 16), 0, 1, 2, 3, 4, 5, 6, 7);
    q8[1] = __builtin_shufflevector(*(const i32x4_t*)(qp + 64), *(const i32x4_t*)(qp + 80), 0, 1, 2, 3, 4, 5, 6, 7); }
  float m_reg = 0.f; f32x16 o[4]; f32x16 lacc; f32x16 negm; f32x16 pA0, pA1, pB0, pB1; i32x8_t p8;
  const i32x8_t ones8 = {0x38383838, 0x38383838, 0x38383838, 0x38383838, 0x38383838, 0x38383838, 0x38383838, 0x38383838};
  asm volatile("s_waitcnt vmcnt(0) lgkmcnt(0)\n\ts_barrier" ::: "memory");
  { float y0 = Y0; asm volatile("" : "+v"(y0));
#pragma unroll
    for (int r = 0; r < 16; ++r) negm[r] = y0; }
  lacc = (f32x16){}; o[0] = (f32x16){}; o[1] = (f32x16){}; o[2] = (f32x16){}; o[3] = (f32x16){};
#define KFR(kbase, kh, s) ld32(L3 + (kbase) + ka[2 * (s)] + (kh) * 4096, L3 + (kbase) + ka[2 * (s) + 1] + (kh) * 4096)
#define VFR(vbase, db) ld32(L3 + (vbase) + va[0] + (db) * 2048, L3 + (vbase) + va[1] + (db) * 2048)
#define QK_TILE(C0, C1, kbase) do { const i32x8_t k00 = KFR(kbase, 0, 0), k01 = KFR(kbase, 0, 1), k10 = KFR(kbase, 1, 0), k11 = KFR(kbase, 1, 1); \
    mfma8_init(C0, k00, q8[0], negm); mfma8_acc(C0, k01, q8[1]); mfma8_init(C1, k10, q8[0], negm); mfma8_acc(C1, k11, q8[1]); } while (0)
#define ROWMAX_A(C0) float rm_ = fmaxf(C0[0], C0[1]); _Pragma("unroll") for (int r = 2; r < 16; ++r) rm_ = fmaxf(rm_, C0[r]);
#define ROWMAX_B(C1) _Pragma("unroll") for (int r = 0; r < 16; ++r) rm_ = fmaxf(rm_, C1[r]); \
    { auto rr = __builtin_amdgcn_permlane32_swap(__float_as_uint(rm_), __float_as_uint(rm_), false, false); rm_ = fmaxf(__uint_as_float(rr[0]), __uint_as_float(rr[1])); }
#define DECIDE(C0, C1, FIRST) do { if ((FIRST) || __builtin_expect(__any(rm_ > THRY), 0)) { const float dl = (FIRST) ? rm_ - Y0 : fmaxf(rm_ - Y0, 0.f); m_reg += dl; \
      _Pragma("unroll") for (int r = 0; r < 16; ++r) { C0[r] -= dl; C1[r] -= dl; } \
      _Pragma("unroll") for (int r = 0; r < 16; ++r) negm[r] = Y0 - m_reg; \
      if (!(FIRST)) { const float f = __builtin_amdgcn_exp2f(dl * (-1.0f / YS)); if (hi == 0) al_l[r32] = f; asm volatile("s_nop 15\n\ts_nop 15\n\ts_nop 15\n\ts_nop 15\n\ts_nop 15\n\ts_nop 15\n\ts_waitcnt lgkmcnt(0)" ::: "memory"); \
        _Pragma("unroll") for (int r = 0; r < 16; ++r) { const float fr_ = al_l[crow(r, hi)]; o[0][r] *= fr_; o[1][r] *= fr_; o[2][r] *= fr_; o[3][r] *= fr_; lacc[r] *= fr_; } } } } while (0)
#define FINISH(P0, P1) do { \
    p8[0] = PK8(P0, 0); p8[1] = PK8(P0, 4); p8[2] = PK8(P0, 8); p8[3] = PK8(P0, 12); p8[4] = PK8(P1, 0); p8[5] = PK8(P1, 4); p8[6] = PK8(P1, 8); p8[7] = PK8(P1, 12); } while (0)
#define PV_TILE(vbase) do { const i32x8_t v0_ = VFR(vbase, 0), v1_ = VFR(vbase, 1), v2_ = VFR(vbase, 2), v3_ = VFR(vbase, 3); \
    mfma8_acc_pad(o[0], p8, v0_); mfma8_acc(o[1], p8, v1_); mfma8_acc(o[2], p8, v2_); mfma8_acc(o[3], p8, v3_); mfma8_acc(lacc, p8, ones8); } while (0)
#define ITER_(C0, C1, P0, P1, KS, jj, TBAR, HOOK0, HOOK, RD, PF) do { const int vprev_ = (((jj) - 1) & 3) * SLOT; const int tn_ = (jj) + 2 < NT ? (jj) + 2 : NT - 1; const int vs2_ = ((jj) + 2) & 3; \
    if (RD) { kf0 = KFR((KS) * SLOT, 0, 0); kf1 = KFR((KS) * SLOT, 0, 1); } \
    const i32x8_t k10 = KFR((KS) * SLOT, 1, 0), k11 = KFR((KS) * SLOT, 1, 1); \
    mfma8_init(C0, kf0, q8[0], negm); p8[0] = PK8(P0, 0); p8[1] = PK8(P0, 4); SBAR(); \
    mfma8_acc(C0, kf1, q8[1]); p8[2] = PK8(P0, 8); p8[3] = PK8(P0, 12); SBAR(); \
    mfma8_init(C1, k10, q8[0], negm); p8[4] = PK8(P1, 0); p8[5] = PK8(P1, 4); SBAR(); \
    mfma8_acc(C1, k11, q8[1]); p8[6] = PK8(P1, 8); p8[7] = PK8(P1, 12); SBAR(); \
    TBAR; \
    i32x8_t va_ = VFR(vprev_, 0), vb_ = VFR(vprev_, 1); \
    mfma8_acc_pad(o[0], p8, va_); asm volatile("s_nop 7" ::: "memory"); ROWMAX_A(C0); SBAR(); \
    mfma8_acc(o[1], p8, vb_); va_ = VFR(vprev_, 2); vb_ = VFR(vprev_, 3); ROWMAX_B(C1); SBAR(); \
    mfma8_acc(o[2], p8, va_); DMA_PIECE(0, tn_, KS, vs2_); DMA_PIECE(1, tn_, KS, vs2_); SBAR(); \
    mfma8_acc(o[3], p8, vb_); SBAR(); f32x8 bgw; HOOK0; \
    mfma8_acc(lacc, p8, ones8); if (PF) { kf0 = KFR((1 - (KS)) * SLOT, 0, 0); kf1 = KFR((1 - (KS)) * SLOT, 0, 1); } SBAR(); HOOK; \
    DECIDE(C0, C1, false); SBAR(); } while (0)
#define TB0 asm volatile("s_waitcnt vmcnt(0)\n\ts_barrier" ::: "memory")
#define TBK do { if (kvw) asm volatile("s_waitcnt vmcnt(0)" ::: "memory"); asm volatile("s_barrier" ::: "memory"); } while (0)
#define NOHOOK do { } while (0)
#define ITER(C0, C1, P0, P1, KS, jj) ITER_(C0, C1, P0, P1, KS, jj, TB0, NOHOOK, NOHOOK, 0, 1)
  int bg_k = 0, bq = 0, bg_nsh = 12; const char* bg_src = (const char*)bg_wgu; unsigned char* bg_dst = bg_dump; unsigned bgo0 = 0u, bgo1 = 0u;
#define BG_DECODE_SRC(tt) do { int t_ = (tt); \
    if (t_ < 16384) { const int e_ = t_ >> 9, nb_ = (t_ >> 4) & 31, kb_ = t_ & 15; bg_src = (const char*)(bg_wgu + (size_t)e_ * (DM * 2048) + (size_t)kb_ * (64 * 2048) + nb_ * 64); bg_nsh = 13; } \
    else { t_ -= 16384; const int e_ = t_ >> 8, nb_ = (t_ >> 4) & 15, kb_ = t_ & 15; bg_src = (const char*)(bg_wdn + (size_t)e_ * (DFF * DM) + (size_t)kb_ * (64 * 1024) + nb_ * 64); bg_nsh = 12; } } while (0)
#define BG_DECODE_DST(tt) do { int t_ = (tt); \
    if (t_ < 16384) { const int e_ = t_ >> 9, nb_ = (t_ >> 4) & 31, kb_ = t_ & 15; bg_dst = bg_gu8 + (size_t)e_ * (2048 * DM) + (size_t)(256 * ((nb_ & 15) >> 1) + 128 * (nb_ >> 4) + 64 * (nb_ & 1)) * 1024 + kb_ * 64; } \
    else { t_ -= 16384; const int e_ = t_ >> 8, nb_ = (t_ >> 4) & 15, kb_ = t_ & 15; bg_dst = bg_dn8 + (size_t)e_ * (DM * DFF) + (size_t)(nb_ * 64) * 1024 + kb_ * 64; } } while (0)
#define BG_LOADH(H) do { if (!kvw) { \
    if ((H) == 0) asm volatile("s_waitcnt vmcnt(%0)" :: "n"(5 * (BG_LAG - 1)) : "memory"); \
    int ln_ = __builtin_amdgcn_mbcnt_hi(~0u, __builtin_amdgcn_mbcnt_lo(~0u, 0u)); asm volatile("" : "+v"(ln_)); \
    const LAS float* cp_ = (const LAS float*)((LAS unsigned char*)lds + LDS_BG + bq * BGT + (wid - 4) * 4096 + (H) * 2048) + ln_; \
    _Pragma("unroll") for (int r_ = 0; r_ < 8; ++r_) bgw[r_] = cp_[r_ * 64]; } else { asm volatile("" : "=v"(bgw)); } SBAR(); } while (0)
#define BG_CONV1() do { if (!kvw) { const f32x8 ws_ = bgw * WSCALE; bgo0 = pk4_fp8(ws_[0], ws_[1], ws_[2], ws_[3]); bgo1 = pk4_fp8(ws_[4], ws_[5], ws_[6], ws_[7]); } \
    else { asm volatile("" : "=v"(bgo0), "=v"(bgo1)); } SBAR(); } while (0)
#define BG_CONV2() do { if (!kvw) { \
    const int c_ = bg_k - BG_LAG; if (c_ < 0) bg_dst = bg_dump; else if ((c_ & 15) == 0) BG_DECODE_DST(bg_t0 + c_); else bg_dst += 64; \
    int ln_ = __builtin_amdgcn_mbcnt_hi(~0u, __builtin_amdgcn_mbcnt_lo(~0u, 0u)); asm volatile("" : "+v"(ln_)); \
    const f32x8 ws_ = bgw * WSCALE; u32x4g o_; o_.x = bgo0; o_.y = bgo1; o_.z = pk4_fp8(ws_[0], ws_[1], ws_[2], ws_[3]); o_.w = pk4_fp8(ws_[4], ws_[5], ws_[6], ws_[7]); \
    __builtin_nontemporal_store(o_, (u32x4g*)(bg_dst + (unsigned)(ln_ * 1024 + (wid - 4) * 16))); } SBAR(); } while (0)
#define BG_DMA() do { if (!kvw) { \
    if (bg_k < BG_TILES) { if ((bg_k & 15) == 0) BG_DECODE_SRC(bg_t0 + bg_k); else bg_src += (64u << bg_nsh); } \
    int ln_ = __builtin_amdgcn_mbcnt_hi(~0u, __builtin_amdgcn_mbcnt_lo(~0u, 0u)); asm volatile("" : "+v"(ln_)); \
    const unsigned so_ = ((unsigned)((wid - 4) * 16 + (ln_ >> 4)) << bg_nsh) + (unsigned)(ln_ & 15) * 16u; \
    LAS unsigned char* lb_ = (LAS unsigned char*)lds + LDS_BG + bq * BGT + (wid - 4) * 4096; \
    __builtin_amdgcn_global_load_lds((const unsigned*)(bg_src + so_), (LAS unsigned*)lb_, 16, 0, 2); \
    __builtin_amdgcn_global_load_lds((const unsigned*)(bg_src + so_ + (4u << bg_nsh)), (LAS unsigned*)(lb_ + 1024), 16, 0, 2); \
    __builtin_amdgcn_global_load_lds((const unsigned*)(bg_src + so_ + (8u << bg_nsh)), (LAS unsigned*)(lb_ + 2048), 16, 0, 2); \
    __builtin_amdgcn_global_load_lds((const unsigned*)(bg_src + so_ + (12u << bg_nsh)), (LAS unsigned*)(lb_ + 3072), 16, 0, 2); } \
    bq = bq == BG_LAG - 1 ? 0 : bq + 1; ++bg_k; SBAR(); } while (0)
#define ITER_BGA(C0, C1, P0, P1, KS, jj) ITER_(C0, C1, P0, P1, KS, jj, TBK, BG_LOADH(0), BG_CONV1(), 0, 0)
#define ITER_BGA2(C0, C1, P0, P1, KS, jj) ITER_(C0, C1, P0, P1, KS, jj, TBK, BG_LOADH(1), BG_CONV2(), 1, 0)
#define ITER_BGB(C0, C1, P0, P1, KS, jj) ITER_(C0, C1, P0, P1, KS, jj, TBK, BG_DMA(), NOHOOK, 1, 1)
#define ITER_BGP(C0, C1, P0, P1, KS, jj) ITER_(C0, C1, P0, P1, KS, jj, TBK, NOHOOK, NOHOOK, 0, 1)
  i32x8_t kf0, kf1;

  QK_TILE(pA0, pA1, 0);
  { asm volatile("s_nop 15\n\ts_nop 15" ::: "memory"); SBAR(); ROWMAX_A(pA0); ROWMAX_B(pA1); DECIDE(pA0, pA1, true); }
  kf0 = KFR(SLOT, 0, 0); kf1 = KFR(SLOT, 0, 1);
  asm volatile("s_waitcnt vmcnt(0)\n\ts_barrier" ::: "memory");
  DMA_ALL(2, 0, 2);
  int j = 1;
  if constexpr (BG) {
    for (; j < 1 + 4 * (BG_TILES + BG_LAG); j += 4) { ITER_BGA(pB0, pB1, pA0, pA1, 1, j); ITER_BGA2(pA0, pA1, pB0, pB1, 0, j + 1); ITER_BGB(pB0, pB1, pA0, pA1, 1, j + 2); ITER_BGP(pA0, pA1, pB0, pB1, 0, j + 3); }
  }
  for (; j + 1 < NT; j += 2) { ITER(pB0, pB1, pA0, pA1, 1, j); ITER(pA0, pA1, pB0, pB1, 0, j + 1); }
  ITER(pB0, pB1, pA0, pA1, 1, j);
  FINISH(pB0, pB1); SBAR();
  PV_TILE(((NT - 1) & 3) * SLOT);
  asm volatile("s_nop 15\n\ts_nop 15" ::: "memory"); SBAR();
  asm volatile("s_nop 15\n\ts_nop 15\n\ts_nop 15\n\ts_nop 15" ::: "memory"); SBAR();
  float rli[16];
#pragma unroll
  for (int r = 0; r < 16; ++r) rli[r] = __builtin_amdgcn_rcpf(lacc[r]);
  { int tid2 = threadIdx.x; asm volatile("" : "+v"(tid2));
    const int hi2 = (tid2 >> 5) & 1; bf16* Ow = Ob + (size_t)((tid2 >> 6) * QBLK) * LDO + (tid2 & 31);
#pragma unroll
    for (int r = 0; r < 16; ++r) { const int orow = crow(r, hi2);
#pragma unroll
      for (int d0 = 0; d0 < 4; ++d0) Ow[(long)orow * LDO + d0 * 32] = __float2bfloat16(o[d0][r] * rli[r]); } }
  asm volatile("s_waitcnt vmcnt(0) lgkmcnt(0)\n\ts_barrier" ::: "memory");
#undef DMA_PIECE
#undef DMA_ALL
#undef KFR
#undef VFR
#undef QK_TILE
#undef ROWMAX_A
#undef ROWMAX_B
#undef DECIDE
#undef FINISH
#undef PV_TILE
#undef ITER
#undef ITER_
#undef ITER_BGA
#undef ITER_BGB
#undef ITER_BGP
#undef TB0
#undef TBK
#undef BG_DMA
#undef BG_DECODE_SRC
#undef BG_DECODE_DST
#undef BG_LOADH
#undef BG_CONV1
#undef BG_CONV2
#undef ITER_BGA2
#undef NOHOOK
}
#undef PK8
#undef SBAR
}

#define XB_TMO      128
#define XB_XCNT(j)  (256  + 64 * (j))
#define XB_XSUB(j)  (1280 + 64 * (j))
#define XB_XGEN(j)  (2304 + 64 * (j))
#define XB_TOP      3328
#define XB_TOPGEN   3392
#define XCD_BAR_WORDS 3456
#define XB_SPIN_CAP (1u << 18)
__device__ __forceinline__ unsigned xb_ld(unsigned* p)              { return __hip_atomic_load(p, __ATOMIC_RELAXED, __HIP_MEMORY_SCOPE_AGENT); }
__device__ __forceinline__ unsigned xb_add(unsigned* p, unsigned v) { return __hip_atomic_fetch_add(p, v, __ATOMIC_RELAXED, __HIP_MEMORY_SCOPE_AGENT); }
__device__ __forceinline__ unsigned xb_xcc_id() { return (unsigned)__builtin_amdgcn_s_getreg((3 << 11) | 20) & 0xFu; }
#define XB_SPIN(cond, bar) do { unsigned _sp = 0; while (cond) { __builtin_amdgcn_s_sleep(1); \
    if ((++_sp & 255u) == 0u) { if (xb_ld(&(bar)[XB_TMO])) break; if (_sp > XB_SPIN_CAP) { atomicAdd(&(bar)[XB_TMO], 1u); break; } } } } while (0)
struct XcdBarrier { unsigned* bar; unsigned x; volatile LAS unsigned* st; };
__device__ __forceinline__ XcdBarrier xcd_barrier_post(unsigned* bar, volatile LAS unsigned* st) {
    XcdBarrier b; b.bar = bar; b.x = xb_xcc_id(); b.st = st;
    if (threadIdx.x == 0) (void)xb_add(&bar[XB_XCNT(b.x)], 1u);
    return b;
}
__device__ __forceinline__ void xcd_barrier_complete(unsigned* bar, unsigned x, unsigned& nloc, unsigned& nx) {
    const unsigned G = gridDim.x * gridDim.y * gridDim.z;
    unsigned sum, cnt, mine, sp = 0u;
    for (;;) {
        sum = 0u; cnt = 0u; mine = 0u;
#pragma unroll
        for (unsigned j = 0; j < 16; ++j) { const unsigned c = xb_ld(&bar[XB_XCNT(j)]); sum += c; cnt += (c > 0u) ? 1u : 0u; mine = (j == x) ? c : mine; }
        if (sum == G) break;
        __builtin_amdgcn_s_sleep(1);
        if ((++sp & 255u) == 0u) { if (xb_ld(&bar[XB_TMO])) break; if (sp > XB_SPIN_CAP) { atomicAdd(&bar[XB_TMO], 1u); break; } }
    }
    nloc = mine > 0u ? mine : 1u; nx = cnt > 0u ? cnt : 1u;
}
__device__ __forceinline__ void xcd_barrier(const XcdBarrier& b) {
    asm volatile("s_waitcnt vmcnt(0)" ::: "memory");
    __syncthreads();
    if (threadIdx.x == 0) {
        unsigned* bar = b.bar;
        __builtin_amdgcn_s_waitcnt(0);
        unsigned nloc = b.st[0], nx = b.st[1];
        if (nloc == 0u) { xcd_barrier_complete(bar, b.x, nloc, nx); b.st[0] = nloc; b.st[1] = nx; }
        const unsigned old = xb_add(&bar[XB_XSUB(b.x)], 1u);
        const unsigned gen = old / nloc;
        if (old + 1u == (gen + 1u) * nloc) {
            __builtin_amdgcn_fence(__ATOMIC_RELEASE, "agent");
            asm volatile("s_waitcnt vmcnt(0)" ::: "memory");
            const unsigned og = xb_add(&bar[XB_TOP], 1u);
            const unsigned tg = og / nx;
            if (og + 1u == (tg + 1u) * nx) xb_add(&bar[XB_TOPGEN], 1u);
            else XB_SPIN(xb_ld(&bar[XB_TOPGEN]) == tg, bar);
            __builtin_amdgcn_fence(__ATOMIC_ACQUIRE, "agent");
            xb_add(&bar[XB_XGEN(b.x)], 1u);
            asm volatile("s_waitcnt vmcnt(0)" ::: "memory");
        } else {
            XB_SPIN(xb_ld(&bar[XB_XGEN(b.x)]) == gen, bar);
            __builtin_amdgcn_fence(__ATOMIC_ACQUIRE, "agent");
            asm volatile("s_waitcnt vmcnt(0)" ::: "memory");
        }
    }
    __syncthreads();
}

struct Args { const float* in[20]; float* out; unsigned char* ws; int ph_lo, ph_hi, li, pad; };
enum { I_X = 0, I_C, I_CTX, I_CCTX, I_WADA, I_BADA, I_G1, I_G2, I_WIN, I_GQ, I_GK, I_WCONV, I_WOUT, I_WR, I_BR, I_WGU, I_BGU, I_WDN, I_BDN, I_GF };

__device__ __forceinline__ void transpose_item64(const float* W, int ldw, bf16_t* WT, int Kd, int k0, int n0, int drow0, LAS float* scr, int lane) {
    const float* src = W + (size_t)k0 * ldw + n0 + lane;
    float v[64];
#pragma unroll
    for (int kk = 0; kk < 64; ++kk) v[kk] = src[(size_t)kk * ldw];
#pragma unroll
    for (int kk = 0; kk < 64; ++kk) scr[kk * 65 + lane] = v[kk];
    asm volatile("s_waitcnt lgkmcnt(0)" ::: "memory");
    const int c = lane & 7;
#pragma unroll
    for (int j = 0; j < 8; ++j) { const int n = (lane >> 3) + 8 * j; const LAS float* s = scr + (8 * c) * 65 + n;
        u32x4 o; o.x = cvt_pk_bf16(s[0 * 65], s[1 * 65]); o.y = cvt_pk_bf16(s[2 * 65], s[3 * 65]); o.z = cvt_pk_bf16(s[4 * 65], s[5 * 65]); o.w = cvt_pk_bf16(s[6 * 65], s[7 * 65]);
        *(GAS u32x4*)(WT + (size_t)(drow0 + n) * Kd + k0 + 8 * c) = o; }
    asm volatile("s_waitcnt lgkmcnt(0)" ::: "memory");
}
__device__ __forceinline__ void transpose_item64_f8(const float* W, int ldw, unsigned char* WT, int Kd, int k0, int n0, int drow0, float sc, LAS float* scr, int lane) {
    const float* src = W + (size_t)k0 * ldw + n0 + lane;
    float v[64];
#pragma unroll
    for (int kk = 0; kk < 64; ++kk) v[kk] = src[(size_t)kk * ldw];
#pragma unroll
    for (int kk = 0; kk < 64; ++kk) scr[kk * 65 + lane] = v[kk];
    asm volatile("s_waitcnt lgkmcnt(0)" ::: "memory");
    const int c = lane & 3;
#pragma unroll
    for (int j = 0; j < 4; ++j) { const int n = (lane >> 2) + 16 * j; const LAS float* sp = scr + (16 * c) * 65 + n;
        u32x4 o; o.x = pk4_fp8(sp[0 * 65] * sc, sp[1 * 65] * sc, sp[2 * 65] * sc, sp[3 * 65] * sc); o.y = pk4_fp8(sp[4 * 65] * sc, sp[5 * 65] * sc, sp[6 * 65] * sc, sp[7 * 65] * sc);
        o.z = pk4_fp8(sp[8 * 65] * sc, sp[9 * 65] * sc, sp[10 * 65] * sc, sp[11 * 65] * sc); o.w = pk4_fp8(sp[12 * 65] * sc, sp[13 * 65] * sc, sp[14 * 65] * sc, sp[15 * 65] * sc);
        *(GAS u32x4*)(WT + (size_t)(drow0 + n) * Kd + k0 + 16 * c) = o; }
    asm volatile("s_waitcnt lgkmcnt(0)" ::: "memory");
}
__device__ __forceinline__ int map_win(int n) { if (n < 1536) return n; if (n < 2048) { const int c = n - 1536; return 1536 + 256 * (c >> 7) + (c & 127); } const int c = n - 2048; return 1536 + 256 * (c >> 7) + 128 + (c & 127); }
__device__ __forceinline__ int map_gu(int n) { if (n < 1024) return 256 * (n >> 7) + (n & 127); const int c = n - 1024; return 256 * (c >> 7) + 128 + (c & 127); }

struct EpiNoPre { };
struct EpiQKV {
    static constexpr bool PERM = true; static constexpr int BMODE = 0; static constexpr bool PRE = false; using Pre = EpiNoPre;
    bf16_t *Q, *Kb, *Vb, *CB, *U; int pn0; float sc;
    __device__ __forceinline__ void operator()(const f32x4 (&acc)[2][2][4][2], const pg8::Unit& u, int wr, int wc, int fr, int fq) const {
        const int pn = u.pn + pn0, pm = u.pm, rloc = wr * 64 + fr, cl = wc * 32 + 8 * fq;
        if (pn >= 6) {
            bf16_t* base = U + (size_t)(pm * 256 + rloc) * CW + 128 * (pn - 6) + cl;
#pragma unroll
            for (int ai = 0; ai < 2; ++ai)
#pragma unroll
                for (int m = 0; m < 4; ++m) { const f32x4 v0 = acc[ai][0][m][0] * acc[ai][1][m][0], v1 = acc[ai][0][m][1] * acc[ai][1][m][1];
                    u32x4 w; w.x = cvt_pk_bf16(v0[0], v0[1]); w.y = cvt_pk_bf16(v0[2], v0[3]); w.z = cvt_pk_bf16(v1[0], v1[1]); w.w = cvt_pk_bf16(v1[2], v1[3]);
                    *(u32x4*)(base + (size_t)(ai * 128 + m * 16) * CW) = w; }
        } else {
            bf16_t* base; int ld;
            if (pn < 2) { base = Q + (size_t)(pm * 256) * QW + 256 * pn; ld = QW; }
            else if (pn < 4) { const int krow0 = pm < 128 ? (pm >> 6) * SKV + (pm & 63) * 256 : (pm - 128) * SKV + SEQ; base = (pn == 2 ? Kb : Vb) + (size_t)krow0 * KVW; ld = KVW; }
            else { base = CB + (size_t)(pm * 256) * CW + 256 * (pn - 4); ld = CW; }
            base += (size_t)rloc * ld + cl;
#pragma unroll
            for (int ai = 0; ai < 2; ++ai)
#pragma unroll
                for (int m = 0; m < 4; ++m)
#pragma unroll
                    for (int bj = 0; bj < 2; ++bj) { const f32x4 v0 = acc[ai][bj][m][0] * sc, v1 = acc[ai][bj][m][1] * sc;
                        u32x4 w; w.x = cvt_pk_bf16(v0[0], v0[1]); w.y = cvt_pk_bf16(v0[2], v0[3]); w.z = cvt_pk_bf16(v1[0], v1[1]); w.w = cvt_pk_bf16(v1[2], v1[3]);
                        *(u32x4*)(base + (size_t)(ai * 128 + m * 16) * ld + bj * 128) = w; }
        }
    }
};
struct QkvOrder {
    pg8::StaticOrder so;
    __device__ __forceinline__ bool next(int i, pg8::Unit& u) const {
        if (so.next(i, u)) return true;
        const long L = (long)i * so.G + so.c - so.nwg; if (L >= 4) return false;
        u.pm = 128 + (int)(L >> 1); u.pn = 2 + (int)(L & 1); u.e = 0; return true;
    }
};
struct EpiResid {
    static constexpr bool PERM = true; static constexpr int BMODE = 0; static constexpr bool PRE = false; using Pre = EpiNoPre;
    const float* gt; bf16_t* d1;
    __device__ __forceinline__ void operator()(const f32x4 (&acc)[2][2][4][2], const pg8::Unit& u, int wr, int wc, int fr, int fq) const {
        const int row0 = u.pm * 256 + wr * 64 + fr, col0 = u.pn * 256 + wc * 32 + 8 * fq, b = u.pm >> 6;
        f32x4 g[2][2];
#pragma unroll
        for (int bj = 0; bj < 2; ++bj)
#pragma unroll
            for (int n = 0; n < 2; ++n) g[bj][n] = *(const f32x4*)(gt + (size_t)b * NMOD + col0 + bj * 128 + n * 4);
#pragma unroll
        for (int ai = 0; ai < 2; ++ai)
#pragma unroll
            for (int m = 0; m < 4; ++m) { bf16_t* dp = d1 + (size_t)(row0 + ai * 128 + m * 16) * DM + col0;
#pragma unroll
                for (int bj = 0; bj < 2; ++bj) { const f32x4 v0 = g[bj][0] * acc[ai][bj][m][0], v1 = g[bj][1] * acc[ai][bj][m][1];
                    u32x4 w; w.x = cvt_pk_bf16(v0[0], v0[1]); w.y = cvt_pk_bf16(v0[2], v0[3]); w.z = cvt_pk_bf16(v1[0], v1[1]); w.w = cvt_pk_bf16(v1[2], v1[3]);
                    *(u32x4*)(dp + bj * 128) = w; } }
    }
};
struct EpiSwiglu {
    static constexpr bool PERM = true; static constexpr int BMODE = 0; static constexpr bool PRE = true;
    struct Pre { f32x4 bg[2], bl[2]; };
    const float* bgu; unsigned char* ACT;
    __device__ __forceinline__ void pre(const pg8::Unit& u, int wr, int wc, int fr, int fq, Pre& p) const {
        const float* bp = bgu + (size_t)u.e * 2048 + 128 * u.pn + wc * 32 + 8 * fq;
#pragma unroll
        for (int n = 0; n < 2; ++n) { p.bg[n] = *(const f32x4*)(bp + 4 * n); p.bl[n] = *(const f32x4*)(bp + 1024 + 4 * n); }
    }
    __device__ __forceinline__ void operator()(const f32x4 (&acc)[2][2][4][2], const pg8::Unit& u, int wr, int wc, int fr, int fq, const Pre& p) const {
        const int cl = wc * 32 + 8 * fq, c0 = 128 * u.pn + cl;
        f32x4 bg[2], bl[2];
#pragma unroll
        for (int n = 0; n < 2; ++n) { bg[n] = p.bg[n]; bl[n] = p.bl[n] + 1.0f; }
        unsigned char* base = ACT + (size_t)(u.pm * 256 + wr * 64 + fr) * DFF + c0;
#pragma unroll
        for (int ai = 0; ai < 2; ++ai)
#pragma unroll
            for (int m = 0; m < 4; ++m) { float o[8];
#pragma unroll
                for (int n = 0; n < 2; ++n)
#pragma unroll
                    for (int i = 0; i < 4; ++i) { float gv = acc[ai][0][m][n][i] * WINV + bg[n][i], lv = acc[ai][1][m][n][i] * WINV + bl[n][i];
                        gv = fminf(gv, 7.0f); lv = fminf(fmaxf(lv, -6.0f), 8.0f);
                        const float sg = __builtin_amdgcn_rcpf(1.0f + __builtin_amdgcn_exp2f(gv * (-1.702f * 1.4426950408889634f)));
                        o[n * 4 + i] = gv * sg * lv; }
                u32x2 w; w.x = pk4_fp8(o[0], o[1], o[2], o[3]); w.y = pk4_fp8(o[4], o[5], o[6], o[7]);
                *(u32x2*)(base + (size_t)(ai * 128 + m * 16) * DFF) = w; }
    }
};
struct EpiDown {
    static constexpr bool PERM = true; static constexpr int BMODE = 1; static constexpr bool PRE = true;
    struct Pre { int dd[2][4]; float gg[2][4]; };
    const float* bd; const int* pinfo; const float* pgate; const LAS int* cntL; const LAS int* ts; unsigned char* YP;
    __device__ __forceinline__ void pre(const pg8::Unit& u, int wr, int wc, int fr, int fq, Pre& p) const {
        const int pos0 = (u.pm - ts[u.e]) * 256 + wr * 64 + fr, cn = cntL[u.e];
#pragma unroll
        for (int ai = 0; ai < 2; ++ai)
#pragma unroll
            for (int m = 0; m < 4; ++m) { const int pos = pos0 + ai * 128 + m * 16; const bool ok = pos < cn; const size_t ix = (size_t)u.e * NTOK + (ok ? pos : 0);
                const int di = pinfo[ix]; const float gi = pgate[ix]; p.dd[ai][m] = ok ? di : -1; p.gg[ai][m] = gi; }
    }
    __device__ __forceinline__ void operator()(const f32x4 (&acc)[2][2][4][2], const pg8::Unit& u, int wr, int wc, int fr, int fq, const Pre& p) const {
        const int c0 = 256 * u.pn + 64 * wc + 16 * fq;
        const float* bp = bd + (size_t)u.e * DM + c0;
        f32x4 bv[2][2];
#pragma unroll
        for (int bj = 0; bj < 2; ++bj)
#pragma unroll
            for (int n = 0; n < 2; ++n) bv[bj][n] = *(const f32x4*)(bp + 8 * bj + 4 * n);
#pragma unroll
        for (int ai = 0; ai < 2; ++ai)
#pragma unroll
            for (int m = 0; m < 4; ++m) { const int d = p.dd[ai][m]; const float gt = p.gg[ai][m];
                if (d >= 0) { u32x4 w;
                    { const f32x4 v0 = (acc[ai][0][m][0] * WINV + bv[0][0]) * gt, v1 = (acc[ai][0][m][1] * WINV + bv[0][1]) * gt; w.x = pk4_fp8(v0[0], v0[1], v0[2], v0[3]); w.y = pk4_fp8(v1[0], v1[1], v1[2], v1[3]); }
                    { const f32x4 v0 = (acc[ai][1][m][0] * WINV + bv[1][0]) * gt, v1 = (acc[ai][1][m][1] * WINV + bv[1][1]) * gt; w.z = pk4_fp8(v0[0], v0[1], v0[2], v0[3]); w.w = pk4_fp8(v1[0], v1[1], v1[2], v1[3]); }
                    *(u32x4*)(YP + (size_t)d * DM + c0) = w; } }
    }
};
struct MoeOrder {
    pg8::StaticOrder so; const LAS int* te;
    __device__ __forceinline__ bool next(int i, pg8::Unit& u) const {
        if (!so.next(i, u)) return false;
        u.e = __builtin_amdgcn_readfirstlane(te[u.pm]); return true;
    }
};
__device__ __forceinline__ int moe_tables(const unsigned* cnt, LAS int* ts, LAS int* te, LAS int* cntL) {
    __syncthreads();
    if (threadIdx.x == 0) { int s = 0; for (int e = 0; e < NEXP; ++e) { const int c = (int)cnt[e]; cntL[e] = c; ts[e] = s; s += (c + 255) >> 8; } ts[NEXP] = s; }
    __syncthreads();
    const int T = ts[NEXP];
    for (int t = threadIdx.x; t < T; t += 512) { int e = 0; while (e < NEXP - 1 && t >= ts[e + 1]) ++e; te[t] = e; }
    __syncthreads();
    return T;
}

__global__ void __launch_bounds__(512, 2) fwd_kernel(Args args) {
    extern __shared__ __attribute__((aligned(16))) unsigned char lds[];
    LAS unsigned char* L = (LAS unsigned char*)lds;
    LAS unsigned* MISC = (LAS unsigned*)(L + MISC_OFF);
    const int wave = __builtin_amdgcn_readfirstlane(threadIdx.x >> 6);
#define PHASE_IDS int tid = threadIdx.x; asm volatile("" : "+v"(tid)); const int lane = tid & 63; (void)lane
    const int G = gridDim.x, bx = blockIdx.x;
    const int vcu = (G % 8 == 0) ? (bx % 8) * (G / 8) + bx / 8 : bx;
    const int gw = vcu * 8 + wave, NGW = G * 8;
    const bool bg_on = G * 2 * attn8::BG_TILES == NEXP * (16 * 32 + 16 * 16);
    unsigned char* ws = args.ws;
    unsigned* ctl = (unsigned*)(ws + WS_CTL);
    const float* x = args.in[I_X];
    float* mod = (float*)(ws + WS_MOD); float* rope = (float*)(ws + WS_ROPE); float* wrt = (float*)(ws + WS_WRT);
    unsigned char* WIN8 = ws + WS_WIN8; unsigned char* H8 = ws + WS_H8;
    bf16_t* WIN = (bf16_t*)(ws + WS_WIN); bf16_t* WOUT = (bf16_t*)(ws + WS_WOUT); unsigned char* WGU8 = ws + WS_WGU; unsigned char* WDN8 = ws + WS_WDN;
    bf16_t* Hb = (bf16_t*)(ws + WS_H); bf16_t* Qb = (bf16_t*)(ws + WS_Q); bf16_t* Kb = (bf16_t*)(ws + WS_K); bf16_t* Vb = (bf16_t*)(ws + WS_V);
    unsigned char* Q8 = ws + WS_Q8; unsigned char* K8 = ws + WS_K8; unsigned char* V8T = ws + WS_V8T;
    bf16_t* CBb = (bf16_t*)(ws + WS_CB); bf16_t* Ub = (bf16_t*)(ws + WS_U); bf16_t* MIX = (bf16_t*)(ws + WS_MIX);
    bf16_t* D1 = (bf16_t*)(ws + WS_X1); bf16_t* X1B = (bf16_t*)(ws + WS_X1 + 64 * MiB); unsigned char* H28 = ws + WS_H2;
    int* PINFO = (int*)(ws + WS_PINFO); float* PGATE = (float*)(ws + WS_PGATE);
    unsigned char* ACT8 = ws + WS_ACT; unsigned char* YP = ws + WS_YP;
    unsigned* cnt = ctl + CW_CNT;

    for (int u = threadIdx.x; u < (LDS_BYTES - MISC_OFF) / 4; u += 512) MISC[u] = 0u;
    __syncthreads();
    XcdBarrier bar; bar.bar = ctl + CW_BAR + args.li * XCD_BAR_WORDS; bar.x = 0; bar.st = nullptr;
#if !MK_PER_PHASE
    bar = xcd_barrier_post(ctl + CW_BAR + args.li * XCD_BAR_WORDS, (volatile LAS unsigned*)(MISC + MO_BAR / 4));
#endif
    const int lo = args.ph_lo, hi = args.ph_hi;
#define IN(k) (lo <= (k) && (k) < hi)
#if MK_PER_PHASE
#define SEAM(k) do { } while (0)
#else
#define SEAM(k) do { if (IN(k) && IN((k) + 1)) xcd_barrier(bar); } while (0)
#endif

    if (IN(0)) {
        PHASE_IDS;
        {
            LAS float* sv = (LAS float*)L;
            LAS float* red = sv + 3 * DM;
            const float* w_ada = args.in[I_WADA]; const float* b_ada = args.in[I_BADA];
            for (int item = bx; item < NMOD / 32; item += G) {
                __syncthreads();
                for (int i = tid; i < 3 * DM; i += 512) { const int j = i >> 10, k = i & 1023; const float cv = j < 2 ? args.in[I_C][j * DM + k] : args.in[I_CCTX][k];
                    sv[i] = cv / (1.0f + __expf(-cv)); }
                __syncthreads();
                const int c0 = item * 32, col = lane & 31, ks = lane >> 5;
                float a0 = 0.f, a1 = 0.f, a2 = 0.f;
                const float* wp = w_ada + (size_t)(wave * 128 + ks) * NMOD + c0 + col;
#pragma unroll 16
                for (int i = 0; i < 64; ++i) { const float wv = wp[(size_t)(2 * i) * NMOD]; const int k = wave * 128 + 2 * i + ks;
                    a0 += sv[k] * wv; a1 += sv[DM + k] * wv; a2 += sv[2 * DM + k] * wv; }
                a0 += __shfl_xor(a0, 32); a1 += __shfl_xor(a1, 32); a2 += __shfl_xor(a2, 32);
                if (lane < 32) { red[(wave * 3 + 0) * 32 + col] = a0; red[(wave * 3 + 1) * 32 + col] = a1; red[(wave * 3 + 2) * 32 + col] = a2; }
                __syncthreads();
                if (tid < 96) { const int j = tid >> 5, cc = tid & 31; float s = b_ada[c0 + cc];
#pragma unroll
                    for (int w = 0; w < 8; ++w) s += red[(w * 3 + j) * 32 + cc];
                    mod[(size_t)j * NMOD + c0 + cc] = s; }
            }
            __syncthreads();
        }
        for (int idx = vcu * 512 + tid; idx < 256 * 32; idx += G * 512) {
            const int pos = idx >> 5, i = idx & 31;
            const float invf = exp2f(-(float)(2 * i) * (13.287712379549449f / 64.0f));
            const float ang = (float)pos * invf;
            const double rev = (double)ang * 0.15915494309189535;
            const float fr_ = (float)(rev - rint(rev));
            rope[2 * idx] = __builtin_amdgcn_cosf(fr_); rope[2 * idx + 1] = __builtin_amdgcn_sinf(fr_);
        }
        for (int idx = vcu * 512 + tid; idx < NEXP * DM; idx += G * 512) { const int e = idx >> 10, k = idx & 1023; wrt[idx] = args.in[I_WR][k * NEXP + e]; }
        {
            LAS float* scr = (LAS float*)(L + wave * 16640);
            constexpr int I_IN = 16 * 40, I_OUT = 16 * 16, I_GU1 = 16 * 32, I_DN1 = 16 * 16;
            constexpr int NITEMS = I_IN + I_OUT + NEXP * I_GU1 + NEXP * I_DN1;
            const int nitems = bg_on ? I_IN + I_OUT : NITEMS;
            for (int it = gw; it < nitems; it += NGW) {
                int r = it;
                if (r < I_IN) { const int kb = r / 40, nb = r % 40; if (nb < 16) transpose_item64_f8(args.in[I_WIN], INC, WIN8, DM, 64 * kb, 64 * nb, 64 * nb, WSCALE, scr, lane);
                    else transpose_item64(args.in[I_WIN], INC, WIN, DM, 64 * kb, 64 * nb, map_win(64 * nb), scr, lane); continue; } r -= I_IN;
                if (r < I_OUT) { const int kb = r / 16, nb = r % 16; transpose_item64(args.in[I_WOUT], DM, WOUT, DM, 64 * kb, 64 * nb, 64 * nb, scr, lane); continue; } r -= I_OUT;
                if (r < NEXP * I_GU1) { const int e = r / I_GU1, q = r % I_GU1, kb = q / 32, nb = q % 32;
                    transpose_item64_f8(args.in[I_WGU] + (size_t)e * DM * 2048, 2048, WGU8 + (size_t)e * 2048 * DM, DM, 64 * kb, 64 * nb, map_gu(64 * nb), WSCALE, scr, lane); continue; } r -= NEXP * I_GU1;
                { const int e = r / I_DN1, q = r % I_DN1, kb = q / 16, nb = q % 16;
                    transpose_item64_f8(args.in[I_WDN] + (size_t)e * DFF * DM, DM, WDN8 + (size_t)e * DM * DFF, DFF, 64 * kb, 64 * nb, 64 * nb, WSCALE, scr, lane); }
            }
        }
    }
    SEAM(0);

    if (IN(1)) {
        PHASE_IDS;
        const float* g1 = args.in[I_G1];
        int curm = -1; f32x4 gs[4], sh[4];
        for (int r0 = gw * 2; r0 < MROWS; r0 += NGW * 2) {
            const int mb = r0 < NTOK ? (r0 >> 14) : 2;
            if (mb != curm) { curm = mb;
#pragma unroll
                for (int j = 0; j < 4; ++j) { const int c = 4 * lane + 256 * j; const f32x4 g = *(const f32x4*)(g1 + c), s = *(const f32x4*)(mod + (size_t)mb * NMOD + DM + c);
                    gs[j] = g * (s + 1.0f); sh[j] = *(const f32x4*)(mod + (size_t)mb * NMOD + c); } }
            f32x4 v[2][4]; float ss[2] = {0.f, 0.f};
#pragma unroll
            for (int q = 0; q < 2; ++q) { const int r = r0 + q;
                const float* src = r < NTOK ? x + (size_t)r * DM : args.in[I_CTX] + (size_t)(r - NTOK) * DM;
                const GAS f32x4* xr = (const GAS f32x4*)src + lane;
#pragma unroll
                for (int j = 0; j < 4; ++j) { v[q][j] = xr[64 * j]; ss[q] += (v[q][j].x * v[q][j].x + v[q][j].y * v[q][j].y) + (v[q][j].z * v[q][j].z + v[q][j].w * v[q][j].w); } }
#pragma unroll
            for (int q = 0; q < 2; ++q) { const int r = r0 + q;
                const float rstd = rsqrtf(wave_sum(ss[q]) * (1.f / DM) + NORM_EPS);
                GAS u32x2* o8 = (GAS u32x2*)(Hb + (size_t)r * DM) + lane;
                GAS unsigned* o4 = (GAS unsigned*)(H8 + (size_t)r * DM) + lane;
#pragma unroll
                for (int j = 0; j < 4; ++j) { const f32x4 y = v[q][j] * rstd * gs[j] + sh[j]; u32x2 w; w.x = cvt_pk_bf16(y.x, y.y); w.y = cvt_pk_bf16(y.z, y.w); o8[64 * j] = w; o4[64 * j] = pk4_fp8(y.x, y.y, y.z, y.w); } }
        }
    }
    SEAM(1);

    if (IN(2)) {
        {
            pg8::Gemm g{(const bf16_t*)H8, (const bf16_t*)WIN8, MROWS, 1024, DM / 2, 0, nullptr, nullptr, nullptr, 0};
            QkvOrder S; S.so.init(NTOK / 256, 4, G, bx);
            EpiQKV E{Qb, Kb, Vb, CBb, Ub, 0, WINV};
            pg8::gemm_phase<EpiQKV, QkvOrder, true, true, true>(L, g, S, E);
        }
        {
            pg8::Gemm g{Hb, WIN + (size_t)1024 * DM, NTOK, INC - 1024, DM, 0, nullptr, nullptr, nullptr, 0};
            pg8::StaticOrder S; S.init(NTOK / 256, 6, G, bx);
            EpiQKV E{Qb, Kb, Vb, CBb, Ub, 4, 1.0f};
            pg8::gemm_phase<EpiQKV, pg8::StaticOrder, true, true>(L, g, S, E);
        }
    }
    SEAM(2);

    if (IN(3)) {
        PHASE_IDS;
        const float* gq = args.in[I_GQ]; const float* gk = args.in[I_GK]; const float* wconv = args.in[I_WCONV];
        const f32x2 gq2 = *(const f32x2*)(gq + 2 * lane), gk2 = *(const f32x2*)(gk + 2 * lane);
        float cw0[8], cw1[8], cw2[8];
#pragma unroll
        for (int i = 0; i < 8; ++i) { cw0[i] = wconv[8 * lane + i]; cw1[i] = wconv[CW + 8 * lane + i]; cw2[i] = wconv[2 * CW + 8 * lane + i]; }
        const int hb4 = (lane >> 4) & 1;
        for (int chunk = gw; chunk < NTOK / 16; chunk += NGW) {
            const int r0 = chunk * 16;
            u32x4 up, uc, un; { const int t0 = r0 & (SEQ - 1); up = t0 == 0 ? (u32x4){0, 0, 0, 0} : *(const u32x4*)(Ub + (size_t)(r0 - 1) * CW + 8 * lane); uc = *(const u32x4*)(Ub + (size_t)r0 * CW + 8 * lane); }
            for (int rr = 0; rr < 16; ++rr) {
                const int r = r0 + rr, b = r >> 14, t = r & (SEQ - 1), prow = t >> 6, pcol = t & 63;
                un = t == SEQ - 1 ? (u32x4){0, 0, 0, 0} : *(const u32x4*)(Ub + (size_t)(r + 1) * CW + 8 * lane);
                const f32x4 cs = *(const f32x4*)(rope + ((size_t)((lane >> 5) ? pcol : prow) * 32 + 2 * (lane & 15)) * 2);
                unsigned qv[4], kv[2];
#pragma unroll
                for (int h = 0; h < 4; ++h) qv[h] = *(const unsigned*)(Qb + (size_t)r * QW + h * HD + 2 * lane);
                bf16_t* krow = Kb + ((size_t)b * SKV + t) * KVW;
#pragma unroll
                for (int h = 0; h < 2; ++h) kv[h] = *(const unsigned*)(krow + h * HD + 2 * lane);
#pragma unroll
                for (int h = 0; h < 6; ++h) {
                    const unsigned w = h < 4 ? qv[h] : kv[h - 4]; const f32x2 g2 = h < 4 ? gq2 : gk2;
                    float a = bf_lo(w), c = bf_hi(w);
                    const float rstd = rsqrtf(wave_sum(a * a + c * c) * (1.f / HD) + NORM_EPS);
                    a = a * rstd * g2.x; c = c * rstd * g2.y;
                    const float pa = __shfl_xor(a, 16), pc = __shfl_xor(c, 16);
                    const float oa = hb4 ? a * cs.x + pa * cs.y : a * cs.x - pa * cs.y;
                    const float oc = hb4 ? c * cs.z + pc * cs.w : c * cs.z - pc * cs.w;
                    if (h < 4) *(unsigned short*)(Q8 + (size_t)r * QW + h * HD + 2 * lane) = (unsigned short)__builtin_amdgcn_cvt_pk_fp8_f32(oa * (QSCALE * attn8::YS), oc * (QSCALE * attn8::YS), 0, false);
                    else *(unsigned short*)(K8 + ((size_t)b * SKV + t) * KVW + (h - 4) * HD + 2 * lane) = (unsigned short)__builtin_amdgcn_cvt_pk_fp8_f32(oa, oc, 0, false);
                }
                const u32x4 cbv = *(const u32x4*)(CBb + (size_t)r * CW + 8 * lane);
                u32x4 ov;
#pragma unroll
                for (int q = 0; q < 4; ++q) {
                    const float y0 = bf_lo(up[q]) * cw0[2 * q] + bf_lo(uc[q]) * cw1[2 * q] + bf_lo(un[q]) * cw2[2 * q];
                    const float y1 = bf_hi(up[q]) * cw0[2 * q + 1] + bf_hi(uc[q]) * cw1[2 * q + 1] + bf_hi(un[q]) * cw2[2 * q + 1];
                    ov[q] = cvt_pk_bf16(bf_lo(cbv[q]) * y0, bf_hi(cbv[q]) * y1);
                }
                *(u32x4*)(MIX + (size_t)r * DM + QW + 8 * lane) = ov;
                up = uc; uc = un;
            }
        }
        for (int cr = gw; cr < NCTX; cr += NGW) {
            bf16_t* krow = Kb + ((size_t)(cr >> 8) * SKV + SEQ + (cr & 255)) * KVW;
#pragma unroll
            for (int h = 0; h < 2; ++h) { const unsigned w = *(const unsigned*)(krow + h * HD + 2 * lane); float a = bf_lo(w), c = bf_hi(w);
                const float rstd = rsqrtf(wave_sum(a * a + c * c) * (1.f / HD) + NORM_EPS);
                *(unsigned short*)(K8 + ((size_t)(cr >> 8) * SKV + SEQ + (cr & 255)) * KVW + h * HD + 2 * lane) = (unsigned short)__builtin_amdgcn_cvt_pk_fp8_f32(a * rstd * gk2.x, c * rstd * gk2.y, 0, false); }
        }
        {
            LAS unsigned short* vt = (LAS unsigned short*)L;
            for (int item = bx; item < BATCH * (SKV / 64); item += G) {
                const int b = item / (SKV / 64), t64 = item % (SKV / 64);
                __syncthreads();
#pragma unroll
                for (int i = 0; i < 4; ++i) { const int cid = tid + 512 * i, row = cid >> 5, c16 = cid & 31;
                    *(LAS u32x4*)(vt + row * 264 + c16 * 8) = *(const u32x4*)(Vb + ((size_t)b * SKV + 64 * t64 + row) * KVW + c16 * 8); }
                __syncthreads();
                const int dr = tid >> 1, h = tid & 1; unsigned w[8];
#pragma unroll
                for (int q = 0; q < 8; ++q) { float f[4];
#pragma unroll
                    for (int i = 0; i < 4; ++i) { const int j = 4 * q + i, r = j & 15, key = 32 * (j >> 4) + (r & 3) + 8 * (r >> 2) + 4 * h; f[i] = __uint_as_float((unsigned)vt[key * 264 + dr] << 16); }
                    w[q] = pk4_fp8(f[0], f[1], f[2], f[3]); }
                unsigned char* dst = V8T + ((size_t)(b * 2 + (dr >> 7)) * HD + (dr & 127)) * SKV + 64 * t64 + 32 * h;
                *(u32x4*)dst = (u32x4){w[0], w[1], w[2], w[3]}; *(u32x4*)(dst + 16) = (u32x4){w[4], w[5], w[6], w[7]};
            }
            __syncthreads();
        }
    }
    SEAM(3);

    if (IN(4)) {
        PHASE_IDS;
        for (int i = 0;; ++i) {
            const int U = i * G + vcu; if (U >= BATCH * NQH * (SEQ / 256)) break;
            const int combo = U >> 7, hl = (U >> 6) & 1, qb = U & 63, b = combo >> 1, kvh = combo & 1, hq = kvh * 2 + hl;
            attn8::bf16* Op = (attn8::bf16*)MIX + ((size_t)(b * SEQ + qb * 256)) * DM + hq * HD;
            if (bg_on && i < 2) attn8::attn_body<true>(Q8 + ((size_t)(b * SEQ + qb * 256)) * QW + hq * HD, K8 + (size_t)b * SKV * KVW + kvh * HD, V8T + (size_t)(b * 2 + kvh) * HD * SKV, Op, SKV, (char*)lds,
                (vcu * 2 + i) * attn8::BG_TILES, args.in[I_WGU], args.in[I_WDN], WGU8, WDN8, ws + WS_ACT + 150 * MiB);
            else attn8::attn_body<false>(Q8 + ((size_t)(b * SEQ + qb * 256)) * QW + hq * HD, K8 + (size_t)b * SKV * KVW + kvh * HD, V8T + (size_t)(b * 2 + kvh) * HD * SKV, Op, SKV, (char*)lds,
                0, nullptr, nullptr, nullptr, nullptr, nullptr);
            __syncthreads();
        }
    }
    SEAM(4);

    if (IN(5)) {
#if MK_ATTN_CHECK
        {
            PHASE_IDS;
            LAS float* red = (LAS float*)L;
            LAS unsigned* mx = (LAS unsigned*)(L + 8192);
            for (int ci = 0; ci < 4; ++ci) {
                const unsigned U = (unsigned)bx * 4u + (unsigned)ci; const int b = U & 1, hq = (U >> 1) & 3, kvh = hq >> 1, t = (int)((U * 2654435761u >> 7) % (unsigned)SEQ);
                __syncthreads(); if (tid < 2) mx[tid] = 0u; __syncthreads();
                const unsigned qw = *(const unsigned short*)(Q8 + ((size_t)(b * SEQ + t)) * QW + hq * HD + 2 * lane); const float q0 = __builtin_amdgcn_cvt_f32_fp8((int)qw, 0), q1 = __builtin_amdgcn_cvt_f32_fp8((int)qw, 1);
                float lsum = 0.f, o0 = 0.f, o1 = 0.f;
                for (int key = wave; key < SKV; key += 8) {
                    const unsigned kw = *(const unsigned short*)(K8 + ((size_t)b * SKV + key) * KVW + kvh * HD + 2 * lane);
                    const int kl = key & 63, tt = kl >> 5, cc = kl & 31, hh = (cc >> 2) & 1, rr2 = (cc & 3) + 4 * (cc >> 3), pos = (key & ~63) + 32 * hh + 16 * tt + rr2;
                    const unsigned char* vp = V8T + ((size_t)(b * 2 + kvh) * HD + 2 * lane) * SKV + pos;
                    const float v0 = __builtin_amdgcn_cvt_f32_fp8((int)vp[0], 0), v1 = __builtin_amdgcn_cvt_f32_fp8((int)vp[SKV], 0);
                    const float dot = wave_sum(q0 * __builtin_amdgcn_cvt_f32_fp8((int)kw, 0) + q1 * __builtin_amdgcn_cvt_f32_fp8((int)kw, 1)); const float p = exp2f(dot * (1.0f / attn8::YS));
                    lsum += p; o0 += p * v0; o1 += p * v1; }
                red[wave * 132 + 2 * lane] = o0; red[wave * 132 + 2 * lane + 1] = o1; if (lane == 0) red[wave * 132 + 128] = lsum;
                __syncthreads();
                if (tid < 128) { float os = 0.f, ls = 0.f;
                    for (int w = 0; w < 8; ++w) { os += red[w * 132 + tid]; ls += red[w * 132 + 128]; }
                    const float ref = os / ls; const unsigned short mv = *(const unsigned short*)(MIX + ((size_t)(b * SEQ + t)) * DM + hq * HD + tid); const float got = __uint_as_float((unsigned)mv << 16);
                    float err = fabsf(got - ref); if (!(err == err)) err = 1e30f;
                    atomicMax((unsigned*)&mx[0], __float_as_uint(err)); atomicMax((unsigned*)&mx[1], __float_as_uint(fabsf(ref))); }
                __syncthreads();
                if (tid == 0) { const float e = __uint_as_float(mx[0]), r = __uint_as_float(mx[1]); if (e > 0.08f * r + 1e-5f) atomicOr(ctl + CW_FLAG, 1u); }
            }
            __syncthreads();
        }
#endif
        pg8::Gemm g{MIX, WOUT, NTOK, DM, DM, 0, nullptr, nullptr, nullptr, 0};
        pg8::StaticOrder S; S.init(NTOK / 256, DM / 256, G, bx);
        EpiResid E{mod + 2 * DM, D1};
        pg8::gemm_phase<EpiResid, pg8::StaticOrder, true, true>(L, g, S, E);
    }
    SEAM(5);

    if (IN(6)) {
        PHASE_IDS;
        LAS float* wl = (LAS float*)L;
        for (int i = tid; i < NEXP * DM / 4; i += 512) ((LAS f32x4*)wl)[i] = ((const f32x4*)wrt)[i];
        LAS int* hist = (LAS int*)(MISC + MO_HIST / 4); LAS int* baseL = (LAS int*)(MISC + MO_BASE / 4);
        LAS int* sele = (LAS int*)(MISC + MO_SELE / 4); LAS float* selg = (LAS float*)(MISC + MO_SELG / 4);
        const float* g2 = args.in[I_G2]; const float* brt = args.in[I_BR];
        const float br_l = brt[8 * (lane >> 4) + (lane & 7)];
        if (bx == 0 && tid < 64) ((u32x4*)(H28 + (size_t)NTOK * DM))[tid] = (u32x4){0, 0, 0, 0};
        for (int tb = bx; tb < NTOK / 128; tb += G) {
            __syncthreads();
            if (tid < NEXP) hist[tid] = 0;
            __syncthreads();
            const int b = (tb * 128) >> 14;
            f32x4 gs[4], sh[4];
            { int lo_ = lane; asm volatile("" : "+v"(lo_));
#pragma unroll
              for (int j = 0; j < 4; ++j) { const int c = 4 * lo_ + 256 * j; const f32x4 g = *(const f32x4*)(g2 + c), s = *(const f32x4*)(mod + (size_t)b * NMOD + 4 * DM + c);
                gs[j] = g * (s + 1.0f); sh[j] = *(const f32x4*)(mod + (size_t)b * NMOD + 3 * DM + c); } }
            f32x4 xq[2][4]; u32x2 dq[2][4];
#define P6_LOAD(G_) do { _Pragma("unroll") for (int rr = 0; rr < 2; ++rr) { const int r = tb * 128 + wave * 16 + (G_) * 2 + rr; \
                const GAS f32x4* xr = (const GAS f32x4*)(x + (size_t)r * DM) + lane; const GAS u32x2* dr = (const GAS u32x2*)(D1 + (size_t)r * DM) + lane; \
                _Pragma("unroll") for (int j = 0; j < 4; ++j) { xq[rr][j] = xr[64 * j]; dq[rr][j] = dr[64 * j]; } } } while (0)
            P6_LOAD(0);
#pragma unroll 1
            for (int grp = 0; grp < 8; ++grp) {
                const int tl0 = wave * 16 + grp * 2;
                f32x4 v[2][4];
#pragma unroll
                for (int rr = 0; rr < 2; ++rr)
#pragma unroll
                    for (int j = 0; j < 4; ++j) v[rr][j] = xq[rr][j] + (f32x4){bf_lo(dq[rr][j].x), bf_hi(dq[rr][j].x), bf_lo(dq[rr][j].y), bf_hi(dq[rr][j].y)};
                __builtin_amdgcn_sched_barrier(0);
                { const int gn = grp + 1 < 8 ? grp + 1 : 7; P6_LOAD(gn); }
                __builtin_amdgcn_sched_barrier(0);
#pragma unroll
                for (int rr = 0; rr < 2; ++rr) { const int r = tb * 128 + tl0 + rr; float s = 0.f;
#pragma unroll
                    for (int j = 0; j < 4; ++j) s += (v[rr][j].x * v[rr][j].x + v[rr][j].y * v[rr][j].y) + (v[rr][j].z * v[rr][j].z + v[rr][j].w * v[rr][j].w);
                    const float rstd = rsqrtf(wave_sum(s) * (1.f / DM) + NORM_EPS);
                    GAS unsigned* o4 = (GAS unsigned*)(H28 + (size_t)r * DM) + lane;
                    GAS u32x2* x1w = (GAS u32x2*)(X1B + (size_t)r * DM) + lane;
#pragma unroll
                    for (int j = 0; j < 4; ++j) { x1w[64 * j] = (u32x2){cvt_pk_bf16(v[rr][j].x, v[rr][j].y), cvt_pk_bf16(v[rr][j].z, v[rr][j].w)};
                        v[rr][j] = v[rr][j] * rstd * gs[j] + sh[j]; o4[64 * j] = pk4_fp8(v[rr][j].x, v[rr][j].y, v[rr][j].z, v[rr][j].w); } }
                float lg[2];
                {
                    float q[2][16];
#pragma unroll
                    for (int i = 0; i < 16; ++i) {
                        float pa[2], pb[2];
#pragma unroll
                        for (int h2 = 0; h2 < 2; ++h2) { const int e = i + 16 * h2;
                            f32x4 w[4];
#pragma unroll
                            for (int j = 0; j < 4; ++j) w[j] = *(const LAS f32x4*)(wl + e * DM + 4 * lane + 256 * j);
#pragma unroll
                            for (int rr = 0; rr < 2; ++rr) {
                                f32x2 a = __builtin_shufflevector(v[rr][0], v[rr][0], 0, 1) * __builtin_shufflevector(w[0], w[0], 0, 1);
                                a = __builtin_elementwise_fma(__builtin_shufflevector(v[rr][0], v[rr][0], 2, 3), __builtin_shufflevector(w[0], w[0], 2, 3), a);
#pragma unroll
                                for (int j = 1; j < 4; ++j) { a = __builtin_elementwise_fma(__builtin_shufflevector(v[rr][j], v[rr][j], 0, 1), __builtin_shufflevector(w[j], w[j], 0, 1), a);
                                    a = __builtin_elementwise_fma(__builtin_shufflevector(v[rr][j], v[rr][j], 2, 3), __builtin_shufflevector(w[j], w[j], 2, 3), a); }
                                (h2 ? pb : pa)[rr] = a.x + a.y; } }
#pragma unroll
                        for (int rr = 0; rr < 2; ++rr) { auto r = __builtin_amdgcn_permlane32_swap(__float_as_uint(pa[rr]), __float_as_uint(pb[rr]), false, false); q[rr][i] = __uint_as_float(r[0]) + __uint_as_float(r[1]); }
                        __builtin_amdgcn_sched_barrier(0);
                    }
#pragma unroll
                    for (int rr = 0; rr < 2; ++rr) {
                        float t8[8];
#pragma unroll
                        for (int i = 0; i < 8; ++i) { auto r = __builtin_amdgcn_permlane16_swap(__float_as_uint(q[rr][i]), __float_as_uint(q[rr][i + 8]), false, false); float t = __uint_as_float(r[0]) + __uint_as_float(r[1]);
                            t += dpp_f<0xB1>(t); t += dpp_f<0x4E>(t); t += dpp_f<0x141>(t); t += dpp_f<0x140>(t); t8[i] = t; }
                        const float a0 = (lane & 1) ? t8[1] : t8[0], a1 = (lane & 1) ? t8[3] : t8[2], a2 = (lane & 1) ? t8[5] : t8[4], a3 = (lane & 1) ? t8[7] : t8[6];
                        const float b0 = (lane & 2) ? a1 : a0, b1 = (lane & 2) ? a3 : a2;
                        lg[rr] = (lane & 4) ? b1 : b0;
                    }
                }
                const int e_l = 8 * (lane >> 4) + (lane & 7);
#pragma unroll
                for (int rr = 0; rr < 2; ++rr) {
                    float val = lg[rr] + br_l; int si[4]; float sv4[4];
#pragma unroll
                    for (int k = 0; k < 4; ++k) { float m = half_max(val);
                        { auto r = __builtin_amdgcn_permlane32_swap(__float_as_uint(m), __float_as_uint(m), false, false); m = fmaxf(__uint_as_float(r[0]), __uint_as_float(r[1])); }
                        const unsigned long long bal = __ballot(val == m);
                        const int fl = __builtin_amdgcn_readfirstlane(__ffsll((long long)bal) - 1);
                        const int idx = 8 * (fl >> 4) + (fl & 7);
                        si[k] = idx; sv4[k] = m;
                        if (e_l == idx) val = -INFINITY; }
                    const float e1 = __expf(sv4[1] - sv4[0]), e2 = __expf(sv4[2] - sv4[0]), e3 = __expf(sv4[3] - sv4[0]);
                    const float inv = 1.0f / (1.0f + e1 + e2 + e3);
                    if (lane < 4) { const int e = lane == 0 ? si[0] : lane == 1 ? si[1] : lane == 2 ? si[2] : si[3];
                        const float gt = (lane == 0 ? 1.0f : lane == 1 ? e1 : lane == 2 ? e2 : e3) * inv;
                        const int rank = __hip_atomic_fetch_add(hist + e, 1, __ATOMIC_RELAXED, __HIP_MEMORY_SCOPE_WORKGROUP);
                        sele[(tl0 + rr) * 4 + lane] = e | (rank << 8); selg[(tl0 + rr) * 4 + lane] = gt; }
                }
            }
#undef P6_LOAD
            __syncthreads();
            if (tid < NEXP) baseL[tid] = (int)atomicAdd(&cnt[tid], (unsigned)hist[tid]);
            __syncthreads();
            { const int v = sele[tid], e = v & 31, pos = baseL[e] + (v >> 8);
              PINFO[(size_t)e * NTOK + pos] = (tb * 128 + (tid >> 2)) * 4 + (tid & 3); PGATE[(size_t)e * NTOK + pos] = selg[tid]; }
        }
    }
    SEAM(6);


    if (IN(8)) {
        LAS int* ts = (LAS int*)(MISC + MO_TS / 4); LAS int* te = (LAS int*)(MISC + MO_TE / 4);
        const int T = moe_tables(cnt, ts, te, (LAS int*)(MISC + MO_HIST / 4));
        pg8::Gemm g{(const bf16_t*)H28, (const bf16_t*)WGU8, T * 256, 2048, DM / 2, (size_t)2048 * DM, PINFO, cnt, ts, NTOK};
        MoeOrder S; S.so.init(T, 8, G, bx); S.te = te;
        EpiSwiglu E{args.in[I_BGU], ACT8};
        pg8::gemm_phase<EpiSwiglu, MoeOrder, true, true, true, true>(L, g, S, E);
    }
    SEAM(8);

    if (IN(9)) {
        LAS int* ts = (LAS int*)(MISC + MO_TS / 4); LAS int* te = (LAS int*)(MISC + MO_TE / 4);
        LAS int* cntL = (LAS int*)(MISC + MO_HIST / 4);
        const int T = moe_tables(cnt, ts, te, cntL);
        pg8::Gemm g{(const bf16_t*)ACT8, (const bf16_t*)WDN8, T * 256, DM, DFF / 2, (size_t)DM * DFF, nullptr, nullptr, nullptr, 0};
        MoeOrder S; S.so.init(T, 4, G, bx); S.te = te;
        EpiDown E{args.in[I_BDN], PINFO, PGATE, cntL, ts, YP};
        pg8::gemm_phase<EpiDown, MoeOrder, true, true, true>(L, g, S, E);
    }
    SEAM(9);

    if (IN(10)) {
        PHASE_IDS;
        const float* gf = args.in[I_GF];
        f32x4 gfv[4];
#pragma unroll
        for (int j = 0; j < 4; ++j) gfv[j] = *(const f32x4*)(gf + 4 * lane + 256 * j);
        int curb = -1; f32x4 gtv[4];
        for (int r0 = gw * 2; r0 < NTOK; r0 += NGW * 2) {
            const int b = r0 >> 14;
            if (b != curb) { curb = b;
#pragma unroll
                for (int j = 0; j < 4; ++j) gtv[j] = *(const f32x4*)(mod + (size_t)b * NMOD + 5 * DM + 4 * lane + 256 * j); }
            f32x4 v[2][4]; float s[2] = {0.f, 0.f};
#pragma unroll
            for (int q = 0; q < 2; ++q) { const int r = r0 + q;
                const GAS u32x2* dr = (const GAS u32x2*)(X1B + (size_t)r * DM) + lane;
#pragma unroll
                for (int j = 0; j < 4; ++j) {
                    f32x4 y = {0.f, 0.f, 0.f, 0.f};
#pragma unroll
                    for (int k = 0; k < 4; ++k) { const int w = (int)((const GAS unsigned*)(YP + ((size_t)r * 4 + k) * DM))[lane + 64 * j];
                        y.x += __builtin_amdgcn_cvt_f32_fp8(w, 0); y.y += __builtin_amdgcn_cvt_f32_fp8(w, 1); y.z += __builtin_amdgcn_cvt_f32_fp8(w, 2); y.w += __builtin_amdgcn_cvt_f32_fp8(w, 3); }
                    const u32x2 dw = dr[64 * j];
                    v[q][j] = (f32x4){bf_lo(dw.x), bf_hi(dw.x), bf_lo(dw.y), bf_hi(dw.y)} + gtv[j] * y;
                    s[q] += (v[q][j].x * v[q][j].x + v[q][j].y * v[q][j].y) + (v[q][j].z * v[q][j].z + v[q][j].w * v[q][j].w);
                } }
#pragma unroll
            for (int q = 0; q < 2; ++q) { const int r = r0 + q;
                const float rstd = rsqrtf(wave_sum(s[q]) * (1.f / DM) + NORM_EPS);
                GAS f32x4* o = (GAS f32x4*)(args.out + (size_t)r * DM) + lane;
#if MK_ATTN_CHECK
                const float poison = ctl[CW_FLAG] ? __builtin_nanf("") : 0.f;
#pragma unroll
                for (int j = 0; j < 4; ++j) o[64 * j] = v[q][j] * rstd * gfv[j] + poison;
#else
#pragma unroll
                for (int j = 0; j < 4; ++j) o[64 * j] = v[q][j] * rstd * gfv[j];
#endif
            }
        }
    }
#undef IN
#undef SEAM
#undef PHASE_IDS
}

extern "C" void kernel_launch(void* const* d_in, const int* in_sizes, int n_in, void* d_out, int out_size, void* d_ws, size_t ws_size, hipStream_t stream) {
    static int grid = 0;
    if (grid == 0) {
        if (n_in != 20 || in_sizes[0] != NTOK * DM || out_size != NTOK * DM || ws_size < WS_END) {
            fprintf(stderr, "kernel_launch: shape mismatch (n_in %d, in0 %d, out %d, ws %zu; need ws >= %zu); nothing launched\n", n_in, n_in > 0 ? in_sizes[0] : -1, out_size, ws_size, (size_t)WS_END); grid = -1; return; }
        int dev = 0, cus = 0, per_cu = 0;
        if (hipGetDevice(&dev) != hipSuccess || hipDeviceGetAttribute(&cus, hipDeviceAttributeMultiprocessorCount, dev) != hipSuccess) { grid = -1; return; }
        if (hipFuncSetAttribute((const void*)fwd_kernel, hipFuncAttributeMaxDynamicSharedMemorySize, LDS_BYTES) != hipSuccess) { fprintf(stderr, "kernel_launch: hipFuncSetAttribute failed\n"); grid = -1; return; }
        if (hipOccupancyMaxActiveBlocksPerMultiprocessor(&per_cu, (const void*)fwd_kernel, 512, LDS_BYTES) != hipSuccess || per_cu < 1)
            fprintf(stderr, "kernel_launch: note: occupancy query reports %d workgroups per CU\n", per_cu);
        (void)hipGetLastError();
        grid = cus;
    }
    if (grid < 0) return;
    if (hipMemsetAsync((char*)d_ws + WS_CTL, 0, CTL_ZERO_BYTES, stream) != hipSuccess) return;
    Args a{};
    for (int i = 0; i < 20; ++i) a.in[i] = (const float*)d_in[i];
    a.out = (float*)d_out; a.ws = (unsigned char*)d_ws;
#if MK_PER_PHASE
    for (int p = 0; p < NPHASE; ++p) { a.ph_lo = p; a.ph_hi = p + 1; hipLaunchKernelGGL(fwd_kernel, dim3(grid), dim3(512), LDS_BYTES, stream, a); }
#elif MK_DUP >= 0
    a.ph_lo = 0; a.ph_hi = MK_DUP + 1; a.li = 0; hipLaunchKernelGGL(fwd_kernel, dim3(grid), dim3(512), LDS_BYTES, stream, a);
    a.ph_lo = MK_DUP; a.ph_hi = NPHASE; a.li = 1; hipLaunchKernelGGL(fwd_kernel, dim3(grid), dim3(512), LDS_BYTES, stream, a);
#else
    a.ph_lo = 0; a.ph_hi = NPHASE;
    hipLaunchKernelGGL(fwd_kernel, dim3(grid), dim3(512), LDS_BYTES, stream, a);
#endif
    const hipError_t le = hipPeekAtLastError();
    if (le != hipSuccess) fprintf(stderr, "kernel_launch: launch failed: %s\n", hipGetErrorName(le));
}
```

```cpp
#include <hip/hip_runtime.h>
#include <hip/hip_bf16.h>
#include <cstdio>
#include <cstdint>

#ifndef MK_DUP
#define MK_DUP (-1)
#endif
#ifndef MK_ATTN_CHECK
#define MK_ATTN_CHECK 0
#endif
#ifndef MK_PER_PHASE
#define MK_PER_PHASE 0
#endif

constexpr int BATCH = 2, SEQ = 16384, DM = 1024, NTOK = BATCH * SEQ, CTXL = 256, NCTX = BATCH * CTXL, MROWS = NTOK + NCTX;
constexpr int SKV = SEQ + CTXL;
constexpr int HD = 128, NQH = 4, NKVH = 2, QW = NQH * HD  , KVW = NKVH * HD  , CW = 512;
constexpr int INC = 2560, NMOD = 6 * DM;
constexpr int NEXP = 32, TOPK = 4, DFF = 1024;
constexpr float NORM_EPS = 1e-6f;
constexpr float WSCALE = 32.0f, WINV = 1.0f / 32.0f;
constexpr int MAXTILES = (NTOK * TOPK) / 256 + NEXP;
constexpr int MAXROWS = MAXTILES * 256;
constexpr int NPHASE = 11;

constexpr size_t MiB = 1u << 20;
constexpr size_t WS_CTL = 0, CTL_ZERO_BYTES = 1 * MiB;
constexpr size_t WS_MOD = 1 * MiB;
constexpr size_t WS_ROPE = WS_MOD + 128 * 1024;
constexpr size_t WS_WRT = WS_ROPE + 128 * 1024;
constexpr size_t WS_WIN8 = WS_MOD + 512 * 1024;
constexpr size_t WS_WIN = 3 * MiB;
constexpr size_t WS_WOUT = 8 * MiB;
constexpr size_t WS_WGU = 10 * MiB;
constexpr size_t WS_WDN = 138 * MiB;
constexpr size_t WS_X1 = 202 * MiB;
constexpr size_t WS_H2 = 330 * MiB;
constexpr size_t WS_PINFO = 395 * MiB;
constexpr size_t WS_PGATE = 399 * MiB;
constexpr size_t WS_R1 = 404 * MiB;
constexpr size_t WS_H = WS_R1;
constexpr size_t WS_Q = WS_R1 + 65 * MiB;
constexpr size_t WS_K = WS_Q + 32 * MiB;
constexpr size_t WS_V = WS_K + 17 * MiB;
constexpr size_t WS_CB = WS_V + 17 * MiB;
constexpr size_t WS_U = WS_CB + 32 * MiB;
constexpr size_t WS_MIX = WS_U + 32 * MiB;
constexpr size_t WS_Q8 = WS_H, WS_K8 = WS_H + 16 * MiB, WS_V8T = WS_H + 26 * MiB;
constexpr size_t WS_YP = WS_R1;
constexpr size_t WS_ACT = 676 * MiB;
constexpr size_t WS_H8 = WS_ACT;
constexpr size_t WS_END = 948 * MiB;
static_assert(WS_MIX + 64 * MiB <= WS_R1 + 272 * MiB && (size_t)MAXROWS * 2048 <= 272 * MiB, "ws map");
constexpr int CW_FLAG = 32;
constexpr int CW_CNT = 64;
constexpr int CW_BAR = 4096;

constexpr int LDS_BYTES = 163840;
constexpr int MISC_OFF = 155648;
constexpr int MO_BAR = 0, MO_TS = 64, MO_TE = 256, MO_HIST = 2816, MO_BASE = 2944, MO_SELE = 3072, MO_SELG = 5120;

#define GAS __attribute__((address_space(1)))
#define LAS __attribute__((address_space(3)))
typedef unsigned short bf16_t;
typedef short bf16x8 __attribute__((ext_vector_type(8)));
typedef float f32x4 __attribute__((ext_vector_type(4)));
typedef float f32x2 __attribute__((ext_vector_type(2)));
typedef unsigned u32x4 __attribute__((ext_vector_type(4)));
typedef unsigned u32x2 __attribute__((ext_vector_type(2)));
typedef int i32x4_t __attribute__((ext_vector_type(4)));
typedef int i32x8_t __attribute__((ext_vector_type(8)));

__device__ __forceinline__ unsigned cvt_pk_bf16(float lo, float hi) { unsigned r; asm volatile("v_cvt_pk_bf16_f32 %0, %1, %2" : "=v"(r) : "v"(lo), "v"(hi)); return r; }
__device__ __forceinline__ unsigned pk4_fp8(float a, float b, float c, float d) { unsigned w = 0; w = __builtin_amdgcn_cvt_pk_fp8_f32(a, b, w, false); w = __builtin_amdgcn_cvt_pk_fp8_f32(c, d, w, true); return w; }
__device__ __forceinline__ void st_wt(GAS unsigned* p, unsigned v) { asm volatile("global_store_dword %0, %1, off sc1" :: "v"(p), "v"(v) : "memory"); }
__device__ __forceinline__ void st_wt(GAS u32x2* p, u32x2 v) { asm volatile("global_store_dwordx2 %0, %1, off sc1" :: "v"(p), "v"(v) : "memory"); }
__device__ __forceinline__ void st_wt(GAS f32x4* p, f32x4 v) { asm volatile("global_store_dwordx4 %0, %1, off sc1\n\ts_nop 1" :: "v"(p), "v"(v) : "memory"); }
__device__ __forceinline__ float bf_lo(unsigned w) { return __uint_as_float(w << 16); }
__device__ __forceinline__ float bf_hi(unsigned w) { return __uint_as_float(w & 0xffff0000u); }
template <int CTRL> __device__ __forceinline__ float dpp_f(float v) { return __builtin_bit_cast(float, __builtin_amdgcn_update_dpp(0, __builtin_bit_cast(int, v), CTRL, 0xf, 0xf, true)); }
__device__ __forceinline__ float wave_sum(float v) {
    v += dpp_f<0xB1>(v); v += dpp_f<0x4E>(v); v += dpp_f<0x141>(v); v += dpp_f<0x140>(v);
    { auto r = __builtin_amdgcn_permlane16_swap(__float_as_uint(v), __float_as_uint(v), false, false); v = __uint_as_float(r[0]) + __uint_as_float(r[1]); }
    { auto r = __builtin_amdgcn_permlane32_swap(__float_as_uint(v), __float_as_uint(v), false, false); v = __uint_as_float(r[0]) + __uint_as_float(r[1]); }
    return v;
}
__device__ __forceinline__ float half_max(float v) {
    v = fmaxf(v, dpp_f<0xB1>(v)); v = fmaxf(v, dpp_f<0x4E>(v)); v = fmaxf(v, dpp_f<0x141>(v)); v = fmaxf(v, dpp_f<0x140>(v));
    { auto r = __builtin_amdgcn_permlane16_swap(__float_as_uint(v), __float_as_uint(v), false, false); v = fmaxf(__uint_as_float(r[0]), __uint_as_float(r[1])); }
    return v;
}

namespace pg8 {
constexpr int BM = 256, BK = 64, HALF = 128, HTB = HALF * BK * 2, STAGE_BYTES = 8 * HTB, NXCD = 8, WGM = 8;
__host__ __device__ __forceinline__ int lds_byte(int r, int c) { const int st = (r >> 4) * 2 + (c >> 5), rr = r & 15, cc = c & 31, ob = rr * 64 + cc * 2; return st * 1024 + (ob ^ (((ob >> 9) & 1) << 5)); }
__host__ __device__ __forceinline__ void stage_rc(int b, int& R, int& C) { const int st = b / 1024, sb = b % 1024, swz = sb ^ (((sb >> 9) & 1) << 5); R = (st >> 1) * 16 + swz / 64; C = (st & 1) * 32 + (swz % 64) / 2; }
__host__ __device__ __forceinline__ int perm32(int rho) { const int n = rho >> 4, i = rho & 15; return 8 * (i >> 2) + 4 * n + (i & 3); }

struct Unit { int pm, pn, e; };
struct Gemm { const bf16_t* A; const bf16_t* Bt; int M, N, K; size_t estride;
              const int* pinfo; const unsigned* cnt; const LAS int* ts; int ntok; };

struct StaticOrder {
    int nM, nN, nwg, G, c;
    __device__ void init(int nM_, int nN_, int G_, int c_) { nM = nM_; nN = nN_; nwg = nM * nN; G = G_; c = c_; }
    __device__ bool next(int i, Unit& u) const {
        const long L = (long)i * G + c; if (L >= nwg) return false;
        int wgid = (int)L; { const int q = nwg / NXCD, r = nwg % NXCD, xcd = wgid % NXCD, off = wgid / NXCD; wgid = (xcd < r ? xcd * (q + 1) : r * (q + 1) + (xcd - r) * q) + off; }
        const int nig = WGM * nN, gid = wgid / nig, fm = gid * WGM, gsz = (nM - fm) < WGM ? (nM - fm) : WGM;
        u.pm = fm + ((wgid % nig) % gsz); u.pn = (wgid % nig) / gsz; u.e = 0; return true;
    }
};

template <class Epi, class Sched, bool ALIGN_EPI = false, bool SP2 = false, bool FP8 = false, bool GATHER = false>
__device__ __forceinline__ void gemm_phase(LAS unsigned char* lds, const Gemm g, const Sched& S, const Epi& E) {
    int tid = threadIdx.x; asm volatile("" : "+v"(tid));
    const int wid = __builtin_amdgcn_readfirstlane(tid >> 6), lane = tid & 63, wr = wid >> 2, wc = wid & 3, fr = lane & 15, fq = lane >> 4;
    const int K = g.K, nt = K / BK;
    unsigned voffA[2], voffB[2], voffB1[2]; int Rrow[2]; unsigned cbyte[2];
#pragma unroll
    for (int i = 0; i < 2; ++i) { int R, C; stage_rc(tid * 16 + i * 8192, R, C); const int Rb = Epi::PERM ? ((R & ~31) + perm32(R & 31)) : R;
        voffA[i] = (unsigned)(R * K + C) * 2u; voffB[i] = (unsigned)(Rb * K + C) * 2u; Rrow[i] = R; cbyte[i] = (unsigned)C * 2u;
        if constexpr (Epi::BMODE == 1) {
            const int Rm = 64 * (R >> 5) + 16 * ((R & 15) >> 2) + 4 * ((R >> 4) & 1) + (R & 3);
            voffB[i] = (unsigned)(Rm * K + C) * 2u; voffB1[i] = (unsigned)((Rm + 8) * K + C) * 2u; } }
    unsigned gC[2][2], gN[2][2]; int gR[2][2];
#define PG8_GISSUE(u_) do { const int e_ = (u_).e; const int p0_ = ((u_).pm - g.ts[e_]) * 256; const int c_ = (int)g.cnt[e_]; \
        _Pragma("unroll") for (int h_ = 0; h_ < 2; ++h_) _Pragma("unroll") for (int i_ = 0; i_ < 2; ++i_) { const int pos_ = p0_ + 128 * h_ + Rrow[i_]; \
            const int* ap_ = g.pinfo + (size_t)e_ * g.ntok + (pos_ < c_ ? pos_ : 0); asm volatile("global_load_dword %0, %1, off" : "=v"(gR[h_][i_]) : "v"(ap_) : "memory"); } } while (0)
#define PG8_GCONV(u_, dst_) do { const int e_ = (u_).e; const int p0_ = ((u_).pm - g.ts[e_]) * 256; const int c_ = (int)g.cnt[e_]; \
        asm volatile("" : "+v"(gR[0][0]), "+v"(gR[0][1]), "+v"(gR[1][0]), "+v"(gR[1][1])); \
        _Pragma("unroll") for (int h_ = 0; h_ < 2; ++h_) _Pragma("unroll") for (int i_ = 0; i_ < 2; ++i_) { const int pos_ = p0_ + 128 * h_ + Rrow[i_]; \
            const int tok_ = pos_ < c_ ? (gR[h_][i_] >> 2) : g.ntok; dst_[h_][i_] = (unsigned)tok_ * (unsigned)(K * 2) + cbyte[i_]; } } while (0)
#define PG8_STAGE_B(bufoff, bbase, bj) do { if constexpr (Epi::BMODE == 1) { if ((bj) == 0) PG8_STAGE(bufoff, bbase, voffB); else PG8_STAGE(bufoff, bbase, voffB1); } \
        else { PG8_STAGE(bufoff, (bbase) + (bj) * hstep, voffB); } } while (0)
#define PG8_STAGE_A(bufoff, abase, h, nx) do { if constexpr (GATHER) { unsigned vs_[2] = {(nx) ? gN[h][0] : gC[h][0], (nx) ? gN[h][1] : gC[h][1]}; PG8_STAGE(bufoff, abase, vs_); } \
        else { PG8_STAGE(bufoff, (abase) + (h) * hstep, voffA); } } while (0)
    const size_t kstep = (size_t)(BK * 2);
    const size_t hstep = (size_t)HALF * K * 2;
    const size_t tstep = 2 * hstep;
    const unsigned ldsw = (unsigned)wid * 1024u;
    int aoff = lds_byte(wr * 64 + fr, fq * 8), boff = lds_byte(wc * 32 + fr, fq * 8) + 4 * HTB;
    asm volatile("" : "+v"(aoff), "+v"(boff));
#define PG8_SA(b, h) (((b) * 2 + (h)) * HTB)
#define PG8_SB(b, h) ((4 + (b) * 2 + (h)) * HTB)
#define PG8_STAGE(bufoff, gbase, voff) do { _Pragma("unroll") for (int _i = 0; _i < 2; ++_i) \
        __builtin_amdgcn_global_load_lds((const unsigned*)((const char*)(gbase) + (voff)[_i]), (LAS unsigned*)(lds + (bufoff) + ldsw + _i * 8192), 16, 0, 0); } while (0)
#define PG8_LD16(off) (*(const LAS i32x4_t*)(lds + (off)))
#define PG8_LDA(dst, b, h) do { _Pragma("unroll") for (int m = 0; m < 4; ++m) dst[m] = __builtin_shufflevector(PG8_LD16(aoff + PG8_SA(b, h) + m * 2048), PG8_LD16(aoff + PG8_SA(b, h) + m * 2048 + 1024), 0, 1, 2, 3, 4, 5, 6, 7); } while (0)
#define PG8_LDB(dst, b, h) do { _Pragma("unroll") for (int n = 0; n < 2; ++n) dst[n] = __builtin_shufflevector(PG8_LD16(boff + ((b) * 2 + (h)) * HTB + n * 2048), PG8_LD16(boff + ((b) * 2 + (h)) * HTB + n * 2048 + 1024), 0, 1, 2, 3, 4, 5, 6, 7); } while (0)
#define PG8_LOH(x) __builtin_bit_cast(bf16x8, __builtin_shufflevector((x), (x), 0, 1, 2, 3))
#define PG8_HIH(x) __builtin_bit_cast(bf16x8, __builtin_shufflevector((x), (x), 4, 5, 6, 7))
#define PG8_MMA(ai, bj, At, Bt) do { __builtin_amdgcn_s_setprio(1); if constexpr (FP8) { _Pragma("unroll") for (int m = 0; m < 4; ++m) _Pragma("unroll") for (int n = 0; n < 2; ++n) \
        asm volatile("v_mfma_f32_16x16x128_f8f6f4 %0, %1, %2, %0" : "+v"(acc[ai][bj][m][n]) : "v"(Bt[n]), "v"(At[m])); } else { \
        _Pragma("unroll") for (int m = 0; m < 4; ++m) _Pragma("unroll") for (int n = 0; n < 2; ++n) { \
        acc[ai][bj][m][n] = __builtin_amdgcn_mfma_f32_16x16x32_bf16(PG8_LOH(Bt[n]), PG8_LOH(At[m]), acc[ai][bj][m][n], 0, 0, 0); \
        acc[ai][bj][m][n] = __builtin_amdgcn_mfma_f32_16x16x32_bf16(PG8_HIH(Bt[n]), PG8_HIH(At[m]), acc[ai][bj][m][n], 0, 0, 0); } } __builtin_amdgcn_s_setprio(0); } while (0)
#define PG8_WAIT_V(n) asm volatile("s_waitcnt vmcnt(" #n ")" ::: "memory")
#define PG8_WAIT_L(n) asm volatile("s_waitcnt lgkmcnt(" #n ")" ::: "memory")
#define PG8_BAR __builtin_amdgcn_s_barrier()
#define PG8_SCHED __builtin_amdgcn_sched_barrier(0)
    Unit cur, nxt; int ui = 0;
    if (!S.next(0, cur)) return;
    f32x4 acc[2][2][4][2];
#pragma unroll
    for (int a = 0; a < 2; ++a)
#pragma unroll
        for (int b = 0; b < 2; ++b)
#pragma unroll
            for (int m = 0; m < 4; ++m)
#pragma unroll
                for (int n = 0; n < 2; ++n) acc[a][b][m][n] = (f32x4){0.f, 0.f, 0.f, 0.f};
    i32x8_t At[4], B0[2], B1[2];
    const char* cA = (const char*)g.A + (GATHER ? (size_t)0 : (size_t)cur.pm * tstep); const char* cB = (const char*)g.Bt + (size_t)cur.e * g.estride + (size_t)cur.pn * tstep;
    if constexpr (GATHER) { PG8_GISSUE(cur); asm volatile("s_waitcnt vmcnt(0)" ::: "memory"); PG8_GCONV(cur, gC);
#pragma unroll
        for (int h_ = 0; h_ < 2; ++h_)
#pragma unroll
            for (int i_ = 0; i_ < 2; ++i_) gN[h_][i_] = gC[h_][i_]; }
    if constexpr (SP2) {
        PG8_STAGE_B(PG8_SB(0, 0), cB, 0); PG8_STAGE_B(PG8_SB(0, 1), cB, 1); PG8_STAGE_A(PG8_SA(0, 0), cA, 0, false); PG8_STAGE_A(PG8_SA(0, 1), cA, 1, false);
        if (wr == 1) PG8_BAR;
        PG8_WAIT_V(2); PG8_BAR;
        PG8_STAGE_B(PG8_SB(1, 0), cB + kstep, 0); PG8_STAGE_A(PG8_SA(1, 0), cA + kstep, 0, false); PG8_STAGE_B(PG8_SB(1, 1), cB + kstep, 1);
        PG8_WAIT_V(6); PG8_BAR;
    } else {
        PG8_STAGE(PG8_SB(0, 0), cB, voffB); PG8_STAGE(PG8_SA(0, 0), cA, voffA); PG8_STAGE(PG8_SB(0, 1), cB + hstep, voffB); PG8_STAGE(PG8_SA(0, 1), cA + hstep, voffA);
        if (wr == 1) PG8_BAR;
        PG8_WAIT_V(4); PG8_BAR;
        PG8_STAGE(PG8_SB(1, 0), cB + kstep, voffB); PG8_STAGE(PG8_SA(1, 0), cA + kstep, voffA); PG8_STAGE(PG8_SB(1, 1), cB + hstep + kstep, voffB);
        PG8_WAIT_V(6); PG8_BAR;
    }
    typename Epi::Pre epre;
    if constexpr (Epi::PRE) E.pre(cur, wr, wc, fr, fq, epre);
    for (;;) {
        const bool has_next = S.next(ui + 1, nxt);
        const char* nA = (has_next && !GATHER) ? (const char*)g.A + (size_t)nxt.pm * tstep : cA; const char* nB = has_next ? (const char*)g.Bt + (size_t)nxt.e * g.estride + (size_t)nxt.pn * tstep : cB;
        if constexpr (GATHER) { if (has_next) PG8_GISSUE(nxt); }
#pragma unroll 1
        for (int t = 0; t < nt; t += 2) {
            const bool last = (t == nt - 2);
            const char* a1 = cA + (size_t)(t + 1) * kstep;
            const char* a2 = last ? nA : cA + (size_t)(t + 2) * kstep; const char* b2 = last ? nB : cB + (size_t)(t + 2) * kstep;
            const char* a3 = a2 + kstep; const char* b3 = b2 + kstep;
            if constexpr (GATHER) { if (last && has_next) PG8_GCONV(nxt, gN); }
            if constexpr (SP2) {
            PG8_LDB(B0, 0, 0); PG8_LDB(B1, 0, 1); PG8_SCHED; PG8_LDA(At, 0, 0); PG8_STAGE_A(PG8_SA(1, 1), a1, 1, false);
            PG8_WAIT_V(8); PG8_WAIT_L(0); PG8_BAR; PG8_MMA(0, 0, At, B0); PG8_MMA(0, 1, At, B1); PG8_BAR; PG8_SCHED;
            PG8_LDA(At, 0, 1); PG8_STAGE_B(PG8_SB(0, 0), b2, 0); PG8_STAGE_B(PG8_SB(0, 1), b2, 1); PG8_STAGE_A(PG8_SA(0, 0), a2, 0, last);
            PG8_WAIT_V(8); PG8_WAIT_L(0); PG8_BAR; PG8_MMA(1, 0, At, B0); PG8_MMA(1, 1, At, B1); PG8_BAR; PG8_SCHED;
            PG8_LDB(B0, 1, 0); PG8_LDB(B1, 1, 1); PG8_SCHED; PG8_LDA(At, 1, 0); PG8_STAGE_A(PG8_SA(0, 1), a2, 1, last);
            PG8_WAIT_V(8); PG8_WAIT_L(0); PG8_BAR; PG8_MMA(0, 0, At, B0); PG8_MMA(0, 1, At, B1); PG8_BAR; PG8_SCHED;
            PG8_LDA(At, 1, 1); PG8_STAGE_B(PG8_SB(1, 0), b3, 0); PG8_STAGE_B(PG8_SB(1, 1), b3, 1); PG8_STAGE_A(PG8_SA(1, 0), a3, 0, last);
            PG8_WAIT_V(8); PG8_WAIT_L(0); PG8_BAR; PG8_MMA(1, 0, At, B0); PG8_MMA(1, 1, At, B1); PG8_BAR; PG8_SCHED;
            } else {
            PG8_LDB(B0, 0, 0); PG8_SCHED; PG8_LDA(At, 0, 0); PG8_STAGE(PG8_SA(1, 1), a1 + hstep, voffA);
            PG8_WAIT_L(8); PG8_BAR; PG8_WAIT_L(0); PG8_MMA(0, 0, At, B0); PG8_BAR; PG8_SCHED;
            PG8_LDB(B1, 0, 1); PG8_STAGE(PG8_SB(0, 0), b2, voffB);
            PG8_BAR; PG8_WAIT_L(0); PG8_MMA(0, 1, At, B1); PG8_BAR;
            PG8_LDA(At, 0, 1); PG8_STAGE(PG8_SA(0, 0), a2, voffA);
            PG8_BAR; PG8_WAIT_L(0); PG8_MMA(1, 0, At, B0); PG8_BAR; PG8_SCHED;
            PG8_STAGE(PG8_SB(0, 1), b2 + hstep, voffB);
            PG8_WAIT_V(6); PG8_BAR; PG8_MMA(1, 1, At, B1); PG8_BAR;
            PG8_LDB(B0, 1, 0); PG8_SCHED; PG8_LDA(At, 1, 0); PG8_STAGE(PG8_SA(0, 1), a2 + hstep, voffA);
            PG8_WAIT_L(8); PG8_BAR; PG8_WAIT_L(0); PG8_MMA(0, 0, At, B0); PG8_BAR; PG8_SCHED;
            PG8_LDB(B1, 1, 1); PG8_STAGE(PG8_SB(1, 0), b3, voffB);
            PG8_BAR; PG8_WAIT_L(0); PG8_MMA(0, 1, At, B1); PG8_BAR;
            PG8_LDA(At, 1, 1); PG8_STAGE(PG8_SA(1, 0), a3, voffA);
            PG8_BAR; PG8_WAIT_L(0); PG8_MMA(1, 0, At, B0); PG8_BAR; PG8_SCHED;
            PG8_STAGE(PG8_SB(1, 1), b3 + hstep, voffB);
            PG8_WAIT_V(6); PG8_BAR; PG8_MMA(1, 1, At, B1); PG8_BAR;
            }
        }
        if constexpr (ALIGN_EPI) { if (wr == 0) PG8_BAR; }
        if constexpr (FP8) { asm volatile("s_nop 15\n\ts_nop 15\n\ts_nop 15" ::: "memory"); PG8_SCHED; }
        if constexpr (Epi::PRE) E(acc, cur, wr, wc, fr, fq, epre); else E(acc, cur, wr, wc, fr, fq);
        if (!has_next) break;
#pragma unroll
        for (int a = 0; a < 2; ++a)
#pragma unroll
            for (int b = 0; b < 2; ++b)
#pragma unroll
                for (int m = 0; m < 4; ++m)
#pragma unroll
                    for (int n = 0; n < 2; ++n) acc[a][b][m][n] = (f32x4){0.f, 0.f, 0.f, 0.f};
        cur = nxt; cA = nA; cB = nB; ++ui;
        if constexpr (Epi::PRE) E.pre(cur, wr, wc, fr, fq, epre);
        if constexpr (GATHER) {
#pragma unroll
            for (int h_ = 0; h_ < 2; ++h_)
#pragma unroll
                for (int i_ = 0; i_ < 2; ++i_) gC[h_][i_] = gN[h_][i_]; }
        if constexpr (ALIGN_EPI) { if (wr == 1) PG8_BAR; }
    }
    PG8_WAIT_V(0);
    if constexpr (!ALIGN_EPI) { if (wr == 0) PG8_BAR; }
    PG8_BAR;
#undef PG8_SA
#undef PG8_SB
#undef PG8_STAGE
#undef PG8_STAGE_A
#undef PG8_STAGE_B
#undef PG8_GISSUE
#undef PG8_GCONV
#undef PG8_LDA
#undef PG8_LDB
#undef PG8_MMA
#undef PG8_LOH
#undef PG8_HIH
#undef PG8_LD16
#undef PG8_WAIT_V
#undef PG8_WAIT_L
#undef PG8_BAR
#undef PG8_SCHED
}
}

constexpr float QSCALE = 0.088388347648318440f * 1.4426950408889634f;

namespace attn8 {
using bf16 = __hip_bfloat16;
constexpr int NW = 8, QBLK = 32, KVBLK = 64, LDO = DM;
constexpr int LDQB = QW, LDKB = KVW;
constexpr float YS = 8.f, Y0 = 56.f;
constexpr float THRY = Y0 + 8.f * YS;
constexpr int SLOT = 8192, NKS = 2, NVS = 4;
constexpr int LDS_KR = 0, LDS_VR = NKS * SLOT, LDS_WS = (NKS + NVS) * SLOT, SHM_ATTN = LDS_WS + NW * 256;
constexpr int LDS_BG = SHM_ATTN, BGT = 16384, BG_TILES = 48, BG_LAG = 4;
using f32x16 = __attribute__((ext_vector_type(16))) float;
using f32x8 = __attribute__((ext_vector_type(8))) float;
using u32x4g = __attribute__((ext_vector_type(4))) unsigned;
typedef __attribute__((address_space(3))) const char* lds_cptr;
#define SBAR() __builtin_amdgcn_sched_barrier(0)
__device__ __forceinline__ int crow(int r, int hi) { return (r & 3) + 8 * (r >> 2) + 4 * hi; }
__device__ __forceinline__ i32x8_t ld32(lds_cptr p0, lds_cptr p1) { return __builtin_shufflevector(*(const LAS i32x4_t*)p0, *(const LAS i32x4_t*)p1, 0, 1, 2, 3, 4, 5, 6, 7); }
__device__ __forceinline__ void mfma8_init(f32x16& d, const i32x8_t& a, const i32x8_t& b, const f32x16& c) { asm volatile("v_mfma_f32_32x32x64_f8f6f4 %0, %1, %2, %3" : "=&v"(d) : "v"(a), "v"(b), "v"(c)); }
__device__ __forceinline__ void mfma8_acc(f32x16& d, const i32x8_t& a, const i32x8_t& b) { asm volatile("v_mfma_f32_32x32x64_f8f6f4 %0, %1, %2, %0" : "+v"(d) : "v"(a), "v"(b)); }
__device__ __forceinline__ void mfma8_acc_pad(f32x16& d, const i32x8_t& a, const i32x8_t& b) { asm volatile("s_nop 3\n\tv_mfma_f32_32x32x64_f8f6f4 %0, %1, %2, %0" : "+v"(d) : "v"(a), "v"(b)); }
#define PK8(P, B) __builtin_amdgcn_cvt_pk_u8_f32(P[B + 3], 3u, __builtin_amdgcn_cvt_pk_u8_f32(P[B + 2], 2u, __builtin_amdgcn_cvt_pk_u8_f32(P[B + 1], 1u, __builtin_amdgcn_cvt_pk_u8_f32(P[B], 0u, 0u))))

template <bool BG>
__device__ __forceinline__ void attn_body(const unsigned char* __restrict__ Q8, const unsigned char* __restrict__ K8, const unsigned char* __restrict__ V8T, bf16* __restrict__ Ob, int seq, char* lds,
    int bg_t0, const float* __restrict__ bg_wgu, const float* __restrict__ bg_wdn, unsigned char* __restrict__ bg_gu8, unsigned char* __restrict__ bg_dn8, unsigned char* __restrict__ bg_dump) {
  int tid = threadIdx.x; asm volatile("" : "+v"(tid));
  const int lane = tid & 63, r32 = lane & 31, hi = lane >> 5; const int wid = __builtin_amdgcn_readfirstlane(tid >> 6);
  const lds_cptr L3 = (lds_cptr)lds;
  float* ws = (float*)(lds + LDS_WS) + wid * 64; float* li_l = ws; float* al_l = ws + 32;
  const bool kvw = wid < 4;
  unsigned koff, voff;
  { const int row = (wid & 3) * 16 + (lane >> 3), c = (lane & 7) ^ ((row >> 1) & 7); koff = (unsigned)(row * LDKB + c * 16); }
  { const int d = (wid & 3) * 32 + (lane >> 2), c = (lane & 3) ^ ((d >> 2) & 3); voff = (unsigned)(d * SKV + c * 16); }
  const unsigned pdst = (unsigned)(wid & 3) * 2048u;
#define DMA_PIECE(p, t, kslot, vslot) do { if (kvw) { \
    if ((p) == 0) { const char* sb_ = (const char*)K8 + (size_t)(t) * (KVBLK * LDKB); asm volatile("" : "+s"(sb_)); \
      __builtin_amdgcn_global_load_lds((const unsigned*)(sb_ + koff), (LAS unsigned*)((LAS unsigned char*)lds + LDS_KR + (kslot) * SLOT + pdst), 16, 0, 0); \
      __builtin_amdgcn_global_load_lds((const unsigned*)(sb_ + ((koff ^ 64u) + 8u * LDKB)), (LAS unsigned*)((LAS unsigned char*)lds + LDS_KR + (kslot) * SLOT + pdst + 1024u), 16, 0, 0); } \
    if ((p) == 1) { const char* sb_ = (const char*)V8T + (size_t)(t) * KVBLK; asm volatile("" : "+s"(sb_)); \
      __builtin_amdgcn_global_load_lds((const unsigned*)(sb_ + voff), (LAS unsigned*)((LAS unsigned char*)lds + LDS_VR + (vslot) * SLOT + pdst), 16, 0, 0); \
      __builtin_amdgcn_global_load_lds((const unsigned*)(sb_ + (voff + 16u * SKV)), (LAS unsigned*)((LAS unsigned char*)lds + LDS_VR + (vslot) * SLOT + pdst + 1024u), 16, 0, 0); } } } while (0)
#define DMA_ALL(t, kslot, vslot) do { DMA_PIECE(0, t, kslot, vslot); DMA_PIECE(1, t, kslot, vslot); } while (0)
  int ka[4], va[2];
#pragma unroll
  for (int q = 0; q < 4; ++q) ka[q] = LDS_KR + r32 * 128 + ((((q >> 1) * 4 + 2 * hi + (q & 1)) ^ ((r32 >> 1) & 7)) << 4);
#pragma unroll
  for (int i = 0; i < 2; ++i) va[i] = LDS_VR + r32 * 64 + (((2 * hi + i) ^ ((r32 >> 2) & 3)) << 4);
  const int NT = seq / KVBLK;
  DMA_ALL(0, 0, 0); DMA_ALL(1, 1, 1);
  i32x8_t q8[2];
  { const unsigned char* qp = Q8 + (size_t)(wid * QBLK + r32) * LDQB + 32 * hi;
    q8[0] = __builtin_shufflevector(*(const i32x4_t*)qp, *(const i32x4_t*)(qp + 16), 0, 1, 2, 3, 4, 5, 6, 7);
    q8[1] = __builtin_shufflevector(*(const i32x4_t*)(qp + 64), *(const i32x4_t*)(qp + 80), 0, 1, 2, 3, 4, 5, 6, 7); }
  float m_reg = 0.f; f32x16 o[4]; f32x16 lacc; f32x16 negm; f32x16 pA0, pA1, pB0, pB1; i32x8_t p8;
  const i32x8_t ones8 = {0x38383838, 0x38383838, 0x38383838, 0x38383838, 0x38383838, 0x38383838, 0x38383838, 0x38383838};
  asm volatile("s_waitcnt vmcnt(0) lgkmcnt(0)\n\ts_barrier" ::: "memory");
  { float y0 = Y0; asm volatile("" : "+v"(y0));
#pragma unroll
    for (int r = 0; r < 16; ++r) negm[r] = y0; }
  lacc = (f32x16){}; o[0] = (f32x16){}; o[1] = (f32x16){}; o[2] = (f32x16){}; o[3] = (f32x16){};
#define KFR(kbase, kh, s) ld32(L3 + (kbase) + ka[2 * (s)] + (kh) * 4096, L3 + (kbase) + ka[2 * (s) + 1] + (kh) * 4096)
#define VFR(vbase, db) ld32(L3 + (vbase) + va[0] + (db) * 2048, L3 + (vbase) + va[1] + (db) * 2048)
#define QK_TILE(C0, C1, kbase) do { const i32x8_t k00 = KFR(kbase, 0, 0), k01 = KFR(kbase, 0, 1), k10 = KFR(kbase, 1, 0), k11 = KFR(kbase, 1, 1); \
    mfma8_init(C0, k00, q8[0], negm); mfma8_acc(C0, k01, q8[1]); mfma8_init(C1, k10, q8[0], negm); mfma8_acc(C1, k11, q8[1]); } while (0)
#define ROWMAX_A(C0) float rm_ = fmaxf(C0[0], C0[1]); _Pragma("unroll") for (int r = 2; r < 16; ++r) rm_ = fmaxf(rm_, C0[r]);
#define ROWMAX_B(C1) _Pragma("unroll") for (int r = 0; r < 16; ++r) rm_ = fmaxf(rm_, C1[r]); \
    { auto rr = __builtin_amdgcn_permlane32_swap(__float_as_uint(rm_), __float_as_uint(rm_), false, false); rm_ = fmaxf(__uint_as_float(rr[0]), __uint_as_float(rr[1])); }
#define DECIDE(C0, C1, FIRST) do { if ((FIRST) || __builtin_expect(__any(rm_ > THRY), 0)) { const float dl = (FIRST) ? rm_ - Y0 : fmaxf(rm_ - Y0, 0.f); m_reg += dl; \
      _Pragma("unroll") for (int r = 0; r < 16; ++r) { C0[r] -= dl; C1[r] -= dl; } \
      _Pragma("unroll") for (int r = 0; r < 16; ++r) negm[r] = Y0 - m_reg; \
      if (!(FIRST)) { const float f = __builtin_amdgcn_exp2f(dl * (-1.0f / YS)); if (hi == 0) al_l[r32] = f; asm volatile("s_nop 15\n\ts_nop 15\n\ts_nop 15\n\ts_nop 15\n\ts_nop 15\n\ts_nop 15\n\ts_waitcnt lgkmcnt(0)" ::: "memory"); \
        _Pragma("unroll") for (int r = 0; r < 16; ++r) { const float fr_ = al_l[crow(r, hi)]; o[0][r] *= fr_; o[1][r] *= fr_; o[2][r] *= fr_; o[3][r] *= fr_; lacc[r] *= fr_; } } } } while (0)
#define FINISH(P0, P1) do { \
    p8[0] = PK8(P0, 0); p8[1] = PK8(P0, 4); p8[2] = PK8(P0, 8); p8[3] = PK8(P0, 12); p8[4] = PK8(P1, 0); p8[5] = PK8(P1, 4); p8[6] = PK8(P1, 8); p8[7] = PK8(P1, 12); } while (0)
#define PV_TILE(vbase) do { const i32x8_t v0_ = VFR(vbase, 0), v1_ = VFR(vbase, 1), v2_ = VFR(vbase, 2), v3_ = VFR(vbase, 3); \
    mfma8_acc_pad(o[0], p8, v0_); mfma8_acc(o[1], p8, v1_); mfma8_acc(o[2], p8, v2_); mfma8_acc(o[3], p8, v3_); mfma8_acc(lacc, p8, ones8); } while (0)
#define ITER_(C0, C1, P0, P1, KS, jj, TBAR, HOOK0, HOOK, RD, PF) do { const int vprev_ = (((jj) - 1) & 3) * SLOT; const int tn_ = (jj) + 2 < NT ? (jj) + 2 : NT - 1; const int vs2_ = ((jj) + 2) & 3; \
    if (RD) { kf0 = KFR((KS) * SLOT, 0, 0); kf1 = KFR((KS) * SLOT, 0, 1); } \
    const i32x8_t k10 = KFR((KS) * SLOT, 1, 0), k11 = KFR((KS) * SLOT, 1, 1); \
    mfma8_init(C0, kf0, q8[0], negm); p8[0] = PK8(P0, 0); p8[1] = PK8(P0, 4); SBAR(); \
    mfma8_acc(C0, kf1, q8[1]); p8[2] = PK8(P0, 8); p8[3] = PK8(P0, 12); SBAR(); \
    mfma8_init(C1, k10, q8[0], negm); p8[4] = PK8(P1, 0); p8[5] = PK8(P1, 4); SBAR(); \
    mfma8_acc(C1, k11, q8[1]); p8[6] = PK8(P1, 8); p8[7] = PK8(P1, 12); SBAR(); \
    TBAR; \
    i32x8_t va_ = VFR(vprev_, 0), vb_ = VFR(vprev_, 1); \
    mfma8_acc_pad(o[0], p8, va_); asm volatile("s_nop 7" ::: "memory"); ROWMAX_A(C0); SBAR(); \
    mfma8_acc(o[1], p8, vb_); va_ = VFR(vprev_, 2); vb_ = VFR(vprev_, 3); ROWMAX_B(C1); SBAR(); \
    mfma8_acc(o[2], p8, va_); DMA_PIECE(0, tn_, KS, vs2_); DMA_PIECE(1, tn_, KS, vs2_); SBAR(); \
    mfma8_acc(o[3], p8, vb_); SBAR(); f32x8 bgw; HOOK0; \
    mfma8_acc(lacc, p8, ones8); if (PF) { kf0 = KFR((1 - (KS)) * SLOT, 0, 0); kf1 = KFR((1 - (KS)) * SLOT, 0, 1); } SBAR(); HOOK; \
    DECIDE(C0, C1, false); SBAR(); } while (0)
#define TB0 asm volatile("s_waitcnt vmcnt(0)\n\ts_barrier" ::: "memory")
#define TBK do { if (kvw) asm volatile("s_waitcnt vmcnt(0)" ::: "memory"); asm volatile("s_barrier" ::: "memory"); } while (0)
#define NOHOOK do { } while (0)
#define ITER(C0, C1, P0, P1, KS, jj) ITER_(C0, C1, P0, P1, KS, jj, TB0, NOHOOK, NOHOOK, 0, 1)
  int bg_k = 0, bq = 0, bg_nsh = 12; const char* bg_src = (const char*)bg_wgu; unsigned char* bg_dst = bg_dump; unsigned bgo0 = 0u, bgo1 = 0u;
#define BG_DECODE_SRC(tt) do { int t_ = (tt); \
    if (t_ < 16384) { const int e_ = t_ >> 9, nb_ = (t_ >> 4) & 31, kb_ = t_ & 15; bg_src = (const char*)(bg_wgu + (size_t)e_ * (DM * 2048) + (size_t)kb_ * (64 * 2048) + nb_ * 64); bg_nsh = 13; } \
    else { t_ -= 16384; const int e_ = t_ >> 8, nb_ = (t_ >> 4) & 15, kb_ = t_ & 15; bg_src = (const char*)(bg_wdn + (size_t)e_ * (DFF * DM) + (size_t)kb_ * (64 * 1024) + nb_ * 64); bg_nsh = 12; } } while (0)
#define BG_DECODE_DST(tt) do { int t_ = (tt); \
    if (t_ < 16384) { const int e_ = t_ >> 9, nb_ = (t_ >> 4) & 31, kb_ = t_ & 15; bg_dst = bg_gu8 + (size_t)e_ * (2048 * DM) + (size_t)(256 * ((nb_ & 15) >> 1) + 128 * (nb_ >> 4) + 64 * (nb_ & 1)) * 1024 + kb_ * 64; } \
    else { t_ -= 16384; const int e_ = t_ >> 8, nb_ = (t_ >> 4) & 15, kb_ = t_ & 15; bg_dst = bg_dn8 + (size_t)e_ * (DM * DFF) + (size_t)(nb_ * 64) * 1024 + kb_ * 64; } } while (0)
#define BG_LOADH(H) do { if (!kvw) { \
    if ((H) == 0) asm volatile("s_waitcnt vmcnt(%0)" :: "n"(5 * (BG_LAG - 1)) : "memory"); \
    int ln_ = __builtin_amdgcn_mbcnt_hi(~0u, __builtin_amdgcn_mbcnt_lo(~0u, 0u)); asm volatile("" : "+v"(ln_)); \
    const LAS float* cp_ = (const LAS float*)((LAS unsigned char*)lds + LDS_BG + bq * BGT + (wid - 4) * 4096 + (H) * 2048) + ln_; \
    _Pragma("unroll") for (int r_ = 0; r_ < 8; ++r_) bgw[r_] = cp_[r_ * 64]; } else { asm volatile("" : "=v"(bgw)); } SBAR(); } while (0)
#define BG_CONV1() do { if (!kvw) { const f32x8 ws_ = bgw * WSCALE; bgo0 = pk4_fp8(ws_[0], ws_[1], ws_[2], ws_[3]); bgo1 = pk4_fp8(ws_[4], ws_[5], ws_[6], ws_[7]); } \
    else { asm volatile("" : "=v"(bgo0), "=v"(bgo1)); } SBAR(); } while (0)
#define BG_CONV2() do { if (!kvw) { \
    const int c_ = bg_k - BG_LAG; if (c_ < 0) bg_dst = bg_dump; else if ((c_ & 15) == 0) BG_DECODE_DST(bg_t0 + c_); else bg_dst += 64; \
    int ln_ = __builtin_amdgcn_mbcnt_hi(~0u, __builtin_amdgcn_mbcnt_lo(~0u, 0u)); asm volatile("" : "+v"(ln_)); \
    const f32x8 ws_ = bgw * WSCALE; u32x4g o_; o_.x = bgo0; o_.y = bgo1; o_.z = pk4_fp8(ws_[0], ws_[1], ws_[2], ws_[3]); o_.w = pk4_fp8(ws_[4], ws_[5], ws_[6], ws_[7]); \
    __builtin_nontemporal_store(o_, (u32x4g*)(bg_dst + (unsigned)(ln_ * 1024 + (wid - 4) * 16))); } SBAR(); } while (0)
#define BG_DMA() do { if (!kvw) { \
    if (bg_k < BG_TILES) { if ((bg_k & 15) == 0) BG_DECODE_SRC(bg_t0 + bg_k); else bg_src += (64u << bg_nsh); } \
    int ln_ = __builtin_amdgcn_mbcnt_hi(~0u, __builtin_amdgcn_mbcnt_lo(~0u, 0u)); asm volatile("" : "+v"(ln_)); \
    const unsigned so_ = ((unsigned)((wid - 4) * 16 + (ln_ >> 4)) << bg_nsh) + (unsigned)(ln_ & 15) * 16u; \
    LAS unsigned char* lb_ = (LAS unsigned char*)lds + LDS_BG + bq * BGT + (wid - 4) * 4096; \
    __builtin_amdgcn_global_load_lds((const unsigned*)(bg_src + so_), (LAS unsigned*)lb_, 16, 0, 2); \
    __builtin_amdgcn_global_load_lds((const unsigned*)(bg_src + so_ + (4u << bg_nsh)), (LAS unsigned*)(lb_ + 1024), 16, 0, 2); \
    __builtin_amdgcn_global_load_lds((const unsigned*)(bg_src + so_ + (8u << bg_nsh)), (LAS unsigned*)(lb_ + 2048), 16, 0, 2); \
    __builtin_amdgcn_global_load_lds((const unsigned*)(bg_src + so_ + (12u << bg_nsh)), (LAS unsigned*)(lb_ + 3072), 16, 0, 2); } \
    bq = bq == BG_LAG - 1 ? 0 : bq + 1; ++bg_k; SBAR(); } while (0)
#define ITER_BGA(C0, C1, P0, P1, KS, jj) ITER_(C0, C1, P0, P1, KS, jj, TBK, BG_LOADH(0), BG_CONV1(), 0, 0)
#define ITER_BGA2(C0, C1, P0, P1, KS, jj) ITER_(C0, C1, P0, P1, KS, jj, TBK, BG_LOADH(1), BG_CONV2(), 1, 0)
#define ITER_BGB(C0, C1, P0, P1, KS, jj) ITER_(C0, C1, P0, P1, KS, jj, TBK, BG_DMA(), NOHOOK, 1, 1)
#define ITER_BGP(C0, C1, P0, P1, KS, jj) ITER_(C0, C1, P0, P1, KS, jj, TBK, NOHOOK, NOHOOK, 0, 1)
  i32x8_t kf0, kf1;

  QK_TILE(pA0, pA1, 0);
  { asm volatile("s_nop 15\n\ts_nop 15" ::: "memory"); SBAR(); ROWMAX_A(pA0); ROWMAX_B(pA1); DECIDE(pA0, pA1, true); }
  kf0 = KFR(SLOT, 0, 0); kf1 = KFR(SLOT, 0, 1);
  asm volatile("s_waitcnt vmcnt(0)\n\ts_barrier" ::: "memory");
  DMA_ALL(2, 0, 2);
  int j = 1;
  if constexpr (BG) {
    for (; j < 1 + 4 * (BG_TILES + BG_LAG); j += 4) { ITER_BGA(pB0, pB1, pA0, pA1, 1, j); ITER_BGA2(pA0, pA1, pB0, pB1, 0, j + 1); ITER_BGB(pB0, pB1, pA0, pA1, 1, j + 2); ITER_BGP(pA0, pA1, pB0, pB1, 0, j + 3); }
  }
  for (; j + 1 < NT; j += 2) { ITER(pB0, pB1, pA0, pA1, 1, j); ITER(pA0, pA1, pB0, pB1, 0, j + 1); }
  ITER(pB0, pB1, pA0, pA1, 1, j);
  FINISH(pB0, pB1); SBAR();
  PV_TILE(((NT - 1) & 3) * SLOT);
  asm volatile("s_nop 15\n\ts_nop 15" ::: "memory"); SBAR();
  asm volatile("s_nop 15\n\ts_nop 15\n\ts_nop 15\n\ts_nop 15" ::: "memory"); SBAR();
  float rli[16];
#pragma unroll
  for (int r = 0; r < 16; ++r) rli[r] = __builtin_amdgcn_rcpf(lacc[r]);
  { int tid2 = threadIdx.x; asm volatile("" : "+v"(tid2));
    const int hi2 = (tid2 >> 5) & 1; bf16* Ow = Ob + (size_t)((tid2 >> 6) * QBLK) * LDO + (tid2 & 31);
#pragma unroll
    for (int r = 0; r < 16; ++r) { const int orow = crow(r, hi2);
#pragma unroll
      for (int d0 = 0; d0 < 4; ++d0) Ow[(long)orow * LDO + d0 * 32] = __float2bfloat16(o[d0][r] * rli[r]); } }
  asm volatile("s_waitcnt vmcnt(0) lgkmcnt(0)\n\ts_barrier" ::: "memory");
#undef DMA_PIECE
#undef DMA_ALL
#undef KFR
#undef VFR
#undef QK_TILE
#undef ROWMAX_A
#undef ROWMAX_B
#undef DECIDE
#undef FINISH
#undef PV_TILE
#undef ITER
#undef ITER_
#undef ITER_BGA
#undef ITER_BGB
#undef ITER_BGP
#undef TB0
#undef TBK
#undef BG_DMA
#undef BG_DECODE_SRC
#undef BG_DECODE_DST
#undef BG_LOADH
#undef BG_CONV1
#undef BG_CONV2
#undef ITER_BGA2
#undef NOHOOK
}
#undef PK8
#undef SBAR
}

#define XB_TMO      128
#define XB_XCNT(j)  (256  + 64 * (j))
#define XB_XSUB(j)  (1280 + 64 * (j))
#define XB_XGEN(j)  (2304 + 64 * (j))
#define XB_TOP      3328
#define XB_TOPGEN   3392
#define XCD_BAR_WORDS 3456
#define XB_SPIN_CAP (1u << 18)
__device__ __forceinline__ unsigned xb_ld(unsigned* p)              { return __hip_atomic_load(p, __ATOMIC_RELAXED, __HIP_MEMORY_SCOPE_AGENT); }
__device__ __forceinline__ unsigned xb_add(unsigned* p, unsigned v) { return __hip_atomic_fetch_add(p, v, __ATOMIC_RELAXED, __HIP_MEMORY_SCOPE_AGENT); }
__device__ __forceinline__ unsigned xb_xcc_id() { return (unsigned)__builtin_amdgcn_s_getreg((3 << 11) | 20) & 0xFu; }
#define XB_SPIN(cond, bar) do { unsigned _sp = 0; while (cond) { __builtin_amdgcn_s_sleep(1); \
    if ((++_sp & 255u) == 0u) { if (xb_ld(&(bar)[XB_TMO])) break; if (_sp > XB_SPIN_CAP) { atomicAdd(&(bar)[XB_TMO], 1u); break; } } } } while (0)
struct XcdBarrier { unsigned* bar; unsigned x; volatile LAS unsigned* st; };
__device__ __forceinline__ XcdBarrier xcd_barrier_post(unsigned* bar, volatile LAS unsigned* st) {
    XcdBarrier b; b.bar = bar; b.x = xb_xcc_id(); b.st = st;
    if (threadIdx.x == 0) (void)xb_add(&bar[XB_XCNT(b.x)], 1u);
    return b;
}
__device__ __forceinline__ void xcd_barrier_complete(unsigned* bar, unsigned x, unsigned& nloc, unsigned& nx) {
    const unsigned G = gridDim.x * gridDim.y * gridDim.z;
    unsigned sum, cnt, mine, sp = 0u;
    for (;;) {
        sum = 0u; cnt = 0u; mine = 0u;
#pragma unroll
        for (unsigned j = 0; j < 16; ++j) { const unsigned c = xb_ld(&bar[XB_XCNT(j)]); sum += c; cnt += (c > 0u) ? 1u : 0u; mine = (j == x) ? c : mine; }
        if (sum == G) break;
        __builtin_amdgcn_s_sleep(1);
        if ((++sp & 255u) == 0u) { if (xb_ld(&bar[XB_TMO])) break; if (sp > XB_SPIN_CAP) { atomicAdd(&bar[XB_TMO], 1u); break; } }
    }
    nloc = mine > 0u ? mine : 1u; nx = cnt > 0u ? cnt : 1u;
}
__device__ __forceinline__ void xcd_barrier(const XcdBarrier& b) {
    asm volatile("s_waitcnt vmcnt(0)" ::: "memory");
    __syncthreads();
    if (threadIdx.x == 0) {
        unsigned* bar = b.bar;
        __builtin_amdgcn_s_waitcnt(0);
        unsigned nloc = b.st[0], nx = b.st[1];
        if (nloc == 0u) { xcd_barrier_complete(bar, b.x, nloc, nx); b.st[0] = nloc; b.st[1] = nx; }
        const unsigned old = xb_add(&bar[XB_XSUB(b.x)], 1u);
        const unsigned gen = old / nloc;
        if (old + 1u == (gen + 1u) * nloc) {
            __builtin_amdgcn_fence(__ATOMIC_RELEASE, "agent");
            asm volatile("s_waitcnt vmcnt(0)" ::: "memory");
            const unsigned og = xb_add(&bar[XB_TOP], 1u);
            const unsigned tg = og / nx;
            if (og + 1u == (tg + 1u) * nx) xb_add(&bar[XB_TOPGEN], 1u);
            else XB_SPIN(xb_ld(&bar[XB_TOPGEN]) == tg, bar);
            __builtin_amdgcn_fence(__ATOMIC_ACQUIRE, "agent");
            xb_add(&bar[XB_XGEN(b.x)], 1u);
            asm volatile("s_waitcnt vmcnt(0)" ::: "memory");
        } else {
            XB_SPIN(xb_ld(&bar[XB_XGEN(b.x)]) == gen, bar);
            __builtin_amdgcn_fence(__ATOMIC_ACQUIRE, "agent");
            asm volatile("s_waitcnt vmcnt(0)" ::: "memory");
        }
    }
    __syncthreads();
}

struct Args { const float* in[20]; float* out; unsigned char* ws; int ph_lo, ph_hi, li, pad; };
enum { I_X = 0, I_C, I_CTX, I_CCTX, I_WADA, I_BADA, I_G1, I_G2, I_WIN, I_GQ, I_GK, I_WCONV, I_WOUT, I_WR, I_BR, I_WGU, I_BGU, I_WDN, I_BDN, I_GF };

__device__ __forceinline__ void transpose_item64(const float* W, int ldw, bf16_t* WT, int Kd, int k0, int n0, int drow0, LAS float* scr, int lane) {
    const float* src = W + (size_t)k0 * ldw + n0 + lane;
    float v[64];
#pragma unroll
    for (int kk = 0; kk < 64; ++kk) v[kk] = src[(size_t)kk * ldw];
#pragma unroll
    for (int kk = 0; kk < 64; ++kk) scr[kk * 65 + lane] = v[kk];
    asm volatile("s_waitcnt lgkmcnt(0)" ::: "memory");
    const int c = lane & 7;
#pragma unroll
    for (int j = 0; j < 8; ++j) { const int n = (lane >> 3) + 8 * j; const LAS float* s = scr + (8 * c) * 65 + n;
        u32x4 o; o.x = cvt_pk_bf16(s[0 * 65], s[1 * 65]); o.y = cvt_pk_bf16(s[2 * 65], s[3 * 65]); o.z = cvt_pk_bf16(s[4 * 65], s[5 * 65]); o.w = cvt_pk_bf16(s[6 * 65], s[7 * 65]);
        *(GAS u32x4*)(WT + (size_t)(drow0 + n) * Kd + k0 + 8 * c) = o; }
    asm volatile("s_waitcnt lgkmcnt(0)" ::: "memory");
}
__device__ __forceinline__ void transpose_item64_f8(const float* W, int ldw, unsigned char* WT, int Kd, int k0, int n0, int drow0, float sc, LAS float* scr, int lane) {
    const float* src = W + (size_t)k0 * ldw + n0 + lane;
    float v[64];
#pragma unroll
    for (int kk = 0; kk < 64; ++kk) v[kk] = src[(size_t)kk * ldw];
#pragma unroll
    for (int kk = 0; kk < 64; ++kk) scr[kk * 65 + lane] = v[kk];
    asm volatile("s_waitcnt lgkmcnt(0)" ::: "memory");
    const int c = lane & 3;
#pragma unroll
    for (int j = 0; j < 4; ++j) { const int n = (lane >> 2) + 16 * j; const LAS float* sp = scr + (16 * c) * 65 + n;
        u32x4 o; o.x = pk4_fp8(sp[0 * 65] * sc, sp[1 * 65] * sc, sp[2 * 65] * sc, sp[3 * 65] * sc); o.y = pk4_fp8(sp[4 * 65] * sc, sp[5 * 65] * sc, sp[6 * 65] * sc, sp[7 * 65] * sc);
        o.z = pk4_fp8(sp[8 * 65] * sc, sp[9 * 65] * sc, sp[10 * 65] * sc, sp[11 * 65] * sc); o.w = pk4_fp8(sp[12 * 65] * sc, sp[13 * 65] * sc, sp[14 * 65] * sc, sp[15 * 65] * sc);
        *(GAS u32x4*)(WT + (size_t)(drow0 + n) * Kd + k0 + 16 * c) = o; }
    asm volatile("s_waitcnt lgkmcnt(0)" ::: "memory");
}
__device__ __forceinline__ int map_win(int n) { if (n < 1536) return n; if (n < 2048) { const int c = n - 1536; return 1536 + 256 * (c >> 7) + (c & 127); } const int c = n - 2048; return 1536 + 256 * (c >> 7) + 128 + (c & 127); }
__device__ __forceinline__ int map_gu(int n) { if (n < 1024) return 256 * (n >> 7) + (n & 127); const int c = n - 1024; return 256 * (c >> 7) + 128 + (c & 127); }

struct EpiNoPre { };
struct EpiQKV {
    static constexpr bool PERM = true; static constexpr int BMODE = 0; static constexpr bool PRE = false; using Pre = EpiNoPre;
    bf16_t *Q, *Kb, *Vb, *CB, *U; int pn0; float sc;
    __device__ __forceinline__ void operator()(const f32x4 (&acc)[2][2][4][2], const pg8::Unit& u, int wr, int wc, int fr, int fq) const {
        const int pn = u.pn + pn0, pm = u.pm, rloc = wr * 64 + fr, cl = wc * 32 + 8 * fq;
        if (pn >= 6) {
            bf16_t* base = U + (size_t)(pm * 256 + rloc) * CW + 128 * (pn - 6) + cl;
#pragma unroll
            for (int ai = 0; ai < 2; ++ai)
#pragma unroll
                for (int m = 0; m < 4; ++m) { const f32x4 v0 = acc[ai][0][m][0] * acc[ai][1][m][0], v1 = acc[ai][0][m][1] * acc[ai][1][m][1];
                    u32x4 w; w.x = cvt_pk_bf16(v0[0], v0[1]); w.y = cvt_pk_bf16(v0[2], v0[3]); w.z = cvt_pk_bf16(v1[0], v1[1]); w.w = cvt_pk_bf16(v1[2], v1[3]);
                    *(u32x4*)(base + (size_t)(ai * 128 + m * 16) * CW) = w; }
        } else {
            bf16_t* base; int ld;
            if (pn < 2) { base = Q + (size_t)(pm * 256) * QW + 256 * pn; ld = QW; }
            else if (pn < 4) { const int krow0 = pm < 128 ? (pm >> 6) * SKV + (pm & 63) * 256 : (pm - 128) * SKV + SEQ; base = (pn == 2 ? Kb : Vb) + (size_t)krow0 * KVW; ld = KVW; }
            else { base = CB + (size_t)(pm * 256) * CW + 256 * (pn - 4); ld = CW; }
            base += (size_t)rloc * ld + cl;
#pragma unroll
            for (int ai = 0; ai < 2; ++ai)
#pragma unroll
                for (int m = 0; m < 4; ++m)
#pragma unroll
                    for (int bj = 0; bj < 2; ++bj) { const f32x4 v0 = acc[ai][bj][m][0] * sc, v1 = acc[ai][bj][m][1] * sc;
                        u32x4 w; w.x = cvt_pk_bf16(v0[0], v0[1]); w.y = cvt_pk_bf16(v0[2], v0[3]); w.z = cvt_pk_bf16(v1[0], v1[1]); w.w = cvt_pk_bf16(v1[2], v1[3]);
                        *(u32x4*)(base + (size_t)(ai * 128 + m * 16) * ld + bj * 128) = w; }
        }
    }
};
struct QkvOrder {
    pg8::StaticOrder so;
    __device__ __forceinline__ bool next(int i, pg8::Unit& u) const {
        if (so.next(i, u)) return true;
        const long L = (long)i * so.G + so.c - so.nwg; if (L >= 4) return false;
        u.pm = 128 + (int)(L >> 1); u.pn = 2 + (int)(L & 1); u.e = 0; return true;
    }
};
struct EpiResid {
    static constexpr bool PERM = true; static constexpr int BMODE = 0; static constexpr bool PRE = false; using Pre = EpiNoPre;
    const float* gt; bf16_t* d1;
    __device__ __forceinline__ void operator()(const f32x4 (&acc)[2][2][4][2], const pg8::Unit& u, int wr, int wc, int fr, int fq) const {
        const int row0 = u.pm * 256 + wr * 64 + fr, col0 = u.pn * 256 + wc * 32 + 8 * fq, b = u.pm >> 6;
        f32x4 g[2][2];
#pragma unroll
        for (int bj = 0; bj < 2; ++bj)
#pragma unroll
            for (int n = 0; n < 2; ++n) g[bj][n] = *(const f32x4*)(gt + (size_t)b * NMOD + col0 + bj * 128 + n * 4);
#pragma unroll
        for (int ai = 0; ai < 2; ++ai)
#pragma unroll
            for (int m = 0; m < 4; ++m) { bf16_t* dp = d1 + (size_t)(row0 + ai * 128 + m * 16) * DM + col0;
#pragma unroll
                for (int bj = 0; bj < 2; ++bj) { const f32x4 v0 = g[bj][0] * acc[ai][bj][m][0], v1 = g[bj][1] * acc[ai][bj][m][1];
                    u32x4 w; w.x = cvt_pk_bf16(v0[0], v0[1]); w.y = cvt_pk_bf16(v0[2], v0[3]); w.z = cvt_pk_bf16(v1[0], v1[1]); w.w = cvt_pk_bf16(v1[2], v1[3]);
                    *(u32x4*)(dp + bj * 128) = w; } }
    }
};
struct EpiSwiglu {
    static constexpr bool PERM = true; static constexpr int BMODE = 0; static constexpr bool PRE = true;
    struct Pre { f32x4 bg[2], bl[2]; };
    const float* bgu; unsigned char* ACT;
    __device__ __forceinline__ void pre(const pg8::Unit& u, int wr, int wc, int fr, int fq, Pre& p) const {
        const float* bp = bgu + (size_t)u.e * 2048 + 128 * u.pn + wc * 32 + 8 * fq;
#pragma unroll
        for (int n = 0; n < 2; ++n) { p.bg[n] = *(const f32x4*)(bp + 4 * n); p.bl[n] = *(const f32x4*)(bp + 1024 + 4 * n); }
    }
    __device__ __forceinline__ void operator()(const f32x4 (&acc)[2][2][4][2], const pg8::Unit& u, int wr, int wc, int fr, int fq, const Pre& p) const {
        const int cl = wc * 32 + 8 * fq, c0 = 128 * u.pn + cl;
        f32x4 bg[2], bl[2];
#pragma unroll
        for (int n = 0; n < 2; ++n) { bg[n] = p.bg[n]; bl[n] = p.bl[n] + 1.0f; }
        unsigned char* base = ACT + (size_t)(u.pm * 256 + wr * 64 + fr) * DFF + c0;
#pragma unroll
        for (int ai = 0; ai < 2; ++ai)
#pragma unroll
            for (int m = 0; m < 4; ++m) { float o[8];
#pragma unroll
                for (int n = 0; n < 2; ++n)
#pragma unroll
                    for (int i = 0; i < 4; ++i) { float gv = acc[ai][0][m][n][i] * WINV + bg[n][i], lv = acc[ai][1][m][n][i] * WINV + bl[n][i];
                        gv = fminf(gv, 7.0f); lv = fminf(fmaxf(lv, -6.0f), 8.0f);
                        const float sg = __builtin_amdgcn_rcpf(1.0f + __builtin_amdgcn_exp2f(gv * (-1.702f * 1.4426950408889634f)));
                        o[n * 4 + i] = gv * sg * lv; }
                u32x2 w; w.x = pk4_fp8(o[0], o[1], o[2], o[3]); w.y = pk4_fp8(o[4], o[5], o[6], o[7]);
                *(u32x2*)(base + (size_t)(ai * 128 + m * 16) * DFF) = w; }
    }
};
struct EpiDown {
    static constexpr bool PERM = true; static constexpr int BMODE = 1; static constexpr bool PRE = true;
    struct Pre { int dd[2][4]; float gg[2][4]; };
    const float* bd; const int* pinfo; const float* pgate; const LAS int* cntL; const LAS int* ts; unsigned char* YP;
    __device__ __forceinline__ void pre(const pg8::Unit& u, int wr, int wc, int fr, int fq, Pre& p) const {
        const int pos0 = (u.pm - ts[u.e]) * 256 + wr * 64 + fr, cn = cntL[u.e];
#pragma unroll
        for (int ai = 0; ai < 2; ++ai)
#pragma unroll
            for (int m = 0; m < 4; ++m) { const int pos = pos0 + ai * 128 + m * 16; const bool ok = pos < cn; const size_t ix = (size_t)u.e * NTOK + (ok ? pos : 0);
                const int di = pinfo[ix]; const float gi = pgate[ix]; p.dd[ai][m] = ok ? di : -1; p.gg[ai][m] = gi; }
    }
    __device__ __forceinline__ void operator()(const f32x4 (&acc)[2][2][4][2], const pg8::Unit& u, int wr, int wc, int fr, int fq, const Pre& p) const {
        const int c0 = 256 * u.pn + 64 * wc + 16 * fq;
        const float* bp = bd + (size_t)u.e * DM + c0;
        f32x4 bv[2][2];
#pragma unroll
        for (int bj = 0; bj < 2; ++bj)
#pragma unroll
            for (int n = 0; n < 2; ++n) bv[bj][n] = *(const f32x4*)(bp + 8 * bj + 4 * n);
#pragma unroll
        for (int ai = 0; ai < 2; ++ai)
#pragma unroll
            for (int m = 0; m < 4; ++m) { const int d = p.dd[ai][m]; const float gt = p.gg[ai][m];
                if (d >= 0) { u32x4 w;
                    { const f32x4 v0 = (acc[ai][0][m][0] * WINV + bv[0][0]) * gt, v1 = (acc[ai][0][m][1] * WINV + bv[0][1]) * gt; w.x = pk4_fp8(v0[0], v0[1], v0[2], v0[3]); w.y = pk4_fp8(v1[0], v1[1], v1[2], v1[3]); }
                    { const f32x4 v0 = (acc[ai][1][m][0] * WINV + bv[1][0]) * gt, v1 = (acc[ai][1][m][1] * WINV + bv[1][1]) * gt; w.z = pk4_fp8(v0[0], v0[1], v0[2], v0[3]); w.w = pk4_fp8(v1[0], v1[1], v1[2], v1[3]); }
                    *(u32x4*)(YP + (size_t)d * DM + c0) = w; } }
    }
};
struct MoeOrder {
    pg8::StaticOrder so; const LAS int* te;
    __device__ __forceinline__ bool next(int i, pg8::Unit& u) const {
        if (!so.next(i, u)) return false;
        u.e = __builtin_amdgcn_readfirstlane(te[u.pm]); return true;
    }
};
__device__ __forceinline__ int moe_tables(const unsigned* cnt, LAS int* ts, LAS int* te, LAS int* cntL) {
    __syncthreads();
    if (threadIdx.x == 0) { int s = 0; for (int e = 0; e < NEXP; ++e) { const int c = (int)cnt[e]; cntL[e] = c; ts[e] = s; s += (c + 255) >> 8; } ts[NEXP] = s; }
    __syncthreads();
    const int T = ts[NEXP];
    for (int t = threadIdx.x; t < T; t += 512) { int e = 0; while (e < NEXP - 1 && t >= ts[e + 1]) ++e; te[t] = e; }
    __syncthreads();
    return T;
}

__global__ void __launch_bounds__(512, 2) fwd_kernel(Args args) {
    extern __shared__ __attribute__((aligned(16))) unsigned char lds[];
    LAS unsigned char* L = (LAS unsigned char*)lds;
    LAS unsigned* MISC = (LAS unsigned*)(L + MISC_OFF);
    const int wave = __builtin_amdgcn_readfirstlane(threadIdx.x >> 6);
#define PHASE_IDS int tid = threadIdx.x; asm volatile("" : "+v"(tid)); const int lane = tid & 63; (void)lane
    const int G = gridDim.x, bx = blockIdx.x;
    const int vcu = (G % 8 == 0) ? (bx % 8) * (G / 8) + bx / 8 : bx;
    const int gw = vcu * 8 + wave, NGW = G * 8;
    const bool bg_on = G * 2 * attn8::BG_TILES == NEXP * (16 * 32 + 16 * 16);
    unsigned char* ws = args.ws;
    unsigned* ctl = (unsigned*)(ws + WS_CTL);
    const float* x = args.in[I_X];
    float* mod = (float*)(ws + WS_MOD); float* rope = (float*)(ws + WS_ROPE); float* wrt = (float*)(ws + WS_WRT);
    unsigned char* WIN8 = ws + WS_WIN8; unsigned char* H8 = ws + WS_H8;
    bf16_t* WIN = (bf16_t*)(ws + WS_WIN); bf16_t* WOUT = (bf16_t*)(ws + WS_WOUT); unsigned char* WGU8 = ws + WS_WGU; unsigned char* WDN8 = ws + WS_WDN;
    bf16_t* Hb = (bf16_t*)(ws + WS_H); bf16_t* Qb = (bf16_t*)(ws + WS_Q); bf16_t* Kb = (bf16_t*)(ws + WS_K); bf16_t* Vb = (bf16_t*)(ws + WS_V);
    unsigned char* Q8 = ws + WS_Q8; unsigned char* K8 = ws + WS_K8; unsigned char* V8T = ws + WS_V8T;
    bf16_t* CBb = (bf16_t*)(ws + WS_CB); bf16_t* Ub = (bf16_t*)(ws + WS_U); bf16_t* MIX = (bf16_t*)(ws + WS_MIX);
    bf16_t* D1 = (bf16_t*)(ws + WS_X1); bf16_t* X1B = (bf16_t*)(ws + WS_X1 + 64 * MiB); unsigned char* H28 = ws + WS_H2;
    int* PINFO = (int*)(ws + WS_PINFO); float* PGATE = (float*)(ws + WS_PGATE);
    unsigned char* ACT8 = ws + WS_ACT; unsigned char* YP = ws + WS_YP;
    unsigned* cnt = ctl + CW_CNT;

    for (int u = threadIdx.x; u < (LDS_BYTES - MISC_OFF) / 4; u += 512) MISC[u] = 0u;
    __syncthreads();
    XcdBarrier bar; bar.bar = ctl + CW_BAR + args.li * XCD_BAR_WORDS; bar.x = 0; bar.st = nullptr;
#if !MK_PER_PHASE
    bar = xcd_barrier_post(ctl + CW_BAR + args.li * XCD_BAR_WORDS, (volatile LAS unsigned*)(MISC + MO_BAR / 4));
#endif
    const int lo = args.ph_lo, hi = args.ph_hi;
#define IN(k) (lo <= (k) && (k) < hi)
#if MK_PER_PHASE
#define SEAM(k) do { } while (0)
#else
#define SEAM(k) do { if (IN(k) && IN((k) + 1)) xcd_barrier(bar); } while (0)
#endif

    if (IN(0)) {
        PHASE_IDS;
        {
            LAS float* sv = (LAS float*)L;
            LAS float* red = sv + 3 * DM;
            const float* w_ada = args.in[I_WADA]; const float* b_ada = args.in[I_BADA];
            for (int item = bx; item < NMOD / 32; item += G) {
                __syncthreads();
                for (int i = tid; i < 3 * DM; i += 512) { const int j = i >> 10, k = i & 1023; const float cv = j < 2 ? args.in[I_C][j * DM + k] : args.in[I_CCTX][k];
                    sv[i] = cv / (1.0f + __expf(-cv)); }
                __syncthreads();
                const int c0 = item * 32, col = lane & 31, ks = lane >> 5;
                float a0 = 0.f, a1 = 0.f, a2 = 0.f;
                const float* wp = w_ada + (size_t)(wave * 128 + ks) * NMOD + c0 + col;
#pragma unroll 16
                for (int i = 0; i < 64; ++i) { const float wv = wp[(size_t)(2 * i) * NMOD]; const int k = wave * 128 + 2 * i + ks;
                    a0 += sv[k] * wv; a1 += sv[DM + k] * wv; a2 += sv[2 * DM + k] * wv; }
                a0 += __shfl_xor(a0, 32); a1 += __shfl_xor(a1, 32); a2 += __shfl_xor(a2, 32);
                if (lane < 32) { red[(wave * 3 + 0) * 32 + col] = a0; red[(wave * 3 + 1) * 32 + col] = a1; red[(wave * 3 + 2) * 32 + col] = a2; }
                __syncthreads();
                if (tid < 96) { const int j = tid >> 5, cc = tid & 31; float s = b_ada[c0 + cc];
#pragma unroll
                    for (int w = 0; w < 8; ++w) s += red[(w * 3 + j) * 32 + cc];
                    mod[(size_t)j * NMOD + c0 + cc] = s; }
            }
            __syncthreads();
        }
        for (int idx = vcu * 512 + tid; idx < 256 * 32; idx += G * 512) {
            const int pos = idx >> 5, i = idx & 31;
            const float invf = exp2f(-(float)(2 * i) * (13.287712379549449f / 64.0f));
            const float ang = (float)pos * invf;
            const double rev = (double)ang * 0.15915494309189535;
            const float fr_ = (float)(rev - rint(rev));
            rope[2 * idx] = __builtin_amdgcn_cosf(fr_); rope[2 * idx + 1] = __builtin_amdgcn_sinf(fr_);
        }
        for (int idx = vcu * 512 + tid; idx < NEXP * DM; idx += G * 512) { const int e = idx >> 10, k = idx & 1023; wrt[idx] = args.in[I_WR][k * NEXP + e]; }
        {
            LAS float* scr = (LAS float*)(L + wave * 16640);
            constexpr int I_IN = 16 * 40, I_OUT = 16 * 16, I_GU1 = 16 * 32, I_DN1 = 16 * 16;
            constexpr int NITEMS = I_IN + I_OUT + NEXP * I_GU1 + NEXP * I_DN1;
            const int nitems = bg_on ? I_IN + I_OUT : NITEMS;
            for (int it = gw; it < nitems; it += NGW) {
                int r = it;
                if (r < I_IN) { const int kb = r / 40, nb = r % 40; if (nb < 16) transpose_item64_f8(args.in[I_WIN], INC, WIN8, DM, 64 * kb, 64 * nb, 64 * nb, WSCALE, scr, lane);
                    else transpose_item64(args.in[I_WIN], INC, WIN, DM, 64 * kb, 64 * nb, map_win(64 * nb), scr, lane); continue; } r -= I_IN;
                if (r < I_OUT) { const int kb = r / 16, nb = r % 16; transpose_item64(args.in[I_WOUT], DM, WOUT, DM, 64 * kb, 64 * nb, 64 * nb, scr, lane); continue; } r -= I_OUT;
                if (r < NEXP * I_GU1) { const int e = r / I_GU1, q = r % I_GU1, kb = q / 32, nb = q % 32;
                    transpose_item64_f8(args.in[I_WGU] + (size_t)e * DM * 2048, 2048, WGU8 + (size_t)e * 2048 * DM, DM, 64 * kb, 64 * nb, map_gu(64 * nb), WSCALE, scr, lane); continue; } r -= NEXP * I_GU1;
                { const int e = r / I_DN1, q = r % I_DN1, kb = q / 16, nb = q % 16;
                    transpose_item64_f8(args.in[I_WDN] + (size_t)e * DFF * DM, DM, WDN8 + (size_t)e * DM * DFF, DFF, 64 * kb, 64 * nb, 64 * nb, WSCALE, scr, lane); }
            }
        }
    }
    SEAM(0);

    if (IN(1)) {
        PHASE_IDS;
        const float* g1 = args.in[I_G1];
        int curm = -1; f32x4 gs[4], sh[4];
        for (int r0 = gw * 2; r0 < MROWS; r0 += NGW * 2) {
            const int mb = r0 < NTOK ? (r0 >> 14) : 2;
            if (mb != curm) { curm = mb;
#pragma unroll
                for (int j = 0; j < 4; ++j) { const int c = 4 * lane + 256 * j; const f32x4 g = *(const f32x4*)(g1 + c), s = *(const f32x4*)(mod + (size_t)mb * NMOD + DM + c);
                    gs[j] = g * (s + 1.0f); sh[j] = *(const f32x4*)(mod + (size_t)mb * NMOD + c); } }
            f32x4 v[2][4]; float ss[2] = {0.f, 0.f};
#pragma unroll
            for (int q = 0; q < 2; ++q) { const int r = r0 + q;
                const float* src = r < NTOK ? x + (size_t)r * DM : args.in[I_CTX] + (size_t)(r - NTOK) * DM;
                const GAS f32x4* xr = (const GAS f32x4*)src + lane;
#pragma unroll
                for (int j = 0; j < 4; ++j) { v[q][j] = xr[64 * j]; ss[q] += (v[q][j].x * v[q][j].x + v[q][j].y * v[q][j].y) + (v[q][j].z * v[q][j].z + v[q][j].w * v[q][j].w); } }
#pragma unroll
            for (int q = 0; q < 2; ++q) { const int r = r0 + q;
                const float rstd = rsqrtf(wave_sum(ss[q]) * (1.f / DM) + NORM_EPS);
                GAS u32x2* o8 = (GAS u32x2*)(Hb + (size_t)r * DM) + lane;
                GAS unsigned* o4 = (GAS unsigned*)(H8 + (size_t)r * DM) + lane;
#pragma unroll
                for (int j = 0; j < 4; ++j) { const f32x4 y = v[q][j] * rstd * gs[j] + sh[j]; u32x2 w; w.x = cvt_pk_bf16(y.x, y.y); w.y = cvt_pk_bf16(y.z, y.w); st_wt(o8 + 64 * j, w); st_wt(o4 + 64 * j, pk4_fp8(y.x, y.y, y.z, y.w)); } }
        }
    }
    SEAM(1);

    if (IN(2)) {
        {
            pg8::Gemm g{(const bf16_t*)H8, (const bf16_t*)WIN8, MROWS, 1024, DM / 2, 0, nullptr, nullptr, nullptr, 0};
            QkvOrder S; S.so.init(NTOK / 256, 4, G, bx);
            EpiQKV E{Qb, Kb, Vb, CBb, Ub, 0, WINV};
            pg8::gemm_phase<EpiQKV, QkvOrder, true, true, true>(L, g, S, E);
        }
        {
            pg8::Gemm g{Hb, WIN + (size_t)1024 * DM, NTOK, INC - 1024, DM, 0, nullptr, nullptr, nullptr, 0};
            pg8::StaticOrder S; S.init(NTOK / 256, 6, G, bx);
            EpiQKV E{Qb, Kb, Vb, CBb, Ub, 4, 1.0f};
            pg8::gemm_phase<EpiQKV, pg8::StaticOrder, true, true>(L, g, S, E);
        }
    }
    SEAM(2);

    if (IN(3)) {
        PHASE_IDS;
        const float* gq = args.in[I_GQ]; const float* gk = args.in[I_GK]; const float* wconv = args.in[I_WCONV];
        const f32x2 gq2 = *(const f32x2*)(gq + 2 * lane), gk2 = *(const f32x2*)(gk + 2 * lane);
        float cw0[8], cw1[8], cw2[8];
#pragma unroll
        for (int i = 0; i < 8; ++i) { cw0[i] = wconv[8 * lane + i]; cw1[i] = wconv[CW + 8 * lane + i]; cw2[i] = wconv[2 * CW + 8 * lane + i]; }
        const int hb4 = (lane >> 4) & 1;
        for (int chunk = gw; chunk < NTOK / 16; chunk += NGW) {
            const int r0 = chunk * 16;
            u32x4 up, uc, un; { const int t0 = r0 & (SEQ - 1); up = t0 == 0 ? (u32x4){0, 0, 0, 0} : *(const u32x4*)(Ub + (size_t)(r0 - 1) * CW + 8 * lane); uc = *(const u32x4*)(Ub + (size_t)r0 * CW + 8 * lane); }
            for (int rr = 0; rr < 16; ++rr) {
                const int r = r0 + rr, b = r >> 14, t = r & (SEQ - 1), prow = t >> 6, pcol = t & 63;
                un = t == SEQ - 1 ? (u32x4){0, 0, 0, 0} : *(const u32x4*)(Ub + (size_t)(r + 1) * CW + 8 * lane);
                const f32x4 cs = *(const f32x4*)(rope + ((size_t)((lane >> 5) ? pcol : prow) * 32 + 2 * (lane & 15)) * 2);
                unsigned qv[4], kv[2];
#pragma unroll
                for (int h = 0; h < 4; ++h) qv[h] = *(const unsigned*)(Qb + (size_t)r * QW + h * HD + 2 * lane);
                bf16_t* krow = Kb + ((size_t)b * SKV + t) * KVW;
#pragma unroll
                for (int h = 0; h < 2; ++h) kv[h] = *(const unsigned*)(krow + h * HD + 2 * lane);
#pragma unroll
                for (int h = 0; h < 6; ++h) {
                    const unsigned w = h < 4 ? qv[h] : kv[h - 4]; const f32x2 g2 = h < 4 ? gq2 : gk2;
                    float a = bf_lo(w), c = bf_hi(w);
                    const float rstd = rsqrtf(wave_sum(a * a + c * c) * (1.f / HD) + NORM_EPS);
                    a = a * rstd * g2.x; c = c * rstd * g2.y;
                    const float pa = __shfl_xor(a, 16), pc = __shfl_xor(c, 16);
                    const float oa = hb4 ? a * cs.x + pa * cs.y : a * cs.x - pa * cs.y;
                    const float oc = hb4 ? c * cs.z + pc * cs.w : c * cs.z - pc * cs.w;
                    if (h < 4) *(unsigned short*)(Q8 + (size_t)r * QW + h * HD + 2 * lane) = (unsigned short)__builtin_amdgcn_cvt_pk_fp8_f32(oa * (QSCALE * attn8::YS), oc * (QSCALE * attn8::YS), 0, false);
                    else *(unsigned short*)(K8 + ((size_t)b * SKV + t) * KVW + (h - 4) * HD + 2 * lane) = (unsigned short)__builtin_amdgcn_cvt_pk_fp8_f32(oa, oc, 0, false);
                }
                const u32x4 cbv = *(const u32x4*)(CBb + (size_t)r * CW + 8 * lane);
                u32x4 ov;
#pragma unroll
                for (int q = 0; q < 4; ++q) {
                    const float y0 = bf_lo(up[q]) * cw0[2 * q] + bf_lo(uc[q]) * cw1[2 * q] + bf_lo(un[q]) * cw2[2 * q];
                    const float y1 = bf_hi(up[q]) * cw0[2 * q + 1] + bf_hi(uc[q]) * cw1[2 * q + 1] + bf_hi(un[q]) * cw2[2 * q + 1];
                    ov[q] = cvt_pk_bf16(bf_lo(cbv[q]) * y0, bf_hi(cbv[q]) * y1);
                }
                *(u32x4*)(MIX + (size_t)r * DM + QW + 8 * lane) = ov;
                up = uc; uc = un;
            }
        }
        for (int cr = gw; cr < NCTX; cr += NGW) {
            bf16_t* krow = Kb + ((size_t)(cr >> 8) * SKV + SEQ + (cr & 255)) * KVW;
#pragma unroll
            for (int h = 0; h < 2; ++h) { const unsigned w = *(const unsigned*)(krow + h * HD + 2 * lane); float a = bf_lo(w), c = bf_hi(w);
                const float rstd = rsqrtf(wave_sum(a * a + c * c) * (1.f / HD) + NORM_EPS);
                *(unsigned short*)(K8 + ((size_t)(cr >> 8) * SKV + SEQ + (cr & 255)) * KVW + h * HD + 2 * lane) = (unsigned short)__builtin_amdgcn_cvt_pk_fp8_f32(a * rstd * gk2.x, c * rstd * gk2.y, 0, false); }
        }
        {
            LAS unsigned short* vt = (LAS unsigned short*)L;
            for (int item = bx; item < BATCH * (SKV / 64); item += G) {
                const int b = item / (SKV / 64), t64 = item % (SKV / 64);
                __syncthreads();
#pragma unroll
                for (int i = 0; i < 4; ++i) { const int cid = tid + 512 * i, row = cid >> 5, c16 = cid & 31;
                    *(LAS u32x4*)(vt + row * 264 + c16 * 8) = *(const u32x4*)(Vb + ((size_t)b * SKV + 64 * t64 + row) * KVW + c16 * 8); }
                __syncthreads();
                const int dr = tid >> 1, h = tid & 1; unsigned w[8];
#pragma unroll
                for (int q = 0; q < 8; ++q) { float f[4];
#pragma unroll
                    for (int i = 0; i < 4; ++i) { const int j = 4 * q + i, r = j & 15, key = 32 * (j >> 4) + (r & 3) + 8 * (r >> 2) + 4 * h; f[i] = __uint_as_float((unsigned)vt[key * 264 + dr] << 16); }
                    w[q] = pk4_fp8(f[0], f[1], f[2], f[3]); }
                unsigned char* dst = V8T + ((size_t)(b * 2 + (dr >> 7)) * HD + (dr & 127)) * SKV + 64 * t64 + 32 * h;
                *(u32x4*)dst = (u32x4){w[0], w[1], w[2], w[3]}; *(u32x4*)(dst + 16) = (u32x4){w[4], w[5], w[6], w[7]};
            }
            __syncthreads();
        }
    }
    SEAM(3);

    if (IN(4)) {
        PHASE_IDS;
        for (int i = 0;; ++i) {
            const int U = i * G + vcu; if (U >= BATCH * NQH * (SEQ / 256)) break;
            const int combo = U >> 7, hl = (U >> 6) & 1, qb = U & 63, b = combo >> 1, kvh = combo & 1, hq = kvh * 2 + hl;
            attn8::bf16* Op = (attn8::bf16*)MIX + ((size_t)(b * SEQ + qb * 256)) * DM + hq * HD;
            if (bg_on && i < 2) attn8::attn_body<true>(Q8 + ((size_t)(b * SEQ + qb * 256)) * QW + hq * HD, K8 + (size_t)b * SKV * KVW + kvh * HD, V8T + (size_t)(b * 2 + kvh) * HD * SKV, Op, SKV, (char*)lds,
                (vcu * 2 + i) * attn8::BG_TILES, args.in[I_WGU], args.in[I_WDN], WGU8, WDN8, ws + WS_ACT + 150 * MiB);
            else attn8::attn_body<false>(Q8 + ((size_t)(b * SEQ + qb * 256)) * QW + hq * HD, K8 + (size_t)b * SKV * KVW + kvh * HD, V8T + (size_t)(b * 2 + kvh) * HD * SKV, Op, SKV, (char*)lds,
                0, nullptr, nullptr, nullptr, nullptr, nullptr);
            __syncthreads();
        }
    }
    SEAM(4);

    if (IN(5)) {
#if MK_ATTN_CHECK
        {
            PHASE_IDS;
            LAS float* red = (LAS float*)L;
            LAS unsigned* mx = (LAS unsigned*)(L + 8192);
            for (int ci = 0; ci < 4; ++ci) {
                const unsigned U = (unsigned)bx * 4u + (unsigned)ci; const int b = U & 1, hq = (U >> 1) & 3, kvh = hq >> 1, t = (int)((U * 2654435761u >> 7) % (unsigned)SEQ);
                __syncthreads(); if (tid < 2) mx[tid] = 0u; __syncthreads();
                const unsigned qw = *(const unsigned short*)(Q8 + ((size_t)(b * SEQ + t)) * QW + hq * HD + 2 * lane); const float q0 = __builtin_amdgcn_cvt_f32_fp8((int)qw, 0), q1 = __builtin_amdgcn_cvt_f32_fp8((int)qw, 1);
                float lsum = 0.f, o0 = 0.f, o1 = 0.f;
                for (int key = wave; key < SKV; key += 8) {
                    const unsigned kw = *(const unsigned short*)(K8 + ((size_t)b * SKV + key) * KVW + kvh * HD + 2 * lane);
                    const int kl = key & 63, tt = kl >> 5, cc = kl & 31, hh = (cc >> 2) & 1, rr2 = (cc & 3) + 4 * (cc >> 3), pos = (key & ~63) + 32 * hh + 16 * tt + rr2;
                    const unsigned char* vp = V8T + ((size_t)(b * 2 + kvh) * HD + 2 * lane) * SKV + pos;
                    const float v0 = __builtin_amdgcn_cvt_f32_fp8((int)vp[0], 0), v1 = __builtin_amdgcn_cvt_f32_fp8((int)vp[SKV], 0);
                    const float dot = wave_sum(q0 * __builtin_amdgcn_cvt_f32_fp8((int)kw, 0) + q1 * __builtin_amdgcn_cvt_f32_fp8((int)kw, 1)); const float p = exp2f(dot * (1.0f / attn8::YS));
                    lsum += p; o0 += p * v0; o1 += p * v1; }
                red[wave * 132 + 2 * lane] = o0; red[wave * 132 + 2 * lane + 1] = o1; if (lane == 0) red[wave * 132 + 128] = lsum;
                __syncthreads();
                if (tid < 128) { float os = 0.f, ls = 0.f;
                    for (int w = 0; w < 8; ++w) { os += red[w * 132 + tid]; ls += red[w * 132 + 128]; }
                    const float ref = os / ls; const unsigned short mv = *(const unsigned short*)(MIX + ((size_t)(b * SEQ + t)) * DM + hq * HD + tid); const float got = __uint_as_float((unsigned)mv << 16);
                    float err = fabsf(got - ref); if (!(err == err)) err = 1e30f;
                    atomicMax((unsigned*)&mx[0], __float_as_uint(err)); atomicMax((unsigned*)&mx[1], __float_as_uint(fabsf(ref))); }
                __syncthreads();
                if (tid == 0) { const float e = __uint_as_float(mx[0]), r = __uint_as_float(mx[1]); if (e > 0.08f * r + 1e-5f) atomicOr(ctl + CW_FLAG, 1u); }
            }
            __syncthreads();
        }
#endif
        pg8::Gemm g{MIX, WOUT, NTOK, DM, DM, 0, nullptr, nullptr, nullptr, 0};
        pg8::StaticOrder S; S.init(NTOK / 256, DM / 256, G, bx);
        EpiResid E{mod + 2 * DM, D1};
        pg8::gemm_phase<EpiResid, pg8::StaticOrder, true, true>(L, g, S, E);
    }
    SEAM(5);

    if (IN(6)) {
        PHASE_IDS;
        LAS float* wl = (LAS float*)L;
        for (int i = tid; i < NEXP * DM / 4; i += 512) ((LAS f32x4*)wl)[i] = ((const f32x4*)wrt)[i];
        LAS int* hist = (LAS int*)(MISC + MO_HIST / 4); LAS int* baseL = (LAS int*)(MISC + MO_BASE / 4);
        LAS int* sele = (LAS int*)(MISC + MO_SELE / 4); LAS float* selg = (LAS float*)(MISC + MO_SELG / 4);
        const float* g2 = args.in[I_G2]; const float* brt = args.in[I_BR];
        const float br_l = brt[8 * (lane >> 4) + (lane & 7)];
        if (bx == 0 && tid < 64) ((u32x4*)(H28 + (size_t)NTOK * DM))[tid] = (u32x4){0, 0, 0, 0};
        for (int tb = bx; tb < NTOK / 128; tb += G) {
            __syncthreads();
            if (tid < NEXP) hist[tid] = 0;
            __syncthreads();
            const int b = (tb * 128) >> 14;
            f32x4 gs[4], sh[4];
            { int lo_ = lane; asm volatile("" : "+v"(lo_));
#pragma unroll
              for (int j = 0; j < 4; ++j) { const int c = 4 * lo_ + 256 * j; const f32x4 g = *(const f32x4*)(g2 + c), s = *(const f32x4*)(mod + (size_t)b * NMOD + 4 * DM + c);
                gs[j] = g * (s + 1.0f); sh[j] = *(const f32x4*)(mod + (size_t)b * NMOD + 3 * DM + c); } }
            f32x4 xq[2][4]; u32x2 dq[2][4];
#define P6_LOAD(G_) do { _Pragma("unroll") for (int rr = 0; rr < 2; ++rr) { const int r = tb * 128 + wave * 16 + (G_) * 2 + rr; \
                const GAS f32x4* xr = (const GAS f32x4*)(x + (size_t)r * DM) + lane; const GAS u32x2* dr = (const GAS u32x2*)(D1 + (size_t)r * DM) + lane; \
                _Pragma("unroll") for (int j = 0; j < 4; ++j) { xq[rr][j] = xr[64 * j]; dq[rr][j] = dr[64 * j]; } } } while (0)
            P6_LOAD(0);
#pragma unroll 1
            for (int grp = 0; grp < 8; ++grp) {
                const int tl0 = wave * 16 + grp * 2;
                f32x4 v[2][4];
#pragma unroll
                for (int rr = 0; rr < 2; ++rr)
#pragma unroll
                    for (int j = 0; j < 4; ++j) v[rr][j] = xq[rr][j] + (f32x4){bf_lo(dq[rr][j].x), bf_hi(dq[rr][j].x), bf_lo(dq[rr][j].y), bf_hi(dq[rr][j].y)};
                __builtin_amdgcn_sched_barrier(0);
                { const int gn = grp + 1 < 8 ? grp + 1 : 7; P6_LOAD(gn); }
                __builtin_amdgcn_sched_barrier(0);
#pragma unroll
                for (int rr = 0; rr < 2; ++rr) { const int r = tb * 128 + tl0 + rr; float s = 0.f;
#pragma unroll
                    for (int j = 0; j < 4; ++j) s += (v[rr][j].x * v[rr][j].x + v[rr][j].y * v[rr][j].y) + (v[rr][j].z * v[rr][j].z + v[rr][j].w * v[rr][j].w);
                    const float rstd = rsqrtf(wave_sum(s) * (1.f / DM) + NORM_EPS);
                    GAS unsigned* o4 = (GAS unsigned*)(H28 + (size_t)r * DM) + lane;
                    GAS u32x2* x1w = (GAS u32x2*)(X1B + (size_t)r * DM) + lane;
#pragma unroll
                    for (int j = 0; j < 4; ++j) { st_wt(x1w + 64 * j, (u32x2){cvt_pk_bf16(v[rr][j].x, v[rr][j].y), cvt_pk_bf16(v[rr][j].z, v[rr][j].w)});
                        v[rr][j] = v[rr][j] * rstd * gs[j] + sh[j]; st_wt(o4 + 64 * j, pk4_fp8(v[rr][j].x, v[rr][j].y, v[rr][j].z, v[rr][j].w)); } }
                float lg[2];
                {
                    float q[2][16];
#pragma unroll
                    for (int i = 0; i < 16; ++i) {
                        float pa[2], pb[2];
#pragma unroll
                        for (int h2 = 0; h2 < 2; ++h2) { const int e = i + 16 * h2;
                            f32x4 w[4];
#pragma unroll
                            for (int j = 0; j < 4; ++j) w[j] = *(const LAS f32x4*)(wl + e * DM + 4 * lane + 256 * j);
#pragma unroll
                            for (int rr = 0; rr < 2; ++rr) {
                                f32x2 a = __builtin_shufflevector(v[rr][0], v[rr][0], 0, 1) * __builtin_shufflevector(w[0], w[0], 0, 1);
                                a = __builtin_elementwise_fma(__builtin_shufflevector(v[rr][0], v[rr][0], 2, 3), __builtin_shufflevector(w[0], w[0], 2, 3), a);
#pragma unroll
                                for (int j = 1; j < 4; ++j) { a = __builtin_elementwise_fma(__builtin_shufflevector(v[rr][j], v[rr][j], 0, 1), __builtin_shufflevector(w[j], w[j], 0, 1), a);
                                    a = __builtin_elementwise_fma(__builtin_shufflevector(v[rr][j], v[rr][j], 2, 3), __builtin_shufflevector(w[j], w[j], 2, 3), a); }
                                (h2 ? pb : pa)[rr] = a.x + a.y; } }
#pragma unroll
                        for (int rr = 0; rr < 2; ++rr) { auto r = __builtin_amdgcn_permlane32_swap(__float_as_uint(pa[rr]), __float_as_uint(pb[rr]), false, false); q[rr][i] = __uint_as_float(r[0]) + __uint_as_float(r[1]); }
                        __builtin_amdgcn_sched_barrier(0);
                    }
#pragma unroll
                    for (int rr = 0; rr < 2; ++rr) {
                        float t8[8];
#pragma unroll
                        for (int i = 0; i < 8; ++i) { auto r = __builtin_amdgcn_permlane16_swap(__float_as_uint(q[rr][i]), __float_as_uint(q[rr][i + 8]), false, false); float t = __uint_as_float(r[0]) + __uint_as_float(r[1]);
                            t += dpp_f<0xB1>(t); t += dpp_f<0x4E>(t); t += dpp_f<0x141>(t); t += dpp_f<0x140>(t); t8[i] = t; }
                        const float a0 = (lane & 1) ? t8[1] : t8[0], a1 = (lane & 1) ? t8[3] : t8[2], a2 = (lane & 1) ? t8[5] : t8[4], a3 = (lane & 1) ? t8[7] : t8[6];
                        const float b0 = (lane & 2) ? a1 : a0, b1 = (lane & 2) ? a3 : a2;
                        lg[rr] = (lane & 4) ? b1 : b0;
                    }
                }
                const int e_l = 8 * (lane >> 4) + (lane & 7);
#pragma unroll
                for (int rr = 0; rr < 2; ++rr) {
                    float val = lg[rr] + br_l; int si[4]; float sv4[4];
#pragma unroll
                    for (int k = 0; k < 4; ++k) { float m = half_max(val);
                        { auto r = __builtin_amdgcn_permlane32_swap(__float_as_uint(m), __float_as_uint(m), false, false); m = fmaxf(__uint_as_float(r[0]), __uint_as_float(r[1])); }
                        const unsigned long long bal = __ballot(val == m);
                        const int fl = __builtin_amdgcn_readfirstlane(__ffsll((long long)bal) - 1);
                        const int idx = 8 * (fl >> 4) + (fl & 7);
                        si[k] = idx; sv4[k] = m;
                        if (e_l == idx) val = -INFINITY; }
                    const float e1 = __expf(sv4[1] - sv4[0]), e2 = __expf(sv4[2] - sv4[0]), e3 = __expf(sv4[3] - sv4[0]);
                    const float inv = 1.0f / (1.0f + e1 + e2 + e3);
                    if (lane < 4) { const int e = lane == 0 ? si[0] : lane == 1 ? si[1] : lane == 2 ? si[2] : si[3];
                        const float gt = (lane == 0 ? 1.0f : lane == 1 ? e1 : lane == 2 ? e2 : e3) * inv;
                        const int rank = __hip_atomic_fetch_add(hist + e, 1, __ATOMIC_RELAXED, __HIP_MEMORY_SCOPE_WORKGROUP);
                        sele[(tl0 + rr) * 4 + lane] = e | (rank << 8); selg[(tl0 + rr) * 4 + lane] = gt; }
                }
            }
#undef P6_LOAD
            __syncthreads();
            if (tid < NEXP) baseL[tid] = (int)atomicAdd(&cnt[tid], (unsigned)hist[tid]);
            __syncthreads();
            { const int v = sele[tid], e = v & 31, pos = baseL[e] + (v >> 8);
              PINFO[(size_t)e * NTOK + pos] = (tb * 128 + (tid >> 2)) * 4 + (tid & 3); PGATE[(size_t)e * NTOK + pos] = selg[tid]; }
        }
    }
    SEAM(6);


    if (IN(8)) {
        LAS int* ts = (LAS int*)(MISC + MO_TS / 4); LAS int* te = (LAS int*)(MISC + MO_TE / 4);
        const int T = moe_tables(cnt, ts, te, (LAS int*)(MISC + MO_HIST / 4));
        pg8::Gemm g{(const bf16_t*)H28, (const bf16_t*)WGU8, T * 256, 2048, DM / 2, (size_t)2048 * DM, PINFO, cnt, ts, NTOK};
        MoeOrder S; S.so.init(T, 8, G, bx); S.te = te;
        EpiSwiglu E{args.in[I_BGU], ACT8};
        pg8::gemm_phase<EpiSwiglu, MoeOrder, true, true, true, true>(L, g, S, E);
    }
    SEAM(8);

    if (IN(9)) {
        LAS int* ts = (LAS int*)(MISC + MO_TS / 4); LAS int* te = (LAS int*)(MISC + MO_TE / 4);
        LAS int* cntL = (LAS int*)(MISC + MO_HIST / 4);
        const int T = moe_tables(cnt, ts, te, cntL);
        pg8::Gemm g{(const bf16_t*)ACT8, (const bf16_t*)WDN8, T * 256, DM, DFF / 2, (size_t)DM * DFF, nullptr, nullptr, nullptr, 0};
        MoeOrder S; S.so.init(T, 4, G, bx); S.te = te;
        EpiDown E{args.in[I_BDN], PINFO, PGATE, cntL, ts, YP};
        pg8::gemm_phase<EpiDown, MoeOrder, true, true, true>(L, g, S, E);
    }
    SEAM(9);

    if (IN(10)) {
        PHASE_IDS;
        const float* gf = args.in[I_GF];
        f32x4 gfv[4];
#pragma unroll
        for (int j = 0; j < 4; ++j) gfv[j] = *(const f32x4*)(gf + 4 * lane + 256 * j);
        int curb = -1; f32x4 gtv[4];
        for (int r0 = gw * 2; r0 < NTOK; r0 += NGW * 2) {
            const int b = r0 >> 14;
            if (b != curb) { curb = b;
#pragma unroll
                for (int j = 0; j < 4; ++j) gtv[j] = *(const f32x4*)(mod + (size_t)b * NMOD + 5 * DM + 4 * lane + 256 * j); }
            f32x4 v[2][4]; float s[2] = {0.f, 0.f};
#pragma unroll
            for (int q = 0; q < 2; ++q) { const int r = r0 + q;
                const GAS u32x2* dr = (const GAS u32x2*)(X1B + (size_t)r * DM) + lane;
#pragma unroll
                for (int j = 0; j < 4; ++j) {
                    f32x4 y = {0.f, 0.f, 0.f, 0.f};
#pragma unroll
                    for (int k = 0; k < 4; ++k) { const int w = (int)((const GAS unsigned*)(YP + ((size_t)r * 4 + k) * DM))[lane + 64 * j];
                        y.x += __builtin_amdgcn_cvt_f32_fp8(w, 0); y.y += __builtin_amdgcn_cvt_f32_fp8(w, 1); y.z += __builtin_amdgcn_cvt_f32_fp8(w, 2); y.w += __builtin_amdgcn_cvt_f32_fp8(w, 3); }
                    const u32x2 dw = dr[64 * j];
                    v[q][j] = (f32x4){bf_lo(dw.x), bf_hi(dw.x), bf_lo(dw.y), bf_hi(dw.y)} + gtv[j] * y;
                    s[q] += (v[q][j].x * v[q][j].x + v[q][j].y * v[q][j].y) + (v[q][j].z * v[q][j].z + v[q][j].w * v[q][j].w);
                } }
#pragma unroll
            for (int q = 0; q < 2; ++q) { const int r = r0 + q;
                const float rstd = rsqrtf(wave_sum(s[q]) * (1.f / DM) + NORM_EPS);
                GAS f32x4* o = (GAS f32x4*)(args.out + (size_t)r * DM) + lane;
#if MK_ATTN_CHECK
                const float poison = ctl[CW_FLAG] ? __builtin_nanf("") : 0.f;
#pragma unroll
                for (int j = 0; j < 4; ++j) o[64 * j] = v[q][j] * rstd * gfv[j] + poison;
#else
#pragma unroll
                for (int j = 0; j < 4; ++j) st_wt(o + 64 * j, v[q][j] * rstd * gfv[j]);
#endif
            }
        }
    }
#undef IN
#undef SEAM
#undef PHASE_IDS
}

extern "C" void kernel_launch(void* const* d_in, const int* in_sizes, int n_in, void* d_out, int out_size, void* d_ws, size_t ws_size, hipStream_t stream) {
    static int grid = 0;
    if (grid == 0) {
        if (n_in != 20 || in_sizes[0] != NTOK * DM || out_size != NTOK * DM || ws_size < WS_END) {
            fprintf(stderr, "kernel_launch: shape mismatch (n_in %d, in0 %d, out %d, ws %zu; need ws >= %zu); nothing launched\n", n_in, n_in > 0 ? in_sizes[0] : -1, out_size, ws_size, (size_t)WS_END); grid = -1; return; }
        int dev = 0, cus = 0, per_cu = 0;
        if (hipGetDevice(&dev) != hipSuccess || hipDeviceGetAttribute(&cus, hipDeviceAttributeMultiprocessorCount, dev) != hipSuccess) { grid = -1; return; }
        if (hipFuncSetAttribute((const void*)fwd_kernel, hipFuncAttributeMaxDynamicSharedMemorySize, LDS_BYTES) != hipSuccess) { fprintf(stderr, "kernel_launch: hipFuncSetAttribute failed\n"); grid = -1; return; }
        if (hipOccupancyMaxActiveBlocksPerMultiprocessor(&per_cu, (const void*)fwd_kernel, 512, LDS_BYTES) != hipSuccess || per_cu < 1)
            fprintf(stderr, "kernel_launch: note: occupancy query reports %d workgroups per CU\n", per_cu);
        (void)hipGetLastError();
        grid = cus;
    }
    if (grid < 0) return;
    if (hipMemsetAsync((char*)d_ws + WS_CTL, 0, CTL_ZERO_BYTES, stream) != hipSuccess) return;
    Args a{};
    for (int i = 0; i < 20; ++i) a.in[i] = (const float*)d_in[i];
    a.out = (float*)d_out; a.ws = (unsigned char*)d_ws;
#if MK_PER_PHASE
    for (int p = 0; p < NPHASE; ++p) { a.ph_lo = p; a.ph_hi = p + 1; hipLaunchKernelGGL(fwd_kernel, dim3(grid), dim3(512), LDS_BYTES, stream, a); }
#elif MK_DUP >= 0
    a.ph_lo = 0; a.ph_hi = MK_DUP + 1; a.li = 0; hipLaunchKernelGGL(fwd_kernel, dim3(grid), dim3(512), LDS_BYTES, stream, a);
    a.ph_lo = MK_DUP; a.ph_hi = NPHASE; a.li = 1; hipLaunchKernelGGL(fwd_kernel, dim3(grid), dim3(512), LDS_BYTES, stream, a);
#else
    a.ph_lo = 0; a.ph_hi = NPHASE;
    hipLaunchKernelGGL(fwd_kernel, dim3(grid), dim3(512), LDS_BYTES, stream, a);
#endif
    const hipError_t le = hipPeekAtLastError();
    if (le != hipSuccess) fprintf(stderr, "kernel_launch: launch failed: %s\n", hipGetErrorName(le));
}
```
